# Optimizing an MI355X kernel written in HIP

```python
import jax, jax.numpy as jnp
from jax import lax
import numpy as np

D_MODEL = 1024
BATCH = 8
SEQ = 4096
DEPTH = 2

GRID_W = 64
CTX_LEN = 256
EPS = 1e-6
ROPE_THETA = 10000.0
Q_BLOCK = 128
LRU_WIDTH = 512
LRU_BLOCKS = 8
LRU_BLOCK = LRU_WIDTH // LRU_BLOCKS
CONV_W = 4
LRU_C = 8.0
MLA_HEADS = 8
MLA_Q_RANK = 256
MLA_KV_RANK = 128
MLA_NOPE = 64
MLA_ROPE = 32
MLA_V = 64
MLA_SCALE = (MLA_NOPE + MLA_ROPE) ** -0.5
GQA_HEADS = 8
GQA_KV_HEADS = 2
GQA_GROUP = GQA_HEADS // GQA_KV_HEADS
GQA_DIM = 64
GQA_SCALE = GQA_DIM ** -0.5
N_BRANCH = 3
BRANCH_W = 512
N_GROUPS = 4
EXPERTS_PER_GROUP = 8
N_EXPERTS = N_GROUPS * EXPERTS_PER_GROUP
TOP_K = 2
D_EXPERT = 256
KV_SIZES = (LRU_WIDTH, MLA_KV_RANK, MLA_ROPE, GQA_KV_HEADS * GQA_DIM, GQA_KV_HEADS * GQA_DIM)
Q_SIZES = (LRU_WIDTH, MLA_Q_RANK, GQA_HEADS * GQA_DIM, N_BRANCH * D_MODEL)
KV_SIDE = LRU_WIDTH + MLA_KV_RANK + MLA_ROPE + 2 * GQA_KV_HEADS * GQA_DIM
D_IN = KV_SIDE + LRU_WIDTH + MLA_Q_RANK + GQA_HEADS * GQA_DIM + N_BRANCH * D_MODEL

kernel_name = "hybrid_flow_backbone"


def rms_norm(x, g):
    xf = x.astype(jnp.float32)
    y = xf * lax.rsqrt(jnp.mean(xf * xf, axis=-1, keepdims=True) + EPS)
    return (y * g.astype(jnp.float32)).astype(x.dtype)


def modulate(h, shift, scale):
    return h * (1 + scale) + shift


def split_cols(u, sizes):
    idx = [int(i) for i in np.cumsum(sizes)[:-1]]
    return jnp.split(u, idx, axis=-1)


def rope_tables(n, rot_dim):
    rows = n // GRID_W
    row = jnp.repeat(jnp.arange(rows), GRID_W).astype(jnp.float32)
    col = jnp.tile(jnp.arange(GRID_W), rows).astype(jnp.float32)
    quarter = rot_dim // 4
    freqs = ROPE_THETA ** (-jnp.arange(quarter, dtype=jnp.float32) / quarter)
    ang = jnp.concatenate([row[:, None] * freqs, col[:, None] * freqs], axis=-1)
    return jnp.cos(ang), jnp.sin(ang)


def apply_rope(x, cos, sin):
    xf = x.astype(jnp.float32)
    half = x.shape[-1] // 2
    x1, x2 = xf[..., :half], xf[..., half:]
    return jnp.concatenate([x1 * cos - x2 * sin, x1 * sin + x2 * cos], axis=-1).astype(x.dtype)


def attend(q, k, v, scale):
    s = jnp.einsum('bhgqd,bhkd->bhgqk', q, k, preferred_element_type=jnp.float32) * scale
    p = jax.nn.softmax(s, axis=-1).astype(v.dtype)
    return jnp.einsum('bhgqk,bhkd->bhgqd', p, v)


def blocked_attend(q, k, v, scale):
    b, h, g, n, d = q.shape
    qb = jnp.moveaxis(q.reshape(b, h, g, n // Q_BLOCK, Q_BLOCK, d), 3, 0)
    ob = lax.map(lambda qi: attend(qi, k, v, scale), qb)
    return jnp.moveaxis(ob, 0, 3).reshape(b, h, g, n, v.shape[-1])


def merge_heads(o):
    b, h, g, n, d = o.shape
    return o.transpose(0, 3, 1, 2, 4).reshape(b, n, h * g * d)


def dwconv(x, w, bias):
    pad = (CONV_W // 2, CONV_W - 1 - CONV_W // 2)
    y = lax.conv_general_dilated(x, w[:, None, :], window_strides=(1,), padding=[pad],
                                 dimension_numbers=('NWC', 'WIO', 'NWC'),
                                 feature_group_count=x.shape[-1])
    return y + bias


def lru_coeffs(xc, wa, ba, wi, bi, lam):
    b, s, _ = xc.shape
    xb = xc.reshape(b, s, LRU_BLOCKS, LRU_BLOCK)
    r = jax.nn.sigmoid(jnp.einsum('bsnc,ncd->bsnd', xb, wa.astype(jnp.float32)).reshape(b, s, -1) + ba)
    i = jax.nn.sigmoid(jnp.einsum('bsnc,ncd->bsnd', xb, wi.astype(jnp.float32)).reshape(b, s, -1) + bi)
    log_a = -LRU_C * r * jax.nn.softplus(-lam.astype(jnp.float32))
    a = jnp.exp(log_a)
    mult = jnp.sqrt(-jnp.expm1(2.0 * log_a))
    return a, mult * i * xc


def linear_scan(a, b, h0, reverse):
    if h0 is not None:
        idx = -1 if reverse else 0
        b = b.at[:, idx].add(a[:, idx] * h0)

    def combine(l, r):
        al, bl = l
        ar, br = r
        return al * ar, ar * bl + br

    _, h = lax.associative_scan(combine, (a, b), reverse=reverse, axis=1)
    return h


def rglru(xr_lat, xr_ctx, conv_w, conv_b, wa, ba, wi, bi, lam, need_ctx):
    xl = dwconv(xr_lat, conv_w, conv_b).astype(jnp.float32)
    xc = dwconv(xr_ctx, conv_w, conv_b).astype(jnp.float32)
    y_lat = jnp.zeros_like(xl)
    y_ctx = jnp.zeros_like(xc) if need_ctx else None
    for d, rev in enumerate((False, True)):
        a_c, b_c = lru_coeffs(xc, wa[d], ba[d], wi[d], bi[d], lam[d])
        h_c = linear_scan(a_c, b_c, None, rev)
        h_final = h_c[:, 0] if rev else h_c[:, -1]
        a_l, b_l = lru_coeffs(xl, wa[d], ba[d], wi[d], bi[d], lam[d])
        y_lat = y_lat + linear_scan(a_l, b_l, h_final, rev)
        if need_ctx:
            y_ctx = y_ctx + h_c
    y_lat = y_lat.astype(xr_lat.dtype)
    return y_lat, (y_ctx.astype(xr_ctx.dtype) if need_ctx else None)


def mla_kv(ckv, kr, g_kv, w_ukv, cos, sin):
    b, n, _ = ckv.shape
    kv = (rms_norm(ckv, g_kv) @ w_ukv).reshape(b, n, MLA_HEADS, MLA_NOPE + MLA_V).transpose(0, 2, 1, 3)
    k_nope, v = kv[..., :MLA_NOPE], kv[..., MLA_NOPE:]
    kr = kr[:, None]
    if cos is not None:
        kr = apply_rope(kr, cos, sin)
    k = jnp.concatenate([k_nope, jnp.broadcast_to(kr, (b, MLA_HEADS, n, MLA_ROPE))], axis=-1)
    return k, v


def mla_q(cq, g_q, w_uq, cos, sin):
    b, n, _ = cq.shape
    q = (rms_norm(cq, g_q) @ w_uq).reshape(b, n, MLA_HEADS, MLA_NOPE + MLA_ROPE).transpose(0, 2, 1, 3)
    qn, qr = q[..., :MLA_NOPE], q[..., MLA_NOPE:]
    if cos is not None:
        qr = apply_rope(qr, cos, sin)
    return jnp.concatenate([qn, qr], axis=-1)[:, :, None]


def gqa_heads(t, n_heads, g, cos, sin):
    b, n, _ = t.shape
    t = t.reshape(b, n, n_heads, GQA_DIM).transpose(0, 2, 1, 3)
    if g is not None:
        t = rms_norm(t, g)
    if cos is not None:
        t = apply_rope(t, cos, sin)
    return t


def merge_branches(y_rnn, y_mla, y_gqa, mg, w_branch, w_out):
    br = jnp.stack([y_rnn, y_mla, y_gqa], axis=-2)
    proj = jnp.einsum('bnkc,kcd->bnkd', br, w_branch)
    gates = jax.nn.sigmoid(mg.reshape(mg.shape[:-1] + (N_BRANCH, D_MODEL)))
    return jnp.sum(gates * proj, axis=-2) @ w_out


def mixer(x, ctx, sh, sc, csh, csc, g_mix, w_in, conv_w, conv_b, lru_wa, lru_ba, lru_wi, lru_bi,
          lru_lambda, mla_gq, mla_wuq, mla_gkv, mla_wukv, gqa_gq, gqa_gk, w_branch, w_out,
          ropes, update_ctx):
    cos_m, sin_m, cos_g, sin_g = ropes
    h = modulate(rms_norm(x, g_mix), sh[:, None], sc[:, None])
    hc = modulate(rms_norm(ctx, g_mix), csh, csc)
    xr, ckv, kr, gk, gv, rg, cq, gq, mg = split_cols(h @ w_in, KV_SIZES + Q_SIZES)
    if update_ctx:
        xr_c, ckv_c, kr_c, gk_c, gv_c, rg_c, cq_c, gq_c, mg_c = split_cols(hc @ w_in, KV_SIZES + Q_SIZES)
    else:
        xr_c, ckv_c, kr_c, gk_c, gv_c = split_cols(hc @ w_in[:, :KV_SIDE], KV_SIZES)

    lru_l, lru_c = rglru(xr, xr_c, conv_w, conv_b, lru_wa, lru_ba, lru_wi, lru_bi, lru_lambda, update_ctx)
    y_rnn = lru_l * jax.nn.gelu(rg)

    k_c, v_c = mla_kv(ckv_c, kr_c, mla_gkv, mla_wukv, None, None)
    k_l, v_l = mla_kv(ckv, kr, mla_gkv, mla_wukv, cos_m, sin_m)
    q_l = mla_q(cq, mla_gq, mla_wuq, cos_m, sin_m)
    y_mla = merge_heads(blocked_attend(q_l, jnp.concatenate([k_c, k_l], axis=2),
                                       jnp.concatenate([v_c, v_l], axis=2), MLA_SCALE))

    b, n, _ = x.shape
    gk_ch = gqa_heads(gk_c, GQA_KV_HEADS, gqa_gk, None, None)
    gv_ch = gqa_heads(gv_c, GQA_KV_HEADS, None, None, None)
    gk_lh = gqa_heads(gk, GQA_KV_HEADS, gqa_gk, cos_g, sin_g)
    gv_lh = gqa_heads(gv, GQA_KV_HEADS, None, None, None)
    gq_lh = gqa_heads(gq, GQA_HEADS, gqa_gq, cos_g, sin_g).reshape(b, GQA_KV_HEADS, GQA_GROUP, n, GQA_DIM)
    y_gqa = merge_heads(blocked_attend(gq_lh, jnp.concatenate([gk_ch, gk_lh], axis=2),
                                       jnp.concatenate([gv_ch, gv_lh], axis=2), GQA_SCALE))

    out = merge_branches(y_rnn, y_mla, y_gqa, mg, w_branch, w_out)
    if not update_ctx:
        return out, None

    nc = ctx.shape[1]
    yc_rnn = lru_c * jax.nn.gelu(rg_c)
    qc = mla_q(cq_c, mla_gq, mla_wuq, None, None)
    yc_mla = merge_heads(attend(qc, k_c, v_c, MLA_SCALE))
    gq_ch = gqa_heads(gq_c, GQA_HEADS, gqa_gq, None, None).reshape(b, GQA_KV_HEADS, GQA_GROUP, nc, GQA_DIM)
    yc_gqa = merge_heads(attend(gq_ch, gk_ch, gv_ch, GQA_SCALE))
    out_c = merge_branches(yc_rnn, yc_mla, yc_gqa, mg_c, w_branch, w_out)
    return out, out_c


def hier_moe(h, wg, bg, we, be, w1, w3, w2):
    b, n, d = h.shape
    t = h.reshape(-1, d)
    glog = (t @ wg + bg).astype(jnp.float32)
    gprob = jax.nn.softmax(glog, axis=-1)
    _, gsel = lax.top_k(glog, 1)
    pg = jnp.take_along_axis(gprob, gsel, axis=-1)
    elog = (t @ we + be).astype(jnp.float32).reshape(-1, N_GROUPS, EXPERTS_PER_GROUP)
    idx = jnp.broadcast_to(gsel[:, :, None], (t.shape[0], 1, EXPERTS_PER_GROUP))
    elog = jnp.take_along_axis(elog, idx, axis=1)[:, 0]
    top_v, top_i = lax.top_k(elog, TOP_K)
    pe = jax.nn.softmax(top_v, axis=-1) * pg
    eidx = gsel * EXPERTS_PER_GROUP + top_i
    comb = jnp.sum(jax.nn.one_hot(eidx, N_EXPERTS, dtype=jnp.float32) * pe[..., None], axis=1).astype(t.dtype)
    out = jnp.zeros_like(t)
    for e in range(N_EXPERTS):
        he = jax.nn.silu(t @ w1[e]) * (t @ w3[e])
        out = out + comb[:, e:e + 1] * (he @ w2[e])
    return out.reshape(b, n, d)


def setup_inputs(seed: int = 0) -> dict:
    key = jax.random.key(seed)
    ks = iter(jax.random.split(key, 40))
    L, D = DEPTH, D_MODEL

    def nrm(shape, scale):
        return jax.random.normal(next(ks), shape, jnp.float32) * scale

    def gain(shape):
        return 1.0 + nrm(shape, 0.02)

    u = jax.random.uniform(next(ks), (L, 2, LRU_WIDTH), jnp.float32, minval=0.9, maxval=0.999)
    s = u ** (1.0 / LRU_C)
    lam = jnp.log(s) - jnp.log1p(-s)
    return {
        "x": nrm((BATCH, SEQ, D), 1.0),
        "c": nrm((BATCH, D), 1.0),
        "ctx": nrm((BATCH, CTX_LEN, D), 1.0),
        "c_ctx": nrm((D,), 1.0),
        "w_mod": nrm((L, D, 6 * D), 0.5 * D ** -0.5),
        "b_mod": nrm((L, 6 * D), 0.01),
        "g_mix": gain((L, D)),
        "g_ffn": gain((L, D)),
        "w_in": nrm((L, D, D_IN), D ** -0.5),
        "conv_w": nrm((L, CONV_W, LRU_WIDTH), CONV_W ** -0.5),
        "conv_b": nrm((L, LRU_WIDTH), 0.01),
        "lru_wa": nrm((L, 2, LRU_BLOCKS, LRU_BLOCK, LRU_BLOCK), LRU_BLOCK ** -0.5),
        "lru_ba": nrm((L, 2, LRU_WIDTH), 0.01),
        "lru_wi": nrm((L, 2, LRU_BLOCKS, LRU_BLOCK, LRU_BLOCK), LRU_BLOCK ** -0.5),
        "lru_bi": nrm((L, 2, LRU_WIDTH), 0.01),
        "lru_lambda": lam,
        "mla_gq": gain((L, MLA_Q_RANK)),
        "mla_wuq": nrm((L, MLA_Q_RANK, MLA_HEADS * (MLA_NOPE + MLA_ROPE)), MLA_Q_RANK ** -0.5),
        "mla_gkv": gain((L, MLA_KV_RANK)),
        "mla_wukv": nrm((L, MLA_KV_RANK, MLA_HEADS * (MLA_NOPE + MLA_V)), MLA_KV_RANK ** -0.5),
        "gqa_gq": gain((L, GQA_DIM)),
        "gqa_gk": gain((L, GQA_DIM)),
        "w_branch": nrm((L, N_BRANCH, BRANCH_W, D), BRANCH_W ** -0.5),
        "w_out": nrm((L, D, D), D ** -0.5),
        "moe_wg": nrm((L, D, N_GROUPS), D ** -0.5),
        "moe_bg": nrm((L, N_GROUPS), 0.01),
        "moe_we": nrm((L, D, N_EXPERTS), D ** -0.5),
        "moe_be": nrm((L, N_EXPERTS), 0.01),
        "moe_w1": nrm((L, N_EXPERTS, D, D_EXPERT), D ** -0.5),
        "moe_w3": nrm((L, N_EXPERTS, D, D_EXPERT), D ** -0.5),
        "moe_w2": nrm((L, N_EXPERTS, D_EXPERT, D), D_EXPERT ** -0.5),
        "g_final": gain((D,)),
    }


def reference(x, c, ctx, c_ctx, w_mod, b_mod, g_mix, g_ffn, w_in, conv_w, conv_b, lru_wa, lru_ba,
              lru_wi, lru_bi, lru_lambda, mla_gq, mla_wuq, mla_gkv, mla_wukv, gqa_gq, gqa_gk,
              w_branch, w_out, moe_wg, moe_bg, moe_we, moe_be, moe_w1, moe_w3, moe_w2, g_final):
    n = x.shape[1]
    nc = ctx.shape[1]
    ropes = rope_tables(n, MLA_ROPE) + rope_tables(n, GQA_DIM)
    for l in range(DEPTH):
        update_ctx = l < DEPTH - 1
        mod = jax.nn.silu(c) @ w_mod[l] + b_mod[l]
        mod_c = jax.nn.silu(c_ctx) @ w_mod[l] + b_mod[l]
        sh_a, sc_a, g_a, sh_f, sc_f, g_f = jnp.split(mod, 6, axis=-1)
        csh_a, csc_a, cg_a, csh_f, csc_f, cg_f = jnp.split(mod_c, 6, axis=-1)
        out, out_c = mixer(x, ctx, sh_a, sc_a, csh_a, csc_a, g_mix[l], w_in[l], conv_w[l], conv_b[l],
                           lru_wa[l], lru_ba[l], lru_wi[l], lru_bi[l], lru_lambda[l], mla_gq[l],
                           mla_wuq[l], mla_gkv[l], mla_wukv[l], gqa_gq[l], gqa_gk[l], w_branch[l],
                           w_out[l], ropes, update_ctx)
        x = x + g_a[:, None] * out
        h = modulate(rms_norm(x, g_ffn[l]), sh_f[:, None], sc_f[:, None])
        if update_ctx:
            ctx = ctx + cg_a * out_c
            hc = modulate(rms_norm(ctx, g_ffn[l]), csh_f, csc_f)
            y = hier_moe(jnp.concatenate([hc, h], axis=1), moe_wg[l], moe_bg[l], moe_we[l], moe_be[l],
                         moe_w1[l], moe_w3[l], moe_w2[l])
            ctx = ctx + cg_f * y[:, :nc]
            x = x + g_f[:, None] * y[:, nc:]
        else:
            x = x + g_f[:, None] * hier_moe(h, moe_wg[l], moe_bg[l], moe_we[l], moe_be[l],
                                            moe_w1[l], moe_w3[l], moe_w2[l])
    return rms_norm(x, g_final)
```

```cpp
#include <hip/hip_runtime.h>
#include <cstdio>
#include <cstdint>

#define LAS __attribute__((address_space(3)))
typedef unsigned short bf16_t;
typedef short bf16x8 __attribute__((ext_vector_type(8)));
typedef float f32x4 __attribute__((ext_vector_type(4)));
typedef float f32x2 __attribute__((ext_vector_type(2)));
typedef float f32x16 __attribute__((ext_vector_type(16)));
typedef unsigned u32x4 __attribute__((ext_vector_type(4)));
typedef unsigned u32x2 __attribute__((ext_vector_type(2)));

#ifndef PHMASK
#define PHMASK 0xFFFFFFFFu
#endif
#define ON(k) ((((unsigned)(PHMASK)) >> (k)) & 1u)
#ifndef ABL
#define ABL 0
#endif
#ifndef DUP
#define DUP -1
#endif
#ifndef DUPN
#define DUPN 3
#endif
#ifndef N_LAUNCH_MODE
#define N_LAUNCH_MODE 1
#endif

constexpr int NB_ = 8, SEQ = 4096, NCTX = 256, DM = 1024, TPB = NCTX + SEQ  , T = NB_ * TPB  , NLAYER = 2;
constexpr int DIN = 5280, NU = 2304;
constexpr int U_XR = 0, U_CKV = 512, U_KR = 640, U_GK = 672, U_GV = 800, U_RG = 928, U_CQ = 1440, U_GQ = 1696, U_MG = 2208;
constexpr int NEXP = 32, DEXP = 256;
constexpr int MAXSLOT = 2 * T + NEXP * 256;
constexpr int NCHUNK = TPB / 64;
constexpr float LOG2E = 1.4426950408889634f;
#define LOG2E_ 1.4426950408889634f
constexpr float QSCALE_G = 0.125f * LOG2E;
constexpr float QSCALE_M = 0.10206207261596575f * LOG2E;

constexpr size_t al256(size_t x) { return (x + 255) & ~(size_t)255; }
constexpr size_t WS_CTL = 0;
constexpr size_t CTL_BYTES = 98304;
constexpr size_t WS_MOD = WS_CTL + CTL_BYTES;
constexpr size_t WS_ROPE = WS_MOD + al256((size_t)2 * 9 * 6144 * 4);
constexpr size_t WS_LRUT = WS_ROPE + (size_t)4096 * 96 * 4;
constexpr size_t WS_WRT = WS_LRUT + 2 * 2 * 512 * 4;
constexpr size_t WS_CARRY = WS_WRT + (size_t)2 * 36 * 1024 * 4;
constexpr size_t WS_SEL = WS_CARRY + (size_t)NB_ * NCHUNK * 2 * 512 * 8;
constexpr size_t WS_LIST = WS_SEL + (size_t)T * 32;
constexpr size_t WS_XSC = WS_LIST + al256((size_t)MAXSLOT * 8 + 2048);
constexpr size_t WS_W = WS_XSC + (size_t)NB_ * NCTX * DM * 4;
constexpr size_t W_IN = 0, W_MG = W_IN + (size_t)NU * 1024 * 2, W_G = W_MG + (size_t)3072 * 1024 * 2, W_UKV = W_G + (size_t)2048 * 512 * 2,
                 W_UQ = W_UKV + (size_t)1024 * 256 * 2, W_BR = W_UQ + (size_t)768 * 256 * 2, W_OUT = W_BR + (size_t)3 * 1024 * 512 * 2,
                 W_13 = W_OUT + (size_t)1024 * 1024 * 2, W_2T = W_13 + (size_t)32 * 512 * 1024 * 2, W_BYTES = W_2T + (size_t)32 * 1024 * 256 * 2;
constexpr size_t WS_H = WS_W + W_BYTES;
constexpr size_t WS_A = WS_H + (size_t)T * 1024 * 2;
constexpr size_t A_BYTES = (size_t)T * NU * 2;
constexpr size_t A_U = 0, A_LAB = 0, A_KM = 0, A_QM = A_KM + (size_t)T * 8 * 64 * 2, A_VMT = A_QM + (size_t)T * 8 * 96 * 2,
                 A_M = 0, A_GT = (size_t)T * 1024 * 2, A_Y2 = 0;
constexpr size_t WS_B = WS_A + A_BYTES;
constexpr size_t B_XC = 0, B_GR = B_XC + (size_t)T * 512 * 2, B_CKVN = B_GR + (size_t)T * 512 * 2, B_CQN = B_CKVN + (size_t)T * 256 * 2,
                 B_QG = B_CQN + (size_t)T * 256 * 2, B_KG = B_QG + (size_t)T * 512 * 2, B_VGT = B_KG + (size_t)T * 128 * 2, B_KR = B_VGT + (size_t)T * 128 * 2,
                 B_BYTES = B_KR + (size_t)T * 32 * 2, B_YM = B_XC, B_YG = B_GR, B_HE = 0;
constexpr size_t WS_C = WS_B + B_BYTES;
constexpr size_t WS_END = WS_C + (size_t)T * 512 * 2;
static_assert(A_VMT + (size_t)T * 8 * 64 * 2 <= A_BYTES, "A overlay");
static_assert(A_GT + (size_t)T * 1024 * 2 <= A_BYTES, "A overlay 2");
static_assert((size_t)T * 2 * 1024 * 2 <= A_BYTES, "A overlay 3");
static_assert((size_t)MAXSLOT * 256 * 2 <= B_BYTES, "B overlay");
static_assert(B_CKVN + (size_t)T * 1024 * 2 <= B_BYTES, "B overlay (M)");
static_assert((size_t)T * 3072 <= A_BYTES, "A overlay (gates)");
static_assert(WS_END <= (size_t)536870912, "workspace");
constexpr int CW_BAR = 0;
constexpr int CW_CNT = 4096;
constexpr int CW_NT = 4096 + 2 * 32 * 64;
constexpr int CW_CMAX = 8448;
constexpr int CW_CMAX2 = CW_CMAX + 2 * 3072;
static_assert((CW_CMAX2 + 2 * 2304) * 4 <= 98304, "control words");

struct Params {
    const float *x, *c, *ctx, *c_ctx, *w_mod, *b_mod, *g_mix, *g_ffn, *w_in, *conv_w, *conv_b, *lru_wa, *lru_ba, *lru_wi, *lru_bi, *lru_lambda,
        *mla_gq, *mla_wuq, *mla_gkv, *mla_wukv, *gqa_gq, *gqa_gk, *w_branch, *w_out, *moe_wg, *moe_bg, *moe_we, *moe_be, *moe_w1, *moe_w3, *moe_w2, *g_final;
    float* out; char* ws; int lo, hi;
};

__device__ __forceinline__ float bf2f(bf16_t b) { return __uint_as_float(((unsigned)b) << 16); }
typedef __bf16 bf16x2_t __attribute__((ext_vector_type(2)));
__device__ __forceinline__ unsigned cvt_pk_bf16(float lo, float hi) { const f32x2 v = {lo, hi}; const bf16x2_t b = __builtin_convertvector(v, bf16x2_t); return __builtin_bit_cast(unsigned, b); }
__device__ __forceinline__ bf16_t f2bf(float f) { return (bf16_t)(cvt_pk_bf16(f, 0.f) & 0xffffu); }
__device__ __forceinline__ float sigmoidf_(float x) { return __builtin_amdgcn_rcpf(1.0f + __builtin_amdgcn_exp2f(-LOG2E_ * x)); }
__device__ __forceinline__ float nexpm1_small(float x) { float q = 1.0f / 720.0f; q = q * x + 1.0f / 120.0f; q = q * x + 1.0f / 24.0f; q = q * x + 1.0f / 6.0f; q = q * x + 0.5f; q = q * x + 1.0f;
    const float big = 1.0f - __builtin_amdgcn_exp2f(x * LOG2E_); return x < -0.25f ? big : -x * q; }
__device__ __forceinline__ float gelu_tanh(float x) { const float u = 0.7978845608028654f * (x + 0.044715f * x * x * x); const float e = __expf(2.0f * u); const float th = 1.0f - 2.0f / (e + 1.0f); return 0.5f * x * (1.0f + th); }
template <int CTRL> __device__ __forceinline__ float dpp_f(float v) { return __builtin_bit_cast(float, __builtin_amdgcn_update_dpp(0, __builtin_bit_cast(int, v), CTRL, 0xF, 0xF, true)); }
__device__ __forceinline__ float red4(float v) { v += dpp_f<0xB1>(v); v += dpp_f<0x4E>(v); return v; }
__device__ __forceinline__ float red8(float v) { v = red4(v); v += dpp_f<0x141>(v); return v; }
__device__ __forceinline__ float red16(float v) { v = red8(v); v += dpp_f<0x140>(v); return v; }
__device__ __forceinline__ float rdl(float v, int l) { return __builtin_bit_cast(float, __builtin_amdgcn_readlane(__builtin_bit_cast(int, v), l)); }
__device__ __forceinline__ float wave_sum(float v) { v = red16(v); return (rdl(v, 0) + rdl(v, 16)) + (rdl(v, 32) + rdl(v, 48)); }
__device__ __forceinline__ f32x4 unpack4(const u32x2 w) { return (f32x4){__uint_as_float(w.x << 16), __uint_as_float(w.x & 0xffff0000u), __uint_as_float(w.y << 16), __uint_as_float(w.y & 0xffff0000u)}; }
__device__ __forceinline__ u32x2 pack4(const f32x4 v) { u32x2 w; w.x = cvt_pk_bf16(v[0], v[1]); w.y = cvt_pk_bf16(v[2], v[3]); return w; }
__device__ __forceinline__ float wave_max_nn(float v) {
    v = fmaxf(v, dpp_f<0xB1>(v)); v = fmaxf(v, dpp_f<0x4E>(v)); v = fmaxf(v, dpp_f<0x141>(v)); v = fmaxf(v, dpp_f<0x140>(v)); return fmaxf(fmaxf(rdl(v, 0), rdl(v, 16)), fmaxf(rdl(v, 32), rdl(v, 48))); }
__device__ __forceinline__ unsigned pack_i8x4(float a, float b, float c, float d, float sc) {
    const unsigned t0 = __float_as_uint(__builtin_fmaf(a, sc, 12582912.0f)), t1 = __float_as_uint(__builtin_fmaf(b, sc, 12582912.0f)), t2 = __float_as_uint(__builtin_fmaf(c, sc, 12582912.0f)), t3 = __float_as_uint(__builtin_fmaf(d, sc, 12582912.0f));
    return __builtin_amdgcn_perm(t1, t0, 0x0c0c0400u) | __builtin_amdgcn_perm(t3, t2, 0x04000c0cu); }
__device__ __forceinline__ void unpack8(const u32x4 w, float (&f)[8]) {
    f[0] = __uint_as_float(w.x << 16); f[1] = __uint_as_float(w.x & 0xffff0000u); f[2] = __uint_as_float(w.y << 16); f[3] = __uint_as_float(w.y & 0xffff0000u);
    f[4] = __uint_as_float(w.z << 16); f[5] = __uint_as_float(w.z & 0xffff0000u); f[6] = __uint_as_float(w.w << 16); f[7] = __uint_as_float(w.w & 0xffff0000u);
}
__device__ __forceinline__ u32x4 pack8(const float (&f)[8]) { u32x4 w; w.x = cvt_pk_bf16(f[0], f[1]); w.y = cvt_pk_bf16(f[2], f[3]); w.z = cvt_pk_bf16(f[4], f[5]); w.w = cvt_pk_bf16(f[6], f[7]); return w; }
#define BUF_RSRC(p) __builtin_amdgcn_make_buffer_rsrc((void*)(p), 0, 0x7fffffff, 0x00020000)
__device__ __forceinline__ float* resid_row(float* out, char* ws, int t) {
    const int b = t / TPB, n = t - b * TPB;
    return n < NCTX ? (float*)(ws + WS_XSC) + ((size_t)b * NCTX + n) * DM : out + ((size_t)b * SEQ + (n - NCTX)) * DM;
}

#define XB_TMO      128
#define XB_XCNT(j)  (256  + 64 * (j))
#define XB_XSUB(j)  (1280 + 64 * (j))
#define XB_XGEN(j)  (2304 + 64 * (j))
#define XB_TOP      3328
#define XB_TOPGEN   3392
#define XCD_BAR_WORDS 3456
#define XB_SPIN_CAP (1u << 18)
__device__ __forceinline__ unsigned xb_ld(unsigned* p)              { return __hip_atomic_load(p, __ATOMIC_RELAXED, __HIP_MEMORY_SCOPE_AGENT); }
__device__ __forceinline__ unsigned xb_add(unsigned* p, unsigned v) { return __hip_atomic_fetch_add(p, v, __ATOMIC_RELAXED, __HIP_MEMORY_SCOPE_AGENT); }
__device__ __forceinline__ unsigned xb_xcc_id() { return (unsigned)__builtin_amdgcn_s_getreg((3 << 11) | 20) & 0xFu; }
#define XB_SPIN(cond, bar) do { unsigned _sp = 0; while (cond) { __builtin_amdgcn_s_sleep(1); \
    if ((++_sp & 255u) == 0u) { if (xb_ld(&(bar)[XB_TMO])) break; if (_sp > XB_SPIN_CAP) { atomicAdd(&(bar)[XB_TMO], 1u); break; } } } } while (0)
struct XcdBarrier { unsigned* bar; unsigned x; volatile LAS unsigned* st; };
__device__ __forceinline__ XcdBarrier xcd_barrier_post(unsigned* bar, volatile LAS unsigned* st) {
    XcdBarrier b; b.bar = bar; b.x = xb_xcc_id(); b.st = st;
    if (threadIdx.x == 0) (void)xb_add(&bar[XB_XCNT(b.x)], 1u);
    return b;
}
__device__ __forceinline__ void xcd_barrier_complete(unsigned* bar, unsigned x, unsigned& nloc, unsigned& nx) {
    const unsigned G = gridDim.x * gridDim.y * gridDim.z;
    unsigned sum, cnt, mine, sp = 0u;
    for (;;) {
        sum = 0u; cnt = 0u; mine = 0u;
#pragma unroll
        for (unsigned j = 0; j < 16; ++j) { const unsigned c = xb_ld(&bar[XB_XCNT(j)]); sum += c; cnt += (c > 0u) ? 1u : 0u; mine = (j == x) ? c : mine; }
        if (sum == G) break;
        __builtin_amdgcn_s_sleep(1);
        if ((++sp & 255u) == 0u) { if (xb_ld(&bar[XB_TMO])) break; if (sp > XB_SPIN_CAP) { atomicAdd(&bar[XB_TMO], 1u); break; } }
    }
    nloc = mine > 0u ? mine : 1u; nx = cnt > 0u ? cnt : 1u;
}
__device__ __forceinline__ void xcd_barrier(const XcdBarrier& b) {
    asm volatile("s_waitcnt vmcnt(0)" ::: "memory");
    __syncthreads();
    if (threadIdx.x == 0) {
        unsigned* bar = b.bar;
        __builtin_amdgcn_s_waitcnt(0);
        unsigned nloc = b.st[0], nx = b.st[1];
        if (nloc == 0u) { xcd_barrier_complete(bar, b.x, nloc, nx); b.st[0] = nloc; b.st[1] = nx; }
        const unsigned old = xb_add(&bar[XB_XSUB(b.x)], 1u);
        const unsigned gen = old / nloc;
        if (old + 1u == (gen + 1u) * nloc) {
            __builtin_amdgcn_fence(__ATOMIC_RELEASE, "agent");
            asm volatile("s_waitcnt vmcnt(0)" ::: "memory");
            const unsigned og = xb_add(&bar[XB_TOP], 1u);
            const unsigned tg = og / nx;
            if (og + 1u == (tg + 1u) * nx) xb_add(&bar[XB_TOPGEN], 1u);
            else XB_SPIN(xb_ld(&bar[XB_TOPGEN]) == tg, bar);
            __builtin_amdgcn_fence(__ATOMIC_ACQUIRE, "agent");
            xb_add(&bar[XB_XGEN(b.x)], 1u);
            asm volatile("s_waitcnt vmcnt(0)" ::: "memory");
        } else {
            XB_SPIN(xb_ld(&bar[XB_XGEN(b.x)]) == gen, bar);
            __builtin_amdgcn_fence(__ATOMIC_ACQUIRE, "agent");
            asm volatile("s_waitcnt vmcnt(0)" ::: "memory");
        }
    }
    __syncthreads();
}

namespace g8 {
constexpr int BM = 256, BK = 64, HALF = 128, HTB = HALF * BK * 2, STAGE_BYTES = 8 * HTB, NXCD = 8, WGM = 8;
__device__ __forceinline__ int lds_byte(int r, int c) { const int st = (r >> 4) * 2 + (c >> 5), rr = r & 15, cc = c & 31, ob = rr * 64 + cc * 2; return st * 1024 + (ob ^ (((ob >> 9) & 1) << 5)); }
__device__ __forceinline__ void stage_rc(int b, int& R, int& C) { const int st = b / 1024, sb = b % 1024, swz = sb ^ (((sb >> 9) & 1) << 5); R = (st >> 1) * 16 + swz / 64; C = (st & 1) * 32 + (swz % 64) / 2; }
__device__ __forceinline__ int perm32(int rho) { const int n = rho >> 4, i = rho & 15; return 8 * (i >> 2) + 4 * n + (i & 3); }

struct Unit { const char* A; const char* B; const int* gidx; int pitchA, pitchB, nt; int pm, pn, aux; int eidx; size_t bstride; int hmask; };

__device__ __forceinline__ bool deal_unit(int i, int G, int c, int nwg, int& uid, int& hmask) {
    const long L = (long)i * G + c; const int full = (nwg / G) * G, rem = nwg - full;
    if (L < full) { uid = (int)L; hmask = 3; return true; }
    const int j = (int)(L - full);
    if (2 * rem <= G) { if (j >= 2 * rem) return false; uid = full + (j >> 1); hmask = 1 << (j & 1); return true; }
    if (j >= rem) return false; uid = full + j; hmask = 3; return true;
}
__device__ __forceinline__ void tile_of(int wgid, int nM, int nN, int& pm, int& pn) {
    const int nwg = nM * nN;
    { const int q = nwg / NXCD, r = nwg % NXCD, xcd = wgid % NXCD, off = wgid / NXCD; wgid = (xcd < r ? xcd * (q + 1) : r * (q + 1) + (xcd - r) * q) + off; }
    const int nig = WGM * nN, gid = wgid / nig, fm = gid * WGM, gsz = (nM - fm) < WGM ? (nM - fm) : WGM;
    pm = fm + ((wgid % nig) % gsz); pn = (wgid % nig) / gsz;
}
__device__ __forceinline__ bool static_tile(int i, int G, int c, int nM, int nN, int& pm, int& pn, int& hmask) {
    int uid; if (!deal_unit(i, G, c, nM * nN, uid, hmask)) return false;
    tile_of(uid, nM, nN, pm, pn); return true;
}

__device__ __forceinline__ void load_gidx(const Unit& u, int tid, int (&gi)[4]) {
#pragma unroll
    for (int i = 0; i < 2; ++i) { int R, C; stage_rc(tid * 16 + i * 8192, R, C);
#pragma unroll
        for (int h = 0; h < 2; ++h) gi[h * 2 + i] = u.gidx[h * HALF + R]; }
}
template <bool PERM, bool GATHER>
__device__ __forceinline__ void calc_voff(const Unit& u, int tid, unsigned (&vA)[2][2], unsigned (&vB)[2], const int (&gi)[4]) {
#pragma unroll
    for (int i = 0; i < 2; ++i) {
        int R, C; stage_rc(tid * 16 + i * 8192, R, C); const int Rb = PERM ? ((R & ~31) + perm32(R & 31)) : R;
        vB[i] = (unsigned)Rb * (unsigned)u.pitchB + (unsigned)C * 2u;
        if (GATHER) {
#pragma unroll
            for (int h = 0; h < 2; ++h) { int g = gi[h * 2 + i]; asm volatile("" : "+v"(g));        const int rowA = g < 0 ? 0 : (g >> 1); vA[h][i] = (unsigned)rowA * (unsigned)u.pitchA + (unsigned)C * 2u; }
        } else { vA[0][i] = (unsigned)R * (unsigned)u.pitchA + (unsigned)C * 2u; vA[1][i] = vA[0][i]; }
    }
}

template <class E, class = void> struct epi_i8 { static constexpr bool value = false; };
template <class E> struct epi_i8<E, decltype((void)E::I8)> { static constexpr bool value = E::I8; };
typedef int i32x4 __attribute__((ext_vector_type(4)));
template <bool I8> __device__ __forceinline__ f32x4 mma16(const bf16x8 a, const bf16x8 b, const f32x4 c) {
    if constexpr (I8) return __builtin_bit_cast(f32x4, __builtin_amdgcn_mfma_i32_16x16x64_i8(__builtin_bit_cast(i32x4, a), __builtin_bit_cast(i32x4, b), __builtin_bit_cast(i32x4, c), 0, 0, 0));
    else return __builtin_amdgcn_mfma_f32_16x16x32_bf16(a, b, c, 0, 0, 0);
}
template <class Epi, class Sched>
__device__ __forceinline__ void gemm_phase(LAS unsigned char* lds, const Sched& S, const Epi& E) {
    int tid_l = threadIdx.x; asm volatile("" : "+v"(tid_l));
    const int tid = tid_l, wid = __builtin_amdgcn_readfirstlane(tid >> 6), lane = tid & 63, wr = wid >> 2, wc = wid & 3, fr = lane & 15, fq = lane >> 4;
    const unsigned ldsw = (unsigned)wid * 1024u;
    const int aoff = lds_byte(wr * 64 + fr, fq * 8), boff = lds_byte(wc * 32 + fr, fq * 8);
#define G8_SA(b, h) (((b) * 2 + (h)) * HTB)
#define G8_SB(b, h) ((4 + (b) * 2 + (h)) * HTB)
#define G8_STAGE(bufoff, gbase, koff, voff) do { _Pragma("unroll") for (int _i = 0; _i < 2; ++_i) \
        __builtin_amdgcn_global_load_lds((const unsigned*)((const char*)(gbase) + (unsigned)((voff)[_i] + (unsigned)(koff))), (LAS unsigned*)(lds + (bufoff) + ldsw + _i * 8192), 16, 0, 0); } while (0)
#define G8_LDA(dst, b, h) do { _Pragma("unroll") for (int m = 0; m < 4; ++m) _Pragma("unroll") for (int k = 0; k < 2; ++k) dst[m][k] = *(const LAS bf16x8*)(lds + G8_SA(b, h) + aoff + m * 2048 + k * 1024); } while (0)
#define G8_LDB(dst, b, h) do { _Pragma("unroll") for (int n = 0; n < 2; ++n) _Pragma("unroll") for (int k = 0; k < 2; ++k) dst[n][k] = *(const LAS bf16x8*)(lds + G8_SB(b, h) + boff + n * 2048 + k * 1024); } while (0)
#define G8_MMA(ai, bj, At, Bt) do { __builtin_amdgcn_s_setprio(1); _Pragma("unroll") for (int m = 0; m < 4; ++m) _Pragma("unroll") for (int n = 0; n < 2; ++n) _Pragma("unroll") for (int k = 0; k < 2; ++k) \
        acc[ai][bj][m][n] = mma16<epi_i8<Epi>::value>(Bt[n][k], At[m][k], acc[ai][bj][m][n]); __builtin_amdgcn_s_setprio(0); } while (0)
#define G8_WAIT_V(n) asm volatile("s_waitcnt vmcnt(" #n ")" ::: "memory")
#define G8_WAIT_L(n) asm volatile("s_waitcnt lgkmcnt(" #n ")" ::: "memory")
#define G8_BAR __builtin_amdgcn_s_barrier()
#define G8_SCHED __builtin_amdgcn_sched_barrier(0)
    Unit cur, nxt; int ui = 0;
    if (!S.next(0, cur)) return;
    f32x4 acc[2][2][4][2];
#pragma unroll
    for (int a = 0; a < 2; ++a)
#pragma unroll
        for (int b = 0; b < 2; ++b)
#pragma unroll
            for (int m = 0; m < 4; ++m)
#pragma unroll
                for (int n = 0; n < 2; ++n) acc[a][b][m][n] = (f32x4){0.f, 0.f, 0.f, 0.f};
    bf16x8 At[4][2], B0[2][2], B1[2][2];
    constexpr bool GA = Sched::GATHER; constexpr int H1 = GA ? 1 : 0;
    unsigned vA[2][2], vB[2];
    { int gi0[4] = {0, 0, 0, 0}; if (GA) load_gidx(cur, tid, gi0); calc_voff<Epi::PERM, GA>(cur, tid, vA, vB, gi0); }
    unsigned hA = GA ? 0u : (unsigned)(HALF * cur.pitchA), hB = (unsigned)(HALF * cur.pitchB);
    const char* cA = cur.A; const char* cB = cur.B + (size_t)cur.eidx * cur.bstride; int nt = cur.nt;
    constexpr unsigned kstep = BK * 2;
    G8_STAGE(G8_SB(0, 0), cB, 0u, vB); G8_STAGE(G8_SB(0, 1), cB, hB, vB); G8_STAGE(G8_SA(0, 0), cA, 0u, vA[0]); G8_STAGE(G8_SA(0, 1), cA, hA, vA[H1]);
    if (wr == 1) G8_BAR;
    G8_WAIT_V(2); G8_BAR;
    G8_STAGE(G8_SB(1, 0), cB, kstep, vB); G8_STAGE(G8_SA(1, 0), cA, kstep, vA[0]); G8_STAGE(G8_SB(1, 1), cB, kstep + hB, vB);
    G8_WAIT_V(6); G8_BAR;
    for (;;) {
        const bool has_next = S.next(ui + 1, nxt);
        int gi[4] = {0, 0, 0, 0};
        if (GA && has_next) load_gidx(nxt, tid, gi);
        const char* nA = has_next ? nxt.A : cA; const char* nB = cB;
        const bool hm0 = (cur.hmask & 1) != 0, hm1 = (cur.hmask & 2) != 0;
        for (int t = 0; t < nt; t += 2) {
            const bool last = (t == nt - 2);
            const unsigned k1 = (unsigned)(t + 1) * kstep, k2 = last ? 0u : (unsigned)(t + 2) * kstep, k3 = k2 + kstep;
            if (last && has_next) { int e = nxt.eidx; asm volatile("" : "+v"(e)); nB = nxt.B + (size_t)__builtin_amdgcn_readfirstlane(e) * nxt.bstride; }
            const char* a2 = last ? nA : cA; const char* b2 = last ? nB : cB;
            G8_LDB(B0, 0, 0); G8_LDB(B1, 0, 1); G8_SCHED; G8_LDA(At, 0, 0); G8_STAGE(G8_SA(1, 1), cA, k1 + hA, vA[H1]);
            if (last && has_next) { calc_voff<Epi::PERM, GA>(nxt, tid, vA, vB, gi); hA = GA ? 0u : (unsigned)(HALF * nxt.pitchA); hB = (unsigned)(HALF * nxt.pitchB); }
            G8_WAIT_V(8); G8_WAIT_L(0); G8_BAR; if (hm0) { G8_MMA(0, 0, At, B0); G8_MMA(0, 1, At, B1); } G8_BAR; G8_SCHED;
            G8_LDA(At, 0, 1); G8_STAGE(G8_SB(0, 0), b2, k2, vB); G8_STAGE(G8_SB(0, 1), b2, k2 + hB, vB); G8_STAGE(G8_SA(0, 0), a2, k2, vA[0]);
            G8_WAIT_V(8); G8_WAIT_L(0); G8_BAR; if (hm1) { G8_MMA(1, 0, At, B0); G8_MMA(1, 1, At, B1); } G8_BAR; G8_SCHED;
            G8_LDB(B0, 1, 0); G8_LDB(B1, 1, 1); G8_SCHED; G8_LDA(At, 1, 0); G8_STAGE(G8_SA(0, 1), a2, k2 + hA, vA[H1]);
            G8_WAIT_V(8); G8_WAIT_L(0); G8_BAR; if (hm0) { G8_MMA(0, 0, At, B0); G8_MMA(0, 1, At, B1); } G8_BAR; G8_SCHED;
            G8_LDA(At, 1, 1); G8_STAGE(G8_SB(1, 0), b2, k3, vB); G8_STAGE(G8_SB(1, 1), b2, k3 + hB, vB); G8_STAGE(G8_SA(1, 0), a2, k3, vA[0]);
            G8_WAIT_V(8); G8_WAIT_L(0); G8_BAR; if (hm1) { G8_MMA(1, 0, At, B0); G8_MMA(1, 1, At, B1); } G8_BAR; G8_SCHED;
        }
        if (wr == 0) G8_BAR;
        G8_SCHED; E(acc, cur, wr, wc, fr, fq); G8_SCHED;
        if (!has_next) break;
        if (!Epi::keeps(cur)) {
#pragma unroll
        for (int a = 0; a < 2; ++a)
#pragma unroll
            for (int b = 0; b < 2; ++b)
#pragma unroll
                for (int m = 0; m < 4; ++m)
#pragma unroll
                    for (int n = 0; n < 2; ++n) acc[a][b][m][n] = (f32x4){0.f, 0.f, 0.f, 0.f};
        }
        cur = nxt; cA = nA; cB = nB; nt = cur.nt; ++ui;
        if (wr == 1) G8_BAR;
    }
    G8_WAIT_V(0);
    G8_BAR;
#undef G8_SA
#undef G8_SB
#undef G8_STAGE
#undef G8_LDA
#undef G8_LDB
#undef G8_MMA
#undef G8_WAIT_V
#undef G8_WAIT_L
#undef G8_BAR
#undef G8_SCHED
}
typedef f32x4 Acc[2][2][4][2];
}
using g8::Unit;

struct SchedDense {
    static constexpr bool GATHER = false;
    const char* A; const char* B; int K, nM, nN, G, c; bool skip;
    __device__ __forceinline__ bool next(int i, Unit& u) const {
        int pm, pn, hm; if (!g8::static_tile(i, G, c, skip ? (nM / 17) * 16 : nM, nN, pm, pn, hm)) return false;
        if (skip) pm = (pm >> 4) * 17 + 1 + (pm & 15);
        u.hmask = hm; u.pitchA = K * 2; u.pitchB = K * 2; u.nt = K / 64; u.pm = pm; u.pn = pn; u.aux = 0; u.gidx = nullptr; u.eidx = 0; u.bstride = 0;
        u.A = A + (size_t)pm * 256 * K * 2; u.B = B + (size_t)pn * 256 * K * 2; return true;
    }
};
struct SchedGate {
    static constexpr bool GATHER = false;
    const char* A; const char* B; int nM, G, c;
    __device__ __forceinline__ bool next(int i, Unit& u) const {
        int pm, pn, hm; if (!g8::static_tile(i, G, c, nM, 8, pm, pn, hm)) return false;
        u.hmask = hm;
        int two = 2; asm volatile("" : "+s"(two));
        u.pitchA = 1024; u.pitchB = 256; u.nt = two; u.pm = pm; u.pn = pn; u.aux = 0; u.gidx = nullptr; u.eidx = 0; u.bstride = 0;
        u.A = A + (size_t)pm * 256 * 1024 + (size_t)(pn >> 1) * 256; u.B = B + (size_t)pn * 256 * 256; return true;
    }
};
struct SchedMerge {
    static constexpr bool GATHER = false;
    const char* wsb; const char* WBR; int nM, G, c; bool skip;
    __device__ __forceinline__ bool next(int i, Unit& u) const {
        const int ti = i / 3, k = i - ti * 3;
        int pm, pn, hm; if (!g8::static_tile(ti, G, c, skip ? (nM / 17) * 16 : nM, 4, pm, pn, hm)) return false;
        u.hmask = hm;
        if (skip) pm = (pm >> 4) * 17 + 1 + (pm & 15);
        u.pm = pm; u.pn = pn; u.aux = k; u.gidx = nullptr; u.eidx = 0; u.bstride = 0;
        u.pitchA = 1024; u.pitchB = 1024; u.nt = 8; { const size_t yo = k == 0 ? WS_C : (k == 1 ? WS_B + B_YM : WS_B + B_YG); u.A = wsb + yo + (size_t)pm * 256 * 1024; } u.B = WBR + ((size_t)k * 1024 + pn * 256) * 1024;
        return true;
    }
};
template <bool GA_> struct SchedMoe {
    static constexpr bool GATHER = GA_;
    const char* A; const char* Bw; const int* list; const LAS int* toffs; int ntiles, nN, K, G, c; size_t strideB;
    __device__ __forceinline__ bool next(int i, Unit& u) const {
        int uid, hm; if (!g8::deal_unit(i, G, c, ntiles * nN, uid, hm)) return false;
        const int tile = uid / nN, pn = uid - tile * nN; u.hmask = hm;
        int e = 0;
#pragma unroll
        for (int st = 16; st >= 1; st >>= 1) if (toffs[e + st] <= tile) e += st;
        u.pm = tile; u.pn = pn; u.aux = 0; u.pitchA = K * 2; u.pitchB = K * 2; u.nt = K / 64; u.eidx = 0; u.bstride = 0;
        u.gidx = GA_ ? list + (size_t)tile * 256 : nullptr; u.A = GA_ ? A : A + (size_t)tile * 256 * K * 2;
        u.B = Bw + (size_t)e * strideB + (size_t)pn * 256 * K * 2; return true;
    }
};

struct EpiBf16Plain {
    static __device__ __forceinline__ bool keeps(const Unit&) { return false; }
    static constexpr bool PERM = true;
    bf16_t* O; int ldc;
    __device__ __forceinline__ void operator()(const g8::Acc& acc, const Unit& u, int wr, int wc, int fr, int fq) const {
        const int row0 = u.pm * 256 + wr * 64 + fr, col0 = u.pn * 256 + wc * 32 + 8 * fq;
#pragma unroll
        for (int ai = 0; ai < 2; ++ai) if ((u.hmask >> ai) & 1)
#pragma unroll
            for (int m = 0; m < 4; ++m) { bf16_t* rowp = O + (size_t)(row0 + ai * 128 + m * 16) * ldc + col0;
#pragma unroll
                for (int bj = 0; bj < 2; ++bj) { const f32x4 v0 = acc[ai][bj][m][0], v1 = acc[ai][bj][m][1];
                    u32x4 w; w.x = cvt_pk_bf16(v0[0], v0[1]); w.y = cvt_pk_bf16(v0[2], v0[3]); w.z = cvt_pk_bf16(v1[0], v1[1]); w.w = cvt_pk_bf16(v1[2], v1[3]);
                    *(u32x4*)(rowp + bj * 128) = w; } }
    }
};
struct EpiBf16I8 {
    static __device__ __forceinline__ bool keeps(const Unit&) { return false; }
    static constexpr bool PERM = true;
    static constexpr bool I8 = true;
    bf16_t* O; int ldc; const float* rs_; const float* cm_;
    __device__ __forceinline__ void operator()(const g8::Acc& acc, const Unit& u, int wr, int wc, int fr, int fq) const {
        asm volatile("" : "+v"(fr), "+v"(fq));
        const int row0 = u.pm * 256 + wr * 64 + fr, col0 = u.pn * 256 + wc * 32 + 8 * fq;
        f32x4 cs[2][2];
#pragma unroll
        for (int bj = 0; bj < 2; ++bj)
#pragma unroll
            for (int h = 0; h < 2; ++h) cs[bj][h] = *(const f32x4*)(cm_ + col0 + bj * 128 + 4 * h) * (1.0f / 127.0f);
        float rsv[2][4];
#pragma unroll
        for (int ai = 0; ai < 2; ++ai)
#pragma unroll
            for (int m = 0; m < 4; ++m) rsv[ai][m] = rs_[row0 + ai * 128 + m * 16];
#pragma unroll
        for (int ai = 0; ai < 2; ++ai) if ((u.hmask >> ai) & 1)
#pragma unroll
            for (int m = 0; m < 4; ++m) { bf16_t* rowp = O + (size_t)(row0 + ai * 128 + m * 16) * ldc + col0; const float rs = rsv[ai][m];
#pragma unroll
                for (int bj = 0; bj < 2; ++bj) { const g8::i32x4 i0 = __builtin_bit_cast(g8::i32x4, acc[ai][bj][m][0]), i1 = __builtin_bit_cast(g8::i32x4, acc[ai][bj][m][1]);
                    const f32x4 v0 = (f32x4){(float)i0[0], (float)i0[1], (float)i0[2], (float)i0[3]} * rs * cs[bj][0], v1 = (f32x4){(float)i1[0], (float)i1[1], (float)i1[2], (float)i1[3]} * rs * cs[bj][1];
                    u32x4 w; w.x = cvt_pk_bf16(v0[0], v0[1]); w.y = cvt_pk_bf16(v0[2], v0[3]); w.z = cvt_pk_bf16(v1[0], v1[1]); w.w = cvt_pk_bf16(v1[2], v1[3]);
                    *(u32x4*)(rowp + bj * 128) = w; } }
    }
};
struct EpiGate {
    static __device__ __forceinline__ bool keeps(const Unit&) { return false; }
    static constexpr bool PERM = false;
    const bf16_t* xc_; bf16_t* lab_; const float* ba; const float* bi; const float* logu;
    __device__ __forceinline__ void operator()(const g8::Acc& acc, const Unit& u, int wr, int wc, int fr_, int fq_) const {
        int fr = fr_, fq = fq_; asm volatile("" : "+v"(fr), "+v"(fq));
        const int row0 = u.pm * 256 + wr * 64 + fr; const int c = u.pn * 64 + wc * 16 + fq * 4;
        const f32x4 baf = *(const f32x4*)(ba + c), bif = *(const f32x4*)(bi + c), bab = *(const f32x4*)(ba + 512 + c), bib = *(const f32x4*)(bi + 512 + c), luf = *(const f32x4*)(logu + c), lub = *(const f32x4*)(logu + 512 + c);
        u32x2 xw[2][4];
#pragma unroll
        for (int ai = 0; ai < 2; ++ai) if ((u.hmask >> ai) & 1)
#pragma unroll
            for (int m = 0; m < 4; ++m) xw[ai][m] = *(const u32x2*)(xc_ + (size_t)(row0 + ai * 128 + m * 16) * 512 + c);
        asm volatile("" ::: "memory");
#pragma unroll
        for (int ai = 0; ai < 2; ++ai) if ((u.hmask >> ai) & 1)
#pragma unroll
            for (int m = 0; m < 4; ++m) {
                const size_t row = (size_t)(row0 + ai * 128 + m * 16);
                const float xc[4] = {__uint_as_float(xw[ai][m].x << 16), __uint_as_float(xw[ai][m].x & 0xffff0000u), __uint_as_float(xw[ai][m].y << 16), __uint_as_float(xw[ai][m].y & 0xffff0000u)};
                unsigned w[8];
#pragma unroll
                for (int i = 0; i < 4; ++i) {
                    const float rf = sigmoidf_(acc[ai][0][m][0][i] + baf[i]), i_f = sigmoidf_(acc[ai][0][m][1][i] + bif[i]), rb = sigmoidf_(acc[ai][1][m][0][i] + bab[i]), ib = sigmoidf_(acc[ai][1][m][1][i] + bib[i]);
                    const float laf = rf * luf[i], lab = rb * lub[i];
                    const float bf_ = __builtin_amdgcn_sqrtf(nexpm1_small(2.0f * laf)) * i_f * xc[i], bb_ = __builtin_amdgcn_sqrtf(nexpm1_small(2.0f * lab)) * ib * xc[i];
                    w[2 * i] = cvt_pk_bf16(laf, bf_); w[2 * i + 1] = cvt_pk_bf16(lab, bb_);
                }
                u32x4* dp = (u32x4*)(lab_ + (row * 512 + c) * 4);
                dp[0] = (u32x4){w[0], w[1], w[2], w[3]}; dp[1] = (u32x4){w[4], w[5], w[6], w[7]};
            }
    }
};
struct EpiUkv {
    static __device__ __forceinline__ bool keeps(const Unit&) { return false; }
    static constexpr bool PERM = false;
    bf16_t* km_; bf16_t* vmt_;
    __device__ __forceinline__ void operator()(const g8::Acc& acc, const Unit& u, int wr, int wc, int fr, int fq) const {
        const int b = u.pm / 17, nb = (u.pm - b * 17) * 256 + wr * 64 + fr;
#pragma unroll
        for (int bj = 0; bj < 2; ++bj) { const int h = u.pn * 2 + bj; const size_t bh = (size_t)b * 8 + h;
#pragma unroll
            for (int n = 0; n < 2; ++n) { const int j = wc * 32 + n * 16 + fq * 4;
#pragma unroll
                for (int ai = 0; ai < 2; ++ai) if ((u.hmask >> ai) & 1)
#pragma unroll
                    for (int m = 0; m < 4; ++m) { const int nn = nb + ai * 128 + m * 16; const f32x4 v = acc[ai][bj][m][n];
                        if (wc < 2) { u32x2 w; w.x = cvt_pk_bf16(v[0], v[1]); w.y = cvt_pk_bf16(v[2], v[3]); *(u32x2*)(km_ + (bh * TPB + nn) * 64 + j) = w; }
                        else {
                            float a0 = v[0], a1 = v[1], a2 = v[2], a3 = v[3];
                            { const bool bq = (fr & 2) != 0; const float s0 = bq ? a0 : a2, s1 = bq ? a1 : a3; const float r0 = dpp_f<0x4E>(s0), r1 = dpp_f<0x4E>(s1); if (bq) { a0 = r0; a1 = r1; } else { a2 = r0; a3 = r1; } }
                            { const bool cq = (fr & 1) != 0; const float s0 = cq ? a0 : a1, s1 = cq ? a2 : a3; const float r0 = dpp_f<0xB1>(s0), r1 = dpp_f<0xB1>(s1); if (cq) { a0 = r0; a2 = r1; } else { a1 = r0; a3 = r1; } }
                            u32x2 w; w.x = cvt_pk_bf16(a0, a1); w.y = cvt_pk_bf16(a2, a3);
                            *(u32x2*)(vmt_ + (bh * 64 + (j - 64) + (fr & 3)) * TPB + (nn & ~3)) = w; } } } }
    }
};
struct EpiUq {
    static __device__ __forceinline__ bool keeps(const Unit&) { return false; }
    static constexpr bool PERM = false;
    bf16_t* qm_; const float* cm_; const float* sm_;
    __device__ __forceinline__ void operator()(const g8::Acc& acc, const Unit& u, int wr, int wc, int fr, int fq) const {
        const int b = u.pm / 17, nb = (u.pm - b * 17) * 256 + wr * 64 + fr; const bool lat = (u.pm - b * 17) != 0;
#pragma unroll
        for (int bj = 0; bj < 2; ++bj) { const int G = (u.pn * 256 + bj * 128 + wc * 32) >> 5, h = G / 3, gg = G - h * 3; const size_t bh = (size_t)b * 8 + h;
#pragma unroll
            for (int ai = 0; ai < 2; ++ai) if ((u.hmask >> ai) & 1)
#pragma unroll
                for (int m = 0; m < 4; ++m) { const int nn = nb + ai * 128 + m * 16; f32x4 v0 = acc[ai][bj][m][0] * QSCALE_M, v1 = acc[ai][bj][m][1] * QSCALE_M;
                    bf16_t* qp = qm_ + (bh * TPB + nn) * 96 + gg * 32 + fq * 4;
                    if (ABL != 5 && gg == 2 && lat) { const f32x4 cs = *(const f32x4*)(cm_ + (size_t)(nn - NCTX) * 16 + fq * 4), sn = *(const f32x4*)(sm_ + (size_t)(nn - NCTX) * 16 + fq * 4);
                        const f32x4 o0 = v0 * cs - v1 * sn, o1 = v0 * sn + v1 * cs; v0 = o0; v1 = o1; }
                    u32x2 w0, w1; w0.x = cvt_pk_bf16(v0[0], v0[1]); w0.y = cvt_pk_bf16(v0[2], v0[3]); w1.x = cvt_pk_bf16(v1[0], v1[1]); w1.y = cvt_pk_bf16(v1[2], v1[3]);
                    *(u32x2*)qp = w0; *(u32x2*)(qp + 16) = w1; } }
    }
};
struct EpiGateU8 {
    static __device__ __forceinline__ bool keeps(const Unit&) { return false; }
    static constexpr bool PERM = true;
    unsigned char* g8_;
    __device__ __forceinline__ void operator()(const g8::Acc& acc, const Unit& u, int wr, int wc, int fr, int fq) const {
        const int row0 = u.pm * 256 + wr * 64 + fr, col0 = u.pn * 256 + wc * 32 + 8 * fq;
#pragma unroll
        for (int ai = 0; ai < 2; ++ai) if ((u.hmask >> ai) & 1)
#pragma unroll
            for (int m = 0; m < 4; ++m)
#pragma unroll
                for (int bj = 0; bj < 2; ++bj) { const f32x4 v0 = acc[ai][bj][m][0], v1 = acc[ai][bj][m][1]; const float f[8] = {v0[0], v0[1], v0[2], v0[3], v1[0], v1[1], v1[2], v1[3]};
                    u32x2 w = {0u, 0u};
#pragma unroll
                    for (int j = 0; j < 4; ++j) { w.x = __builtin_amdgcn_cvt_pk_u8_f32(fmaxf(sigmoidf_(f[j]) * 255.0f, 1.0f), j, w.x); w.y = __builtin_amdgcn_cvt_pk_u8_f32(fmaxf(sigmoidf_(f[4 + j]) * 255.0f, 1.0f), j, w.y); }
                    *(u32x2*)(g8_ + (size_t)(row0 + ai * 128 + m * 16) * 3072 + col0 + bj * 128) = w; }
    }
};
struct EpiGateI8 {
    static __device__ __forceinline__ bool keeps(const Unit&) { return false; }
    static constexpr bool PERM = true;
    static constexpr bool I8 = true;
    unsigned char* g8_; const float* rs_; const float* cm_;
    __device__ __forceinline__ void operator()(const g8::Acc& acc, const Unit& u, int wr, int wc, int fr, int fq) const {
        asm volatile("" : "+v"(fr), "+v"(fq));
        const int row0 = u.pm * 256 + wr * 64 + fr, col0 = u.pn * 256 + wc * 32 + 8 * fq;
        f32x4 cs[2][2];
#pragma unroll
        for (int bj = 0; bj < 2; ++bj)
#pragma unroll
            for (int h = 0; h < 2; ++h) cs[bj][h] = *(const f32x4*)(cm_ + col0 + bj * 128 + 4 * h) * (-LOG2E_ / 127.0f);
        float rsv[2][4];
#pragma unroll
        for (int ai = 0; ai < 2; ++ai)
#pragma unroll
            for (int m = 0; m < 4; ++m) rsv[ai][m] = rs_[row0 + ai * 128 + m * 16];
#pragma unroll
        for (int ai = 0; ai < 2; ++ai) if ((u.hmask >> ai) & 1)
#pragma unroll
            for (int m = 0; m < 4; ++m)
#pragma unroll
                for (int bj = 0; bj < 2; ++bj) { const g8::i32x4 v0 = __builtin_bit_cast(g8::i32x4, acc[ai][bj][m][0]), v1 = __builtin_bit_cast(g8::i32x4, acc[ai][bj][m][1]); const float rs = rsv[ai][m];
                    u32x2 w = {0u, 0u};
#pragma unroll
                    for (int j = 0; j < 4; ++j) {
                        const float s0 = __builtin_amdgcn_rcpf(1.0f + __builtin_amdgcn_exp2f((float)v0[j] * rs * cs[bj][0][j])), s1 = __builtin_amdgcn_rcpf(1.0f + __builtin_amdgcn_exp2f((float)v1[j] * rs * cs[bj][1][j]));
                        w.x = __builtin_amdgcn_cvt_pk_u8_f32(fmaxf(s0 * 255.0f, 1.0f), j, w.x); w.y = __builtin_amdgcn_cvt_pk_u8_f32(fmaxf(s1 * 255.0f, 1.0f), j, w.y); }
                    *(u32x2*)(g8_ + (size_t)(row0 + ai * 128 + m * 16) * 3072 + col0 + bj * 128) = w; }
    }
};
struct EpiMerge {
    static constexpr bool PERM = true;
    static __device__ __forceinline__ bool keeps(const Unit& u) { return u.aux < 2; }
    bf16_t* mb_; const unsigned char* g8_;
    __device__ __forceinline__ void operator()(g8::Acc& acc, const Unit& u, int wr, int wc, int fr_, int fq_) const {
        int fr = fr_, fq = fq_; asm volatile("" : "+v"(fr), "+v"(fq));
        const int row0 = u.pm * 256 + wr * 64 + fr, col0 = u.pn * 256 + wc * 32 + 8 * fq; const int k = u.aux;
        const unsigned char* ga = g8_ + k * 1024 + col0; const unsigned char* gb = g8_ + (k < 2 ? k + 1 : k) * 1024 + col0;
#pragma unroll
        for (int am = 0; am < 4; ++am) {
            const int ai = am >> 1, m0 = (am & 1) * 2;
            if (!((u.hmask >> ai) & 1)) continue;
            u32x2 wa[2][2], wb2[2][2];
#pragma unroll
            for (int mm = 0; mm < 2; ++mm)
#pragma unroll
                for (int bj = 0; bj < 2; ++bj) { const size_t o = (size_t)(row0 + ai * 128 + (m0 + mm) * 16) * 3072 + bj * 128; wa[mm][bj] = *(const u32x2*)(ga + o); wb2[mm][bj] = *(const u32x2*)(gb + o); }
            asm volatile("" ::: "memory");
#pragma unroll
            for (int mm = 0; mm < 2; ++mm)
#pragma unroll
                for (int bj = 0; bj < 2; ++bj) { const int m = m0 + mm;
                    float sc[8];
#pragma unroll
                    for (int j = 0; j < 8; ++j) { const float a = (float)(((j < 4 ? wa[mm][bj].x : wa[mm][bj].y) >> (8 * (j & 3))) & 255u), bq = (float)(((j < 4 ? wb2[mm][bj].x : wb2[mm][bj].y) >> (8 * (j & 3))) & 255u);
                        sc[j] = k == 2 ? a * (1.0f / 255.0f) : a * __builtin_amdgcn_rcpf(bq); }
                    const f32x4 v0 = acc[ai][bj][m][0] * (f32x4){sc[0], sc[1], sc[2], sc[3]}, v1 = acc[ai][bj][m][1] * (f32x4){sc[4], sc[5], sc[6], sc[7]};
                    acc[ai][bj][m][0] = v0; acc[ai][bj][m][1] = v1;
                    if (k == 2) { u32x4 w; w.x = cvt_pk_bf16(v0[0], v0[1]); w.y = cvt_pk_bf16(v0[2], v0[3]); w.z = cvt_pk_bf16(v1[0], v1[1]); w.w = cvt_pk_bf16(v1[2], v1[3]);
                        *(u32x4*)(mb_ + (size_t)(row0 + ai * 128 + m * 16) * 1024 + col0 + bj * 128) = w; }
                }
            asm volatile("" ::: "memory");
        }
    }
};
struct EpiOut {
    static __device__ __forceinline__ bool keeps(const Unit&) { return false; }
    static constexpr bool PERM = false;
    bf16_t* xb_; const float* in_; const float* inc_; const float* mod_;
    __device__ __forceinline__ void operator()(const g8::Acc& acc, const Unit& u, int wr, int wc, int fr, int fq) const {
        const int b = u.pm / 17, pt = u.pm - b * 17; const bool isctx = pt == 0;
        if (ABL == 7 && isctx) return;
        const float* ga = mod_ + (size_t)(isctx ? 8 : b) * 6144 + 2048;
        const int r0 = wr * 64 + fr, col0 = u.pn * 256 + wc * 32 + 4 * fq;
        bf16_t* xrow = xb_ + (size_t)(u.pm * 256 + r0) * DM + col0;
        f32x4 g[2][2];
#pragma unroll
        for (int bj = 0; bj < 2; ++bj)
#pragma unroll
            for (int n = 0; n < 2; ++n) g[bj][n] = *(const f32x4*)(ga + col0 + bj * 128 + n * 16);
#pragma unroll
        for (int ai = 0; ai < 2; ++ai) { if (!((u.hmask >> ai) & 1)) continue;
            f32x4 r[4][2][2];
            if (in_) { const float* rbase = (isctx ? inc_ + (size_t)b * NCTX * DM : in_ + ((size_t)b * SEQ + (size_t)(pt - 1) * 256) * DM) + (size_t)r0 * DM + col0;
#pragma unroll
                for (int m = 0; m < 4; ++m)
#pragma unroll
                    for (int bj = 0; bj < 2; ++bj)
#pragma unroll
                        for (int n = 0; n < 2; ++n) r[m][bj][n] = *(const f32x4*)(rbase + (size_t)(ai * 128 + m * 16) * DM + bj * 128 + n * 16);
            } else { u32x2 q[4][2][2];
#pragma unroll
                for (int m = 0; m < 4; ++m)
#pragma unroll
                    for (int bj = 0; bj < 2; ++bj)
#pragma unroll
                        for (int n = 0; n < 2; ++n) q[m][bj][n] = *(const u32x2*)(xrow + (size_t)(ai * 128 + m * 16) * DM + bj * 128 + n * 16);
                asm volatile("" ::: "memory");
#pragma unroll
                for (int m = 0; m < 4; ++m)
#pragma unroll
                    for (int bj = 0; bj < 2; ++bj)
#pragma unroll
                        for (int n = 0; n < 2; ++n) r[m][bj][n] = unpack4(q[m][bj][n]);
            }
            asm volatile("" ::: "memory");
#pragma unroll
            for (int m = 0; m < 4; ++m)
#pragma unroll
                for (int bj = 0; bj < 2; ++bj)
#pragma unroll
                    for (int n = 0; n < 2; ++n) *(u32x2*)(xrow + (size_t)(ai * 128 + m * 16) * DM + bj * 128 + n * 16) = pack4(r[m][bj][n] + g[bj][n] * acc[ai][bj][m][n]);
            asm volatile("" ::: "memory");
        }
    }
};
struct EpiMoe1 {
    static __device__ __forceinline__ bool keeps(const Unit&) { return false; }
    static constexpr bool PERM = false;
    bf16_t* he_;
    __device__ __forceinline__ void operator()(const g8::Acc& acc, const Unit& u, int wr, int wc, int fr, int fq) const {
        const int row0 = u.pm * 256 + wr * 64 + fr;
#pragma unroll
        for (int bj = 0; bj < 2; ++bj) { const int j0 = u.pn * 128 + bj * 64 + wc * 16 + fq * 4;
#pragma unroll
            for (int ai = 0; ai < 2; ++ai) if ((u.hmask >> ai) & 1)
#pragma unroll
                for (int m = 0; m < 4; ++m) { const f32x4 a = acc[ai][bj][m][0], bb = acc[ai][bj][m][1]; float o[4];
#pragma unroll
                    for (int j = 0; j < 4; ++j) o[j] = a[j] * sigmoidf_(a[j]) * bb[j];
                    u32x2 w; w.x = cvt_pk_bf16(o[0], o[1]); w.y = cvt_pk_bf16(o[2], o[3]);
                    *(u32x2*)(he_ + (size_t)(row0 + ai * 128 + m * 16) * 256 + j0) = w; } }
    }
};
struct EpiMoe2 {
    static __device__ __forceinline__ bool keeps(const Unit&) { return false; }
    static constexpr bool PERM = true;
    bf16_t* y2_; const int* ltok_; const float* lp_;
    __device__ __forceinline__ void operator()(const g8::Acc& acc, const Unit& u, int wr, int wc, int fr_, int fq_) const {
        int fr = fr_, fq = fq_; asm volatile("" : "+v"(fr), "+v"(fq));
        const int row0 = u.pm * 256 + wr * 64 + fr, col0 = u.pn * 256 + wc * 32 + 8 * fq;
        int tk[2][4]; float pw[2][4];
#pragma unroll
        for (int ai = 0; ai < 2; ++ai) if ((u.hmask >> ai) & 1)
#pragma unroll
            for (int m = 0; m < 4; ++m) { const int slot = row0 + ai * 128 + m * 16; tk[ai][m] = ltok_[slot]; pw[ai][m] = lp_[slot]; }
#pragma unroll
        for (int ai = 0; ai < 2; ++ai) if ((u.hmask >> ai) & 1)
#pragma unroll
            for (int m = 0; m < 4; ++m) {
                if (tk[ai][m] >= 0) { bf16_t* rowp = y2_ + (size_t)tk[ai][m] * 1024 + col0;
                    const float pq = ABL == 3 ? 0.f : pw[ai][m];
#pragma unroll
                    for (int bj = 0; bj < 2; ++bj) { const f32x4 v0 = acc[ai][bj][m][0] * pq, v1 = acc[ai][bj][m][1] * pq;
                        u32x4 w; w.x = cvt_pk_bf16(v0[0], v0[1]); w.y = cvt_pk_bf16(v0[2], v0[3]); w.z = cvt_pk_bf16(v1[0], v1[1]); w.w = cvt_pk_bf16(v1[2], v1[3]);
                        *(u32x4*)(rowp + bj * 128) = w; } } }
    }
};

__device__ __forceinline__ float half_max(float m) { auto rr = __builtin_amdgcn_permlane32_swap(__float_as_uint(m), __float_as_uint(m), false, false); return __builtin_fmaxf(__uint_as_float(rr[0]), __uint_as_float(rr[1])); }
__device__ __forceinline__ float half_sum(float m) { auto rr = __builtin_amdgcn_permlane32_swap(__float_as_uint(m), __float_as_uint(m), false, false); return __uint_as_float(rr[0]) + __uint_as_float(rr[1]); }
__device__ __forceinline__ float max3f(float a, float b, float c) { return __builtin_fmaxf(__builtin_fmaxf(a, b), c); }
__device__ __forceinline__ float max2f(float a, float b) { return __builtin_fmaxf(a, b); }
template <int DQK, int NQ, int NS, bool SAFE>
__device__ __forceinline__ bool attn_unit(
    LAS unsigned char* lds, const bf16_t* Q, const bf16_t* Kn, const bf16_t* Kr, const bf16_t* Vt, int nkeys, bf16_t* O  ) {
    constexpr int KB = 8192, RB_ = (DQK == 96) ? 4096 : 0, VB = 8192, SUB = KB + RB_ + VB, BUF = NS * SUB;
    constexpr int ND = DQK / 16;
    constexpr float THR = 8.0f;
    int tid_l = threadIdx.x; asm volatile("" : "+v"(tid_l));
    const int tid = tid_l, lane = tid & 63, r32 = lane & 31, hi = lane >> 5; const int wid = __builtin_amdgcn_readfirstlane(tid >> 6);
    LAS float* scr = (LAS float*)(lds + 2 * BUF) + wid * 32;
    bf16x8 qf[NQ][ND];
#pragma unroll
    for (int q = 0; q < NQ; ++q) { const bf16_t* qrow = Q + (size_t)((wid * NQ + q) * 32 + r32) * DQK + hi * 8;
#pragma unroll
      for (int d0 = 0; d0 < ND; ++d0) qf[q][d0] = *(const bf16x8*)(qrow + d0 * 16); }
    const int drow = wid * 8 + (lane >> 3), dch = (lane & 7) ^ ((drow >> 1) & 7);
    const unsigned ksrc = (unsigned)(drow * 128 + dch * 16);
    const unsigned vsrc = (unsigned)(drow * (TPB * 2) + dch * 16);
    const int rrow = (wid & 3) * 16 + (lane >> 2), rch = (lane & 3) ^ ((rrow >> 2) & 3);
    const unsigned rsrc = (unsigned)(rrow * 64 + rch * 16);
    const int NT = nkeys / (64 * NS);
    auto dma = [&](int t, int boff) {
#pragma unroll
        for (int u = 0; u < NS; ++u) { const int k0 = (t * NS + u) * 64; LAS unsigned char* sb = lds + boff + u * SUB;
            __builtin_amdgcn_global_load_lds((const unsigned*)((const char*)Kn + (unsigned)(ksrc + (unsigned)k0 * 128u)), (LAS unsigned*)(sb + wid * 1024), 16, 0, 0);
            if (DQK == 96) { if (wid < 4) __builtin_amdgcn_global_load_lds((const unsigned*)((const char*)Kr + (unsigned)(rsrc + (unsigned)k0 * 64u)), (LAS unsigned*)(sb + KB + wid * 1024), 16, 0, 0); }
            __builtin_amdgcn_global_load_lds((const unsigned*)((const char*)Vt + (unsigned)(vsrc + (unsigned)k0 * 2u)), (LAS unsigned*)(sb + KB + RB_ + wid * 1024), 16, 0, 0); }
    };
    dma(0, 0);
    asm volatile("s_waitcnt vmcnt(0)" ::: "memory");
    __syncthreads();
    f32x16 o0[NQ], o1[NQ]; float m_run[NQ], l_run[NQ]; bool zref[NQ];
#pragma unroll
    for (int q = 0; q < NQ; ++q) { o0[q] = f32x16{}; o1[q] = f32x16{}; m_run[q] = 0.f; l_run[q] = 0.f; zref[q] = true; }
    const int ksw = (r32 & 19) | ((r32 & 4) << 1) | ((r32 & 8) >> 1);
    const int kro = ksw * 128, ksx = (ksw >> 1) & 7, rro = ksw * 64, rsx = (ksw >> 2) & 3, vro = r32 * 128, vsx = (r32 >> 1) & 7;
    for (int t = 0; t < NT; ++t) {
        if (t + 1 < NT) dma(t + 1, ((t + 1) & 1) * BUF);
        const LAS unsigned char* bb = lds + (t & 1) * BUF;
#pragma unroll
        for (int u = 0; u < NS; ++u) {
            const LAS unsigned char* kb = bb + u * SUB; const LAS unsigned char* rb = kb + KB; const LAS unsigned char* vb = rb + RB_;
            f32x16 p0[NQ], p1[NQ];
#pragma unroll
            for (int q = 0; q < NQ; ++q) { p0[q] = f32x16{}; p1[q] = f32x16{}; }
            __builtin_amdgcn_s_setprio(1);
#pragma unroll
            for (int d0 = 0; d0 < ND; ++d0) {
                bf16x8 a0, a1;
                if (d0 < 4) { const int off = kro + (((2 * d0 + hi) ^ ksx) << 4); a0 = *(const LAS bf16x8*)(kb + off); a1 = *(const LAS bf16x8*)(kb + 4096 + off); }
                else { const int off = rro + (((2 * (d0 - 4) + hi) ^ rsx) << 4); a0 = *(const LAS bf16x8*)(rb + off); a1 = *(const LAS bf16x8*)(rb + 2048 + off); }
#pragma unroll
                for (int q = 0; q < NQ; ++q) { p0[q] = __builtin_amdgcn_mfma_f32_32x32x16_bf16(a0, qf[q][d0], p0[q], 0, 0, 0); p1[q] = __builtin_amdgcn_mfma_f32_32x32x16_bf16(a1, qf[q][d0], p1[q], 0, 0, 0); }
            }
            __builtin_amdgcn_s_setprio(0);
            bf16x8 pa[NQ][4];
#pragma unroll
            for (int q = 0; q < NQ; ++q) {
                if (ABL == 4) { p0[q] = f32x16{}; p1[q] = f32x16{}; }
                if (SAFE) {
                    float mx = max2f(p0[q][0], p1[q][0]);
#pragma unroll
                    for (int r = 1; r < 16; ++r) mx = max3f(mx, p0[q][r], p1[q][r]);
                    mx = half_max(mx);
                    const bool first = (t == 0 && u == 0);
                    if (first ? __any(__builtin_fabsf(mx) > THR) : __any(mx - m_run[q] > THR)) {
                        const float m_new = first ? mx : max2f(m_run[q], mx); const float alpha = first ? 1.0f : __builtin_amdgcn_exp2f(m_run[q] - m_new);
                        m_run[q] = m_new; l_run[q] *= alpha; zref[q] = false;
                        if (hi == 0) scr[r32] = alpha;
#pragma unroll
                        for (int r = 0; r < 16; ++r) { const float al = scr[(r & 3) + 8 * (r >> 2) + 4 * hi]; o0[q][r] *= al; o1[q][r] *= al; }
                    }
                }
                float ps = 0.f;
                if (!SAFE || zref[q]) {
#pragma unroll
                    for (int r = 0; r < 16; ++r) { p0[q][r] = __builtin_amdgcn_exp2f(p0[q][r]); ps += p0[q][r]; }
#pragma unroll
                    for (int r = 0; r < 16; ++r) { p1[q][r] = __builtin_amdgcn_exp2f(p1[q][r]); ps += p1[q][r]; }
                } else {
                    const float mr = m_run[q];
#pragma unroll
                    for (int r = 0; r < 16; ++r) { p0[q][r] = __builtin_amdgcn_exp2f(p0[q][r] - mr); ps += p0[q][r]; }
#pragma unroll
                    for (int r = 0; r < 16; ++r) { p1[q][r] = __builtin_amdgcn_exp2f(p1[q][r] - mr); ps += p1[q][r]; }
                }
                l_run[q] += ps;
                u32x4 w; const f32x16& a = p0[q]; const f32x16& c = p1[q];
                w.x = cvt_pk_bf16(a[0], a[1]); w.y = cvt_pk_bf16(a[2], a[3]); w.z = cvt_pk_bf16(a[4], a[5]); w.w = cvt_pk_bf16(a[6], a[7]); pa[q][0] = __builtin_bit_cast(bf16x8, w);
                w.x = cvt_pk_bf16(a[8], a[9]); w.y = cvt_pk_bf16(a[10], a[11]); w.z = cvt_pk_bf16(a[12], a[13]); w.w = cvt_pk_bf16(a[14], a[15]); pa[q][1] = __builtin_bit_cast(bf16x8, w);
                w.x = cvt_pk_bf16(c[0], c[1]); w.y = cvt_pk_bf16(c[2], c[3]); w.z = cvt_pk_bf16(c[4], c[5]); w.w = cvt_pk_bf16(c[6], c[7]); pa[q][2] = __builtin_bit_cast(bf16x8, w);
                w.x = cvt_pk_bf16(c[8], c[9]); w.y = cvt_pk_bf16(c[10], c[11]); w.z = cvt_pk_bf16(c[12], c[13]); w.w = cvt_pk_bf16(c[14], c[15]); pa[q][3] = __builtin_bit_cast(bf16x8, w);
            }
#pragma unroll
            for (int s = 0; s < 4; ++s) {
                const int off = vro + (((2 * s + hi) ^ vsx) << 4);
                const bf16x8 v0 = *(const LAS bf16x8*)(vb + off);
                const bf16x8 v1 = *(const LAS bf16x8*)(vb + 4096 + off);
#pragma unroll
                for (int q = 0; q < NQ; ++q) { o0[q] = __builtin_amdgcn_mfma_f32_32x32x16_bf16(pa[q][s], v0, o0[q], 0, 0, 0); o1[q] = __builtin_amdgcn_mfma_f32_32x32x16_bf16(pa[q][s], v1, o1[q], 0, 0, 0); }
            }
            if (NQ > 1) __builtin_amdgcn_sched_barrier(0);
        }
        asm volatile("s_waitcnt vmcnt(0)" ::: "memory");
        __syncthreads();
    }
    bool bad = false;
#pragma unroll
    for (int q = 0; q < NQ; ++q) {
        const float lt = half_sum(l_run[q]);
        bad = bad || !(lt > 7.9e-31f && lt < 1.2e30f);
        if (hi == 0) scr[r32] = 1.0f / lt;
        bf16_t* orow = O + (size_t)((wid * NQ + q) * 32) * 512;
#pragma unroll
        for (int r = 0; r < 16; ++r) { const int qq = (r & 3) + 8 * (r >> 2) + 4 * hi; const float il = scr[qq];
            orow[(size_t)qq * 512 + r32] = f2bf(ABL == 1 ? 0.f : o0[q][r] * il); orow[(size_t)qq * 512 + 32 + r32] = f2bf(ABL == 1 ? 0.f : o1[q][r] * il); }
    }
    __syncthreads();
    return !SAFE && (__any(bad) || ABL == 6);
}
#ifndef ATTN_PRIO
#define ATTN_PRIO 4
#endif
template <int DQK, int NS>
__device__ __forceinline__ bool attn16_unit(LAS unsigned char* lds, const bf16_t* Q, const bf16_t* Kn, const bf16_t* Kr, const bf16_t* Vt, int nkeys, f32x4 (&o)[4][4], f32x4 (&ol)[4]) {
    constexpr int KB = 8192, RB_ = (DQK == 96) ? 4096 : 0, VB = 8192, SUB = KB + RB_ + VB, BUF = NS * SUB;
    constexpr int KS = DQK / 32;
    int tid_l = threadIdx.x; asm volatile("" : "+v"(tid_l));
    const int tid = tid_l, lane = tid & 63, li = lane & 15, g = lane >> 4; const int wid = __builtin_amdgcn_readfirstlane(tid >> 6);
    LAS float* scr = (LAS float*)(lds + 2 * BUF) + wid * 64;
    bf16x8 qf[4][KS];
#pragma unroll
    for (int qt = 0; qt < 4; ++qt) { const bf16_t* qrow = Q + (size_t)(wid * 64 + qt * 16 + li) * DQK + g * 8;
#pragma unroll
        for (int ks = 0; ks < KS; ++ks) qf[qt][ks] = *(const bf16x8*)(qrow + ks * 32); }
    const int drow = wid * 8 + (lane >> 3), dch = (lane & 7) ^ (2 * ((drow >> 1) & 1) + 4 * ((drow >> 3) & 1));
    const unsigned ksrc = (unsigned)(drow * 128 + dch * 16), vsrc = (unsigned)(drow * (TPB * 2) + dch * 16);
    const int rrow = (wid & 3) * 16 + (lane >> 2), rch = (lane & 3) ^ (2 * ((rrow >> 3) & 1));
    const unsigned rsrc = (unsigned)(rrow * 64 + rch * 16);
    const int NT = nkeys / (64 * NS);
    auto dma = [&](int t, int boff) {
#pragma unroll
        for (int u = 0; u < NS; ++u) { const int k0 = (t * NS + u) * 64; LAS unsigned char* sb = lds + boff + u * SUB;
            __builtin_amdgcn_global_load_lds((const unsigned*)((const char*)Kn + (unsigned)(ksrc + (unsigned)k0 * 128u)), (LAS unsigned*)(sb + wid * 1024), 16, 0, 0);
            if (DQK == 96) { if (wid < 4) __builtin_amdgcn_global_load_lds((const unsigned*)((const char*)Kr + (unsigned)(rsrc + (unsigned)k0 * 64u)), (LAS unsigned*)(sb + KB + wid * 1024), 16, 0, 0); }
            __builtin_amdgcn_global_load_lds((const unsigned*)((const char*)Vt + (unsigned)(vsrc + (unsigned)k0 * 2u)), (LAS unsigned*)(sb + KB + RB_ + wid * 1024), 16, 0, 0); }
    };
    dma(0, 0);
    asm volatile("s_waitcnt vmcnt(0)" ::: "memory");
    __syncthreads();
#pragma unroll
    for (int qt = 0; qt < 4; ++qt) { ol[qt] = (f32x4){0.f, 0.f, 0.f, 0.f};
#pragma unroll
        for (int dt = 0; dt < 4; ++dt) o[qt][dt] = (f32x4){0.f, 0.f, 0.f, 0.f}; }
    const bf16x8 ones = {(short)0x3F80, (short)0x3F80, (short)0x3F80, (short)0x3F80, (short)0x3F80, (short)0x3F80, (short)0x3F80, (short)0x3F80};
    const int krow = 8 * (li >> 2) + (li & 3), fk = 2 * ((li >> 1) & 1) + 4 * ((li >> 2) & 1), fr = 2 * ((li >> 2) & 1);
    const int fv = 2 * ((li >> 1) & 1) + 4 * ((li >> 3) & 1);
    for (int t = 0; t < NT; ++t) {
        if (t + 1 < NT) dma(t + 1, ((t + 1) & 1) * BUF);
        const LAS unsigned char* bb = lds + (t & 1) * BUF;
#pragma unroll
        for (int u = 0; u < NS; ++u) {
            const LAS unsigned char* kb = bb + u * SUB; const LAS unsigned char* rb = kb + KB; const LAS unsigned char* vb = rb + RB_;
#pragma unroll
            for (int b32 = 0; b32 < 2; ++b32) {
                f32x4 sT[2][4];
#pragma unroll
                for (int T2 = 0; T2 < 2; ++T2)
#pragma unroll
                    for (int qt = 0; qt < 4; ++qt) sT[T2][qt] = (f32x4){0.f, 0.f, 0.f, 0.f};
                if (ATTN_PRIO) __builtin_amdgcn_s_setprio(ATTN_PRIO == 4 ? 2 : 1);
#pragma unroll
                for (int ks = 0; ks < KS; ++ks) {
                    bf16x8 kf[2];
#pragma unroll
                    for (int T2 = 0; T2 < 2; ++T2) { const int row = 32 * b32 + 4 * T2 + krow;
                        kf[T2] = ks < 2 ? *(const LAS bf16x8*)(kb + row * 128 + (((4 * ks + g) ^ fk) << 4)) : *(const LAS bf16x8*)(rb + row * 64 + ((g ^ fr) << 4)); }
#pragma unroll
                    for (int T2 = 0; T2 < 2; ++T2)
#pragma unroll
                        for (int qt = 0; qt < 4; ++qt) sT[T2][qt] = __builtin_amdgcn_mfma_f32_16x16x32_bf16(kf[T2], qf[qt][ks], sT[T2][qt], 0, 0, 0);
                }
                if (ATTN_PRIO && ATTN_PRIO != 3) __builtin_amdgcn_s_setprio(ATTN_PRIO == 4 ? 1 : 0);
                bf16x8 pf[4];
#pragma unroll
                for (int qt = 0; qt < 4; ++qt) {
                    float e[8];
#pragma unroll
                    for (int j = 0; j < 4; ++j) { e[j] = __builtin_amdgcn_exp2f(ABL == 4 ? 0.f : sT[0][qt][j]); e[4 + j] = __builtin_amdgcn_exp2f(ABL == 4 ? 0.f : sT[1][qt][j]); }
                    u32x4 w; w.x = cvt_pk_bf16(e[0], e[1]); w.y = cvt_pk_bf16(e[2], e[3]); w.z = cvt_pk_bf16(e[4], e[5]); w.w = cvt_pk_bf16(e[6], e[7]); pf[qt] = __builtin_bit_cast(bf16x8, w);
                }
                bf16x8 vf[4];
#pragma unroll
                for (int dt = 0; dt < 4; ++dt) vf[dt] = *(const LAS bf16x8*)(vb + (16 * dt + li) * 128 + (((4 * b32 + g) ^ fv) << 4));
                if (ATTN_PRIO == 3 || ATTN_PRIO == 4) __builtin_amdgcn_s_setprio(0);
                if (ATTN_PRIO == 2) __builtin_amdgcn_s_setprio(1);
#pragma unroll
                for (int qt = 0; qt < 4; ++qt) {
#pragma unroll
                    for (int dt = 0; dt < 4; ++dt) o[qt][dt] = __builtin_amdgcn_mfma_f32_16x16x32_bf16(pf[qt], vf[dt], o[qt][dt], 0, 0, 0);
                    ol[qt] = __builtin_amdgcn_mfma_f32_16x16x32_bf16(pf[qt], ones, ol[qt], 0, 0, 0); }
                if (ATTN_PRIO == 2) __builtin_amdgcn_s_setprio(0);
                __builtin_amdgcn_sched_barrier(0);
            }
        }
        asm volatile("s_waitcnt vmcnt(0)" ::: "memory");
        __syncthreads();
    }
    bool bad = false;
#pragma unroll
    for (int qt = 0; qt < 4; ++qt)
#pragma unroll
        for (int r = 0; r < 4; ++r) { const float lt = ol[qt][r]; bad = bad || !(lt > 7.9e-31f && lt < 1.2e30f); }
    __syncthreads();
    return __any(bad) || ABL == 6;
}
__device__ __forceinline__ void attn16_store(bf16_t* O, const f32x4 (&o)[4][4], const f32x4 (&ol)[4]) {
    int tid_l = threadIdx.x; asm volatile("" : "+v"(tid_l));
    const int lane = tid_l & 63, li = lane & 15, g = lane >> 4; const int wid = __builtin_amdgcn_readfirstlane(tid_l >> 6);
#pragma unroll
    for (int qt = 0; qt < 4; ++qt)
#pragma unroll
        for (int r = 0; r < 4; ++r) { const float il = 1.0f / ol[qt][r]; bf16_t* orow = O + (size_t)(wid * 64 + qt * 16 + 4 * g + r) * 512 + li;
#pragma unroll
            for (int dt = 0; dt < 4; ++dt) orow[dt * 16] = f2bf(ABL == 1 ? 0.f : o[qt][dt][r] * il); }
}

template <int DQK, int NQ, int NS>
__device__ __forceinline__ void attn_run(LAS unsigned char* lds, const bf16_t* Q, const bf16_t* Kn, const bf16_t* Kr, const bf16_t* Vt, int nkeys, bf16_t* O) {
    f32x4 o16[4][4], ol16[4];
    bool bad;
    if constexpr (NQ == 2) bad = attn16_unit<DQK, NS>(lds, Q, Kn, Kr, Vt, nkeys, o16, ol16); else bad = attn_unit<DQK, NQ, NS, false>(lds, Q, Kn, Kr, Vt, nkeys, O);
    LAS unsigned* flag = (LAS unsigned*)(lds + 160 * 1024 - 64);
    int t_ = threadIdx.x; asm volatile("" : "+v"(t_));
    if (t_ == 0) *flag = 0u;
    __syncthreads();
    if (bad && (t_ & 63) == 0) *flag = 1u;
    __syncthreads();
    const unsigned any_bad = *flag;
    __syncthreads();
    if constexpr (NQ == 2) { if (!any_bad) attn16_store(O, o16, ol16); }
    if (any_bad) {
#pragma unroll
        for (int h = 0; h < NQ; ++h) attn_unit<DQK, 1, NS, true>(lds, Q + (size_t)h * 256 * DQK, Kn, Kr, Vt, nkeys, O + (size_t)h * 256 * 512);
    }
}

template <class F>
__device__ __forceinline__ void cvt_tile(LAS unsigned char* buf, bf16_t* dst, int dst_ld, int tid, F srcp) {
    const int w = tid >> 6, lane = tid & 63;
    f32x4 v[8];
#pragma unroll
    for (int i = 0; i < 8; ++i) { const float* sp = srcp(8 * w + i, lane); v[i] = sp ? *(const f32x4*)sp : (f32x4){0.f, 0.f, 0.f, 0.f}; }
#pragma unroll
    for (int j = 0; j < 4; ++j) { u32x4 o; o.x = cvt_pk_bf16(v[0][j], v[1][j]); o.y = cvt_pk_bf16(v[2][j], v[3][j]); o.z = cvt_pk_bf16(v[4][j], v[5][j]); o.w = cvt_pk_bf16(v[6][j], v[7][j]);
        const int n = 4 * lane + j; *(LAS u32x4*)(buf + n * 128 + ((w ^ (lane & 7)) << 4)) = o; }
    __syncthreads();
#pragma unroll
    for (int i = 0; i < 4; ++i) { const int e = tid + i * 512, n = e >> 3, c = e & 7; const u32x4 o = *(const LAS u32x4*)(buf + n * 128 + ((c ^ ((n >> 2) & 7)) << 4));
        *(u32x4*)(dst + (size_t)n * dst_ld + c * 8) = o; }
}

template <class F>
__device__ __forceinline__ void cvt_tile_i8(LAS unsigned char* buf, unsigned char* dst, int dst_ld, int tid, const float* cmax, F srcp) {
    const int w = tid >> 6, lane = tid & 63;
    f32x4 v[8];
#pragma unroll
    for (int i = 0; i < 8; ++i) { const float* sp = srcp(8 * w + i, lane); v[i] = sp ? *(const f32x4*)sp : (f32x4){0.f, 0.f, 0.f, 0.f}; }
    const f32x4 cm = *(const f32x4*)(cmax + 4 * lane);
#pragma unroll
    for (int j = 0; j < 4; ++j) { const float sc = 127.0f / fmaxf(cm[j], 1e-30f); u32x2 o; o.x = pack_i8x4(v[0][j], v[1][j], v[2][j], v[3][j], sc); o.y = pack_i8x4(v[4][j], v[5][j], v[6][j], v[7][j], sc);
        *(LAS u32x2*)(buf + (4 * lane + j) * 64 + w * 8) = o; }
    __syncthreads();
#pragma unroll
    for (int i = 0; i < 2; ++i) { const int e = tid + i * 512, n = e >> 2, c = e & 3; *(u32x4*)(dst + (size_t)n * dst_ld + c * 16) = *(const LAS u32x4*)(buf + n * 64 + c * 16); }
}

constexpr int LDS_BYTES = 163840;
constexpr int NPH_PRO = 1;
constexpr int NPH_LAYER = 15;
constexpr int PH_FINAL = NPH_PRO + NLAYER * NPH_LAYER;
constexpr int NPHASE = PH_FINAL + 1;

__global__ void __launch_bounds__(512, 2) mega(Params kp) {
    extern __shared__ __attribute__((aligned(16))) unsigned char lds_raw[];
    LAS unsigned char* lds = (LAS unsigned char*)lds_raw;
    const int ph_lo = kp.lo, ph_hi = kp.hi;
    typedef const __attribute__((address_space(4))) Params* KPtr;
#define PHK() int koff_ = 0, Gl_ = gridDim.x, bidl_ = blockIdx.x; asm volatile("" : "+s"(koff_), "+s"(Gl_), "+s"(bidl_)); const int G = Gl_, bid = bidl_; (void)G; (void)bid; const KPtr KP = (KPtr)((const __attribute__((address_space(4))) char*)__builtin_amdgcn_kernarg_segment_ptr() + koff_)
#define LTID() PHK(); int tid_l = threadIdx.x; asm volatile("" : "+v"(tid_l)); const int tid = tid_l, lane = tid & 63; const int wid = __builtin_amdgcn_readfirstlane(tid >> 6); (void)lane; (void)wid
    unsigned* ctl = (unsigned*)(kp.ws + WS_CTL);
    volatile LAS unsigned* xbw = (volatile LAS unsigned*)(lds + LDS_BYTES - 16);
    if (threadIdx.x == 0) { xbw[0] = 0u; xbw[1] = 0u; xbw[2] = 0u; xbw[3] = 0u; }
    __syncthreads();
    XcdBarrier bar = xcd_barrier_post(ctl + CW_BAR, xbw);
#define RUN(id) (ph_lo <= (id) && (id) < ph_hi)
#define SEAM(id) do { if (ph_lo <= (id) && (id) + 1 < ph_hi) { xcd_barrier(bar); if (DUP == 15) xcd_barrier(bar); } } while (0)

#define modv ((float*)(KP->ws + WS_MOD))
#define cosG ((float*)(KP->ws + WS_ROPE))
#define sinG (cosG + 4096 * 32)
#define cosM (cosG + 2 * 4096 * 32)
#define sinM (cosG + 2 * 4096 * 32 + 4096 * 16)
#define lrut ((float*)(KP->ws + WS_LRUT))
#define wrt ((float*)(KP->ws + WS_WRT))
#define carry ((f32x2*)(KP->ws + WS_CARRY))
#define sel ((int*)(KP->ws + WS_SEL))
#define list_tok ((int*)(KP->ws + WS_LIST))
#define list_p ((float*)(KP->ws + WS_LIST + (size_t)MAXSLOT * 4))
#define tile_exp ((int*)(KP->ws + WS_LIST + (size_t)MAXSLOT * 8))
#define xsc ((float*)(KP->ws + WS_XSC))
#define wb (KP->ws + WS_W)
#define Hb ((bf16_t*)KP->out)
#define H8 ((unsigned char*)KP->out + (size_t)T * 1024 * 2)
#define RS8 ((float*)((char*)KP->out + (size_t)T * 1024 * 3))
#define CMAX(l_) ((const float*)(KP->ws + WS_CTL) + CW_CMAX + (l_) * 3072)
#define CMAX2(l_) ((const float*)(KP->ws + WS_CTL) + CW_CMAX2 + (l_) * 2304)
#define XB ((bf16_t*)(KP->ws + WS_H))
#define RA (KP->ws + WS_A)
#define RB (KP->ws + WS_B)
#define Ub ((bf16_t*)(RA + A_U))
#define LAB ((bf16_t*)(RA + A_LAB))
#define KM ((bf16_t*)(RA + A_KM))
#define QM ((bf16_t*)(RA + A_QM))
#define VMt ((bf16_t*)(RA + A_VMT))
#define Mb ((bf16_t*)(RB + B_CKVN))
#define GT ((bf16_t*)(RA + A_GT))
#define Y2 ((bf16_t*)(RA + A_Y2))
#define XC ((bf16_t*)(RB + B_XC))
#define GR ((bf16_t*)(RB + B_GR))
#define CKVN ((bf16_t*)(RB + B_CKVN))
#define CQN ((bf16_t*)(RB + B_CQN))
#define QG ((bf16_t*)(RB + B_QG))
#define KG ((bf16_t*)(RB + B_KG))
#define VGt ((bf16_t*)(RB + B_VGT))
#define KR ((bf16_t*)(RB + B_KR))
#define YM ((bf16_t*)(RB + B_YM))
#define YG ((bf16_t*)(RB + B_YG))
#define HE ((bf16_t*)(RB + B_HE))
#define YR ((bf16_t*)(KP->ws + WS_C))

    for (int rep_ = 0; rep_ < (DUP == 0 ? 1 + DUPN : 1); ++rep_)
    if (ON(0) && RUN(0)) { LTID();
        LAS float* sc_ = (LAS float*)lds;
        LAS float* red = sc_ + 9 * 1024;
        for (int e = tid; e < 9 * 1024; e += 512) { const int r = e >> 10, k = e & 1023; const float v = r < 8 ? KP->c[r * 1024 + k] : KP->c_ctx[k]; sc_[e] = v / (1.0f + __expf(-v)); }
        __syncthreads();
        for (int cb = bid; cb < 256; cb += G) {
            const int colg = cb * 48, l = colg / 6144, n0 = colg - l * 6144;
            const int cs = tid % 48, kg = tid / 48;
            float a[9] = {0.f, 0.f, 0.f, 0.f, 0.f, 0.f, 0.f, 0.f, 0.f};
            if (kg < 10) { const int k0 = kg * 103, k1 = (k0 + 103) < 1024 ? (k0 + 103) : 1024; const float* wp = KP->w_mod + (size_t)l * 1024 * 6144 + n0 + cs;
                for (int k = k0; k < k1; k += 8) { float w[8];
#pragma unroll
                    for (int u = 0; u < 8; ++u) w[u] = (k + u < k1) ? wp[(size_t)(k + u) * 6144] : 0.f;
#pragma unroll
                    for (int u = 0; u < 8; ++u) { const int kk = (k + u < k1) ? k + u : k;
#pragma unroll
                        for (int r = 0; r < 9; ++r) a[r] += sc_[r * 1024 + kk] * w[u]; } }
#pragma unroll
                for (int r = 0; r < 9; ++r) red[(kg * 48 + cs) * 9 + r] = a[r]; }
            __syncthreads();
            if (tid < 48 * 9) { const int c2 = tid / 9, r = tid - c2 * 9; float s = KP->b_mod[l * 6144 + n0 + c2];
                for (int g = 0; g < 10; ++g) s += red[(g * 48 + c2) * 9 + r];
                modv[((size_t)l * 9 + r) * 6144 + n0 + c2] = s; }
            __syncthreads();
        }
        { LAS float* cmx = (LAS float*)lds;
          for (int ti = bid; ti < 2 * 21 * 16; ti += G) { const int l2 = ti / 336, q = ti - l2 * 336, ns = q % 21, ks = q / 21;
              const int n = ns * 256 + 4 * lane, col = n < U_MG ? n : (n < NU ? -1 : n - (NU - U_MG));
              const float* src = KP->w_in + (size_t)l2 * 1024 * DIN + (size_t)(ks * 64 + 8 * wid) * DIN + (col < 0 ? 0 : col);
              f32x4 mx = {0.f, 0.f, 0.f, 0.f};
#pragma unroll
              for (int i = 0; i < 8; ++i) { const f32x4 v = col < 0 ? (f32x4){0.f, 0.f, 0.f, 0.f} : *(const f32x4*)(src + (size_t)i * DIN); mx[0] = fmaxf(mx[0], __builtin_fabsf(v[0])); mx[1] = fmaxf(mx[1], __builtin_fabsf(v[1])); mx[2] = fmaxf(mx[2], __builtin_fabsf(v[2])); mx[3] = fmaxf(mx[3], __builtin_fabsf(v[3])); }
              *(LAS f32x4*)(cmx + wid * 256 + 4 * lane) = mx;
              __syncthreads();
              if (tid < 256) { float m = cmx[tid];
#pragma unroll
                  for (int w = 1; w < 8; ++w) m = fmaxf(m, cmx[w * 256 + tid]);
                  atomicMax((unsigned*)(KP->ws + WS_CTL) + (ns < 9 ? CW_CMAX2 + l2 * 2304 + ns * 256 : CW_CMAX + l2 * 3072 + (ns - 9) * 256) + tid, __float_as_uint(m)); }
              __syncthreads(); } }
        for (int e = bid * 512 + tid; e < 4096 * 48; e += G * 512) {
            const int pos = e / 48, j = e - pos * 48; const float row = (float)(pos >> 6), col = (float)(pos & 63);
            if (j < 32) { const int q = j & 15; const float f = powf(10000.0f, -(float)q / 16.0f); const float ang = (j < 16 ? row : col) * f; float s, c; sincosf(ang, &s, &c); cosG[pos * 32 + j] = c; sinG[pos * 32 + j] = s; }
            else { const int jj = j - 32, q = jj & 7; const float f = powf(10000.0f, -(float)q / 8.0f); const float ang = (jj < 8 ? row : col) * f; float s, c; sincosf(ang, &s, &c); cosM[pos * 16 + jj] = c; sinM[pos * 16 + jj] = s; }
        }
        for (int e = bid * 512 + tid; e < 2 * 2 * 512; e += G * 512) { const float lam = KP->lru_lambda[e]; const float sp = (-lam > 20.f) ? -lam : log1pf(__expf(-lam)); lrut[e] = -8.0f * sp; }
        for (int e = bid * 512 + tid; e < 2 * 36 * 1024; e += G * 512) { const int l = e / (36 * 1024), r = (e / 1024) % 36, k = e & 1023;
            wrt[e] = r < 4 ? KP->moe_wg[((size_t)l * 1024 + k) * 4 + r] : KP->moe_we[((size_t)l * 1024 + k) * 32 + (r - 4)]; }
    }
    SEAM(0);

    for (int l = 0; l < NLAYER; ++l) {
        const int P0 = NPH_PRO + l * NPH_LAYER;
#define modl (modv + (size_t)l * 9 * 6144)
        unsigned* cnt = ctl + CW_CNT + l * 32 * 64;
        if (ON(1) && RUN(P0 + 0)) { LTID();
            for (int rep_ = 0; rep_ < (DUP == 1 ? 1 + DUPN : 1); ++rep_) {
            int par = 0;
            for (int ti = bid; ti < 2060; ti += G, par ^= 1) {
                LAS unsigned char* buf = lds + par * 32768;
                if (ti < 336 && ti % 21 >= 9) { const int ns = ti % 21 - 9, ks = ti / 21; const float* src = KP->w_in + (size_t)l * 1024 * DIN + (size_t)ks * 64 * DIN + U_MG + ns * 256;
                    cvt_tile_i8(buf, (unsigned char*)(wb + W_MG) + (size_t)ns * 256 * 1024 + ks * 64, 1024, tid, CMAX(l) + ns * 256, [=](int kk, int ln) -> const float* { return src + (size_t)kk * DIN + 4 * ln; });
                } else if (ti < 336) { const int ns = ti % 21, ks = ti / 21; const float* src = KP->w_in + (size_t)l * 1024 * DIN + (size_t)ks * 64 * DIN;
                    cvt_tile_i8(buf, (unsigned char*)(wb + W_IN) + (size_t)ns * 256 * 1024 + ks * 64, 1024, tid, CMAX2(l) + ns * 256, [=](int kk, int ln) -> const float* { const int n = ns * 256 + 4 * ln; return n < U_MG ? src + (size_t)kk * DIN + n : nullptr; });
                } else if (ti < 352) { const int q = ti - 336, ns = q & 3, ks = q >> 2; const float* src = KP->mla_wukv + (size_t)l * 128 * 1024 + (size_t)ks * 64 * 1024 + ns * 256;
                    cvt_tile(buf, (bf16_t*)(wb + W_UKV) + (size_t)ns * 256 * 256 + ks * 64, 256, tid, [=](int kk, int ln) -> const float* { return ks < 2 ? src + (size_t)kk * 1024 + 4 * ln : nullptr; });
                } else if (ti < 364) { const int q = ti - 352, ns = q % 3, ks = q / 3; const float* src = KP->mla_wuq + (size_t)l * 256 * 768 + (size_t)ks * 64 * 768 + ns * 256;
                    cvt_tile(buf, (bf16_t*)(wb + W_UQ) + (size_t)ns * 256 * 256 + ks * 64, 256, tid, [=](int kk, int ln) -> const float* { return src + (size_t)kk * 768 + 4 * ln; });
                } else if (ti < 460) { const int q = ti - 364, br = q >> 5, r = q & 31, ns = r & 3, ks = r >> 2; const float* src = KP->w_branch + ((size_t)l * 3 + br) * 512 * 1024 + (size_t)ks * 64 * 1024 + ns * 256;
                    cvt_tile(buf, (bf16_t*)(wb + W_BR) + (size_t)br * 1024 * 512 + (size_t)ns * 256 * 512 + ks * 64, 512, tid, [=](int kk, int ln) -> const float* { return src + (size_t)kk * 1024 + 4 * ln; });
                } else if (ti < 524) { const int q = ti - 460, ns = q & 3, ks = q >> 2; const float* src = KP->w_out + (size_t)l * 1024 * 1024 + (size_t)ks * 64 * 1024 + ns * 256;
                    cvt_tile(buf, (bf16_t*)(wb + W_OUT) + (size_t)ns * 256 * 1024 + ks * 64, 1024, tid, [=](int kk, int ln) -> const float* { return src + (size_t)kk * 1024 + 4 * ln; });
                } else if (ti < 1548) { const int q = ti - 524, e = q >> 5, r = q & 31, ns = r & 1, ks = r >> 1;
                    const float* s1 = KP->moe_w1 + ((size_t)l * NEXP + e) * 1024 * 256 + (size_t)ks * 64 * 256; const float* s3 = KP->moe_w3 + ((size_t)l * NEXP + e) * 1024 * 256 + (size_t)ks * 64 * 256;
                    cvt_tile(buf, (bf16_t*)(wb + W_13) + (size_t)e * 512 * 1024 + (size_t)ns * 256 * 1024 + ks * 64, 1024, tid, [=](int kk, int ln) -> const float* { const int n = ns * 256 + 4 * ln, g = n >> 5, i = n & 31; return (i < 16 ? s1 : s3) + (size_t)kk * 256 + 16 * g + (i & 15); });
                } else { const int q = ti - 1548, e = q >> 4, r = q & 15, ns = r & 3, ks = r >> 2; const float* src = KP->moe_w2 + ((size_t)l * NEXP + e) * 256 * 1024 + (size_t)ks * 64 * 1024 + ns * 256;
                    cvt_tile(buf, (bf16_t*)(wb + W_2T) + (size_t)e * 1024 * 256 + (size_t)ns * 256 * 256 + ks * 64, 256, tid, [=](int kk, int ln) -> const float* { return src + (size_t)kk * 1024 + 4 * ln; });
                }
            }
            __syncthreads();
            for (int e = bid * 512 + tid; e < 8 * 256 * 128; e += G * 512) {
                const int pn = e >> 15, r = (e >> 7) & 255, k = e & 127; const int g = 2 * (r >> 7) + ((r >> 4) & 1), cl = 16 * ((r >> 5) & 3) + (r & 15), dir = g >> 1; float v = 0.f;
                if ((k >> 6) == (pn & 1)) { const float* w = (g & 1) ? KP->lru_wi : KP->lru_wa; v = w[((((size_t)l * 2 + dir) * 8 + pn) * 64 + (k & 63)) * 64 + cl]; }
                ((bf16_t*)(wb + W_G))[e] = f2bf(v);
            }
            }
            for (int rep2_ = 0; rep2_ < ((DUP == 20 && l == 0) ? 2 : 1); ++rep2_) {
            f32x4 gmx[4];
#pragma unroll
            for (int j = 0; j < 4; ++j) gmx[j] = *(const f32x4*)(KP->g_mix + (size_t)l * 1024 + (j * 64 + lane) * 4);
            for (int bb = bid; bb < T / 136; bb += G) {
                f32x4 L_v[4]; u32x2 L_xb[4], L_ya[4], L_yb[4]; f32x4 m_sc[4], m_sh[4], m_gf[4]; int cur_mr = -1;
#pragma unroll
                for (int j = 0; j < 4; ++j) { L_v[j] = (f32x4){0.f, 0.f, 0.f, 0.f}; L_xb[j] = (u32x2){0u, 0u}; L_ya[j] = (u32x2){0u, 0u}; L_yb[j] = (u32x2){0u, 0u}; m_sc[j] = m_sh[j] = m_gf[j] = (f32x4){0.f, 0.f, 0.f, 0.f}; }
#define N1_ISSUE(TT) do { const int t_ = (TT); const int b_ = t_ / TPB, n_ = t_ - b_ * TPB; \
                    if (l == 0) { const float* src_ = n_ < NCTX ? KP->ctx + ((size_t)b_ * NCTX + n_) * DM : KP->x + ((size_t)b_ * SEQ + (n_ - NCTX)) * DM; \
                        _Pragma("unroll") for (int j = 0; j < 4; ++j) L_v[j] = *(const f32x4*)(src_ + (j * 64 + lane) * 4); } \
                    else { const bf16_t* x_ = XB + (size_t)t_ * 1024; const bf16_t* y_ = Y2 + (size_t)t_ * 2048; _Pragma("unroll") for (int j = 0; j < 4; ++j) { L_xb[j] = *(const u32x2*)(x_ + (j * 64 + lane) * 4); L_ya[j] = *(const u32x2*)(y_ + (j * 64 + lane) * 4); L_yb[j] = *(const u32x2*)(y_ + 1024 + (j * 64 + lane) * 4); } } } while (0)
                N1_ISSUE(bb * 136 + wid);
                for (int it = 0; it < 17; ++it) {
                    const int t = bb * 136 + it * 8 + wid; const int b = t / TPB, n = t - b * TPB; const int mr = n < NCTX ? 8 : b;
                    f32x4 v[4]; u32x2 ya[4], yb[4];
#pragma unroll
                    for (int j = 0; j < 4; ++j) { v[j] = l == 0 ? L_v[j] : unpack4(L_xb[j]); ya[j] = L_ya[j]; yb[j] = L_yb[j]; }
                    if (it + 1 < 17) N1_ISSUE(t + 8);
                    if (mr != cur_mr) { cur_mr = mr; const float* sh = modl + (size_t)mr * 6144; const float* gf = modv + ((size_t)(l > 0 ? l - 1 : 0) * 9 + mr) * 6144 + 5120;
#pragma unroll
                        for (int j = 0; j < 4; ++j) { const int col = (j * 64 + lane) * 4; m_sh[j] = *(const f32x4*)(sh + col); m_sc[j] = *(const f32x4*)(sh + 1024 + col) + 1.0f; m_gf[j] = *(const f32x4*)(gf + col); } }
                    __builtin_amdgcn_sched_barrier(0);
                    if (l != 0 && !(ABL == 7 && n < NCTX)) {
#pragma unroll
                        for (int j = 0; j < 4; ++j) { f32x4 xv = v[j]; const f32x4 g = m_gf[j]; const u32x2 a = ya[j], bq = yb[j];
                            xv[0] += g[0] * (__uint_as_float(a.x << 16) + __uint_as_float(bq.x << 16)); xv[1] += g[1] * (__uint_as_float(a.x & 0xffff0000u) + __uint_as_float(bq.x & 0xffff0000u));
                            xv[2] += g[2] * (__uint_as_float(a.y << 16) + __uint_as_float(bq.y << 16)); xv[3] += g[3] * (__uint_as_float(a.y & 0xffff0000u) + __uint_as_float(bq.y & 0xffff0000u));
                            v[j] = xv; } }
                    if (l != 0) {
#pragma unroll
                        for (int j = 0; j < 4; ++j) *(u32x2*)(XB + (size_t)t * 1024 + (j * 64 + lane) * 4) = pack4(v[j]); }
                    float ss = 0.f;
#pragma unroll
                    for (int j = 0; j < 4; ++j) ss += v[j][0] * v[j][0] + v[j][1] * v[j][1] + v[j][2] * v[j][2] + v[j][3] * v[j][3];
                    ss = wave_sum(ss); const float rstd = rsqrtf(ss * (1.0f / 1024.0f) + 1e-6f);
#pragma unroll
                    for (int j = 0; j < 4; ++j) { const int col = (j * 64 + lane) * 4;
                        const f32x4 h = v[j] * rstd * gmx[j] * m_sc[j] + m_sh[j]; v[j] = h; (void)col; }
                    {
                        float am = 0.f;
#pragma unroll
                        for (int j = 0; j < 4; ++j) am = fmaxf(fmaxf(am, fmaxf(__builtin_fabsf(v[j][0]), __builtin_fabsf(v[j][1]))), fmaxf(__builtin_fabsf(v[j][2]), __builtin_fabsf(v[j][3])));
                        am = fmaxf(wave_max_nn(am), 1e-30f); const float sc = 127.0f / am;
#pragma unroll
                        for (int j = 0; j < 4; ++j) *(unsigned*)(H8 + (size_t)t * 1024 + (j * 64 + lane) * 4) = pack_i8x4(v[j][0], v[j][1], v[j][2], v[j][3], sc);
                        if (lane == 0) RS8[t] = am * (1.0f / 127.0f);
                    }
                }
#undef N1_ISSUE
            }
            }
        }
        SEAM(P0 + 0);
        for (int rep_ = 0; rep_ < (DUP == 2 ? 1 + DUPN : 1); ++rep_)
        if (ON(2) && RUN(P0 + 1)) { PHK();
            SchedDense S{(const char*)H8, wb + W_IN, 512, T / 256, NU / 256, G, bid, false}; EpiBf16I8 E{Ub, NU, RS8, CMAX2(l)};
            g8::gemm_phase(lds, S, E);
        }
        SEAM(P0 + 1);
        for (int rep_ = 0; rep_ < (DUP == 3 ? 1 + DUPN : 1); ++rep_)
        if (ON(3) && RUN(P0 + 2)) { LTID();
            f32x4 cwv[4][2]; f32x4 cbv[2];
            { const float* cw = KP->conv_w + (size_t)l * 4 * 512 + lane * 8; const float* cbias = KP->conv_b + (size_t)l * 512 + lane * 8;
#pragma unroll
              for (int k = 0; k < 4; ++k) { cwv[k][0] = *(const f32x4*)(cw + k * 512); cwv[k][1] = *(const f32x4*)(cw + k * 512 + 4); }
              cbv[0] = *(const f32x4*)cbias; cbv[1] = *(const f32x4*)(cbias + 4); }
            const f32x2 gkv2 = *(const f32x2*)(KP->mla_gkv + (size_t)l * 128 + lane * 2);
            const f32x4 gqm4 = *(const f32x4*)(KP->mla_gq + (size_t)l * 256 + lane * 4);
            const int qa = lane & 7, qh = lane >> 3;
            const f32x4 ggqA = *(const f32x4*)(KP->gqa_gq + (size_t)l * 64 + qa * 4), ggqB = *(const f32x4*)(KP->gqa_gq + (size_t)l * 64 + 32 + qa * 4);
            const int ki = lane & 15, kh = (lane >> 4) & 1;
            const f32x2 ggkA = *(const f32x2*)(KP->gqa_gk + (size_t)l * 64 + ki * 2), ggkB = *(const f32x2*)(KP->gqa_gk + (size_t)l * 64 + 32 + ki * 2);
            LAS bf16_t* vst = (LAS bf16_t*)lds;
            constexpr int VSTP = 138;
            for (int bb = bid; bb < T / 136; bb += G) {
            __syncthreads();
            u32x4 L_xr[4], L_rg; unsigned L_ckv, L_gka, L_gkb, L_gv; u32x2 L_cq, L_gqa, L_gqb; bf16_t L_kr1, L_kr2; f32x4 L_qc, L_qs; f32x2 L_kc, L_ks; float L_rc, L_rs;
#define P3_ISSUE(TT) do { const int t_ = (TT); const int b_ = t_ / TPB, n_ = t_ - b_ * TPB; const bool ic_ = n_ < NCTX; const int s0_ = ic_ ? 0 : NCTX, s1_ = ic_ ? NCTX : TPB; \
                const int pp_ = ic_ ? 0 : n_ - NCTX; const bf16_t* ur_ = Ub + (size_t)t_ * NU; \
                _Pragma("unroll") for (int k = 0; k < 4; ++k) { const int nn = n_ + k - 2; L_xr[k] = (nn >= s0_ && nn < s1_) ? *(const u32x4*)(ur_ + (ptrdiff_t)(k - 2) * NU + U_XR + lane * 8) : (u32x4){0u, 0u, 0u, 0u}; } \
                L_rg = *(const u32x4*)(ur_ + U_RG + lane * 8); L_ckv = *(const unsigned*)(ur_ + U_CKV + lane * 2); L_cq = *(const u32x2*)(ur_ + U_CQ + lane * 4); \
                L_kr1 = ur_[U_KR + ki]; L_kr2 = ur_[U_KR + 16 + ki]; L_gka = *(const unsigned*)(ur_ + U_GK + kh * 64 + ki * 2); L_gkb = *(const unsigned*)(ur_ + U_GK + kh * 64 + 32 + ki * 2); \
                L_gv = *(const unsigned*)(ur_ + U_GV + lane * 2); L_gqa = *(const u32x2*)(ur_ + U_GQ + qh * 64 + qa * 4); L_gqb = *(const u32x2*)(ur_ + U_GQ + qh * 64 + 32 + qa * 4); \
                L_qc = *(const f32x4*)(cosG + pp_ * 32 + qa * 4); L_qs = *(const f32x4*)(sinG + pp_ * 32 + qa * 4); L_kc = *(const f32x2*)(cosG + pp_ * 32 + ki * 2); L_ks = *(const f32x2*)(sinG + pp_ * 32 + ki * 2); \
                L_rc = cosM[pp_ * 16 + ki]; L_rs = sinM[pp_ * 16 + ki]; } while (0)
            P3_ISSUE(bb * 136 + wid);
            for (int it = 0; it < 17; ++it) {
                const int tl = it * 8 + wid; const int t = bb * 136 + tl;
                const int b = t / TPB, n = t - b * TPB; const bool isctx = n < NCTX;
                u32x4 xr4[4]; xr4[0] = L_xr[0]; xr4[1] = L_xr[1]; xr4[2] = L_xr[2]; xr4[3] = L_xr[3];
                const u32x4 rg4 = L_rg; const unsigned ckvw = L_ckv, gka = L_gka, gkb = L_gkb, gvw = L_gv; const u32x2 cqw = L_cq, gqa_ = L_gqa, gqb_ = L_gqb; const bf16_t kr1 = L_kr1, kr2 = L_kr2;
                const f32x4 qc = L_qc, qs = L_qs; const f32x2 kc = L_kc, ks = L_ks; const float rc = L_rc, rs_ = L_rs;
                if (it + 1 < 17) P3_ISSUE(t + 8);
                __builtin_amdgcn_sched_barrier(0);
                { f32x4 a0 = cbv[0], a1 = cbv[1];
#pragma unroll
                  for (int k = 0; k < 4; ++k) { float xv[8]; unpack8(xr4[k], xv); a0 += cwv[k][0] * (f32x4){xv[0], xv[1], xv[2], xv[3]}; a1 += cwv[k][1] * (f32x4){xv[4], xv[5], xv[6], xv[7]}; }
                  const float a[8] = {a0[0], a0[1], a0[2], a0[3], a1[0], a1[1], a1[2], a1[3]};
                  *(u32x4*)(XC + (size_t)t * 512 + lane * 8) = pack8(a); }
                { float xv[8]; unpack8(rg4, xv);
#pragma unroll
                  for (int j = 0; j < 8; ++j) xv[j] = gelu_tanh(xv[j]);
                  *(u32x4*)(GR + (size_t)t * 512 + lane * 8) = pack8(xv); }
                { const float x0 = __uint_as_float(ckvw << 16), x1 = __uint_as_float(ckvw & 0xffff0000u);
                  const float ss = wave_sum(x0 * x0 + x1 * x1); const float rs = rsqrtf(ss * (1.0f / 128.0f) + 1e-6f);
                  *(unsigned*)(CKVN + (size_t)t * 256 + lane * 2) = cvt_pk_bf16(x0 * rs * gkv2.x, x1 * rs * gkv2.y);
                  *(unsigned*)(CKVN + (size_t)t * 256 + 128 + lane * 2) = 0u; }
                { const float x0 = __uint_as_float(cqw.x << 16), x1 = __uint_as_float(cqw.x & 0xffff0000u), x2 = __uint_as_float(cqw.y << 16), x3 = __uint_as_float(cqw.y & 0xffff0000u);
                  const float ss = wave_sum(x0 * x0 + x1 * x1 + x2 * x2 + x3 * x3); const float rs = rsqrtf(ss * (1.0f / 256.0f) + 1e-6f);
                  u32x2 o; o.x = cvt_pk_bf16(x0 * rs * gqm4[0], x1 * rs * gqm4[1]); o.y = cvt_pk_bf16(x2 * rs * gqm4[2], x3 * rs * gqm4[3]);
                  *(u32x2*)(CQN + (size_t)t * 256 + lane * 4) = o; }
                { float x1 = bf2f(kr1), x2 = bf2f(kr2);
                  if (ABL != 5 && !isctx) { const float o1 = x1 * rc - x2 * rs_, o2 = x1 * rs_ + x2 * rc; x1 = o1; x2 = o2; }
                  if (lane < 16) { KR[(size_t)t * 32 + lane] = f2bf(x1); KR[(size_t)t * 32 + 16 + lane] = f2bf(x2); } }
                { float a0 = __uint_as_float(gka << 16), a1 = __uint_as_float(gka & 0xffff0000u), b0 = __uint_as_float(gkb << 16), b1 = __uint_as_float(gkb & 0xffff0000u);
                  const float ss = red16(a0 * a0 + a1 * a1 + b0 * b0 + b1 * b1); const float rs = rsqrtf(ss * (1.0f / 64.0f) + 1e-6f);
                  a0 *= rs * ggkA.x; a1 *= rs * ggkA.y; b0 *= rs * ggkB.x; b1 *= rs * ggkB.y;
                  if (ABL != 5 && !isctx) { const float o0 = a0 * kc.x - b0 * ks.x, o1 = a1 * kc.y - b1 * ks.y, o2 = a0 * ks.x + b0 * kc.x, o3 = a1 * ks.y + b1 * kc.y; a0 = o0; a1 = o1; b0 = o2; b1 = o3; }
                  if (lane < 32) { bf16_t* kp = KG + (((size_t)b * 2 + kh) * TPB + n) * 64; *(unsigned*)(kp + ki * 2) = cvt_pk_bf16(a0, a1); *(unsigned*)(kp + 32 + ki * 2) = cvt_pk_bf16(b0, b1); } }
                { vst[(lane * 2) * VSTP + tl] = (bf16_t)(gvw & 0xffffu); vst[(lane * 2 + 1) * VSTP + tl] = (bf16_t)(gvw >> 16); }
                { f32x4 xA = {__uint_as_float(gqa_.x << 16), __uint_as_float(gqa_.x & 0xffff0000u), __uint_as_float(gqa_.y << 16), __uint_as_float(gqa_.y & 0xffff0000u)};
                  f32x4 xB = {__uint_as_float(gqb_.x << 16), __uint_as_float(gqb_.x & 0xffff0000u), __uint_as_float(gqb_.y << 16), __uint_as_float(gqb_.y & 0xffff0000u)};
                  const f32x4 sq = xA * xA + xB * xB; const float ss = red8((sq[0] + sq[1]) + (sq[2] + sq[3])); const float rs = rsqrtf(ss * (1.0f / 64.0f) + 1e-6f);
                  xA = xA * rs * ggqA; xB = xB * rs * ggqB;
                  if (ABL != 5 && !isctx) { const f32x4 oA = xA * qc - xB * qs, oB = xA * qs + xB * qc; xA = oA; xB = oB; }
                  xA = xA * QSCALE_G; xB = xB * QSCALE_G;
                  bf16_t* qp = QG + (((size_t)b * 8 + qh) * TPB + n) * 64; u32x2 oa, ob; oa.x = cvt_pk_bf16(xA[0], xA[1]); oa.y = cvt_pk_bf16(xA[2], xA[3]); ob.x = cvt_pk_bf16(xB[0], xB[1]); ob.y = cvt_pk_bf16(xB[2], xB[3]);
                  *(u32x2*)(qp + qa * 4) = oa; *(u32x2*)(qp + 32 + qa * 4) = ob; }
            }
#undef P3_ISSUE
            __syncthreads();
            { const int b = (bb * 136) / TPB, n0 = bb * 136 - b * TPB;
#pragma unroll 4
              for (int r = 0; r < 16; ++r) { const int row = wid * 16 + r; bf16_t* gp = VGt + (((size_t)b * 2 + (row >> 6)) * 64 + (row & 63)) * TPB + n0;
                  *(unsigned*)(gp + lane * 2) = *(const LAS unsigned*)(vst + row * VSTP + lane * 2);
                  if (lane < 4) *(unsigned*)(gp + 128 + lane * 2) = *(const LAS unsigned*)(vst + row * VSTP + 128 + lane * 2); } }
            }
        }
        SEAM(P0 + 2);
        for (int rep_ = 0; rep_ < (DUP == 4 ? 1 + DUPN : 1); ++rep_)
        if (ON(4) && RUN(P0 + 3)) { PHK();
            SchedGate S{(const char*)XC, wb + W_G, T / 256, G, bid};
            EpiGate E{XC, LAB, KP->lru_ba + (size_t)l * 1024, KP->lru_bi + (size_t)l * 1024, lrut + (size_t)l * 1024};
            g8::gemm_phase(lds, S, E);
        }
        SEAM(P0 + 3);
        for (int rep_ = 0; rep_ < (DUP == 5 ? 1 + DUPN : 1); ++rep_)
        if (ON(5) && RUN(P0 + 4)) { LTID();
            for (int it = bid; it < NB_ * NCHUNK; it += G) {
                const int b = it / NCHUNK, j = it - b * NCHUNK; const int c = tid;
                const char* ub = (const char*)(LAB + ((size_t)b * TPB + (size_t)j * 64) * 2048); const unsigned lo = (unsigned)c * 8u;
                u32x2 w[64];
                { const __amdgpu_buffer_rsrc_t rs = BUF_RSRC(ub);
#pragma unroll
                  for (int s = 0; s < 64; ++s) w[s] = __builtin_amdgcn_raw_buffer_load_b64(rs, lo, s * 4096, 0); }
                __builtin_amdgcn_sched_barrier(0);
                float Pf = 1.f, Hf = 0.f, Pb = 1.f, Hb_ = 0.f;
#pragma unroll
                for (int s = 0; s < 64; ++s) { const float af = __expf(__uint_as_float(w[s].x << 16)); Hf = af * Hf + __uint_as_float(w[s].x & 0xffff0000u); Pf *= af; }
#pragma unroll
                for (int s = 63; s >= 0; --s) { const float ab = __expf(__uint_as_float(w[s].y << 16)); Hb_ = ab * Hb_ + __uint_as_float(w[s].y & 0xffff0000u); Pb *= ab; }
                __builtin_amdgcn_sched_barrier(0);
                carry[(((size_t)b * NCHUNK + j) * 2 + 0) * 512 + c] = (f32x2){Pf, Hf};
                carry[(((size_t)b * NCHUNK + j) * 2 + 1) * 512 + c] = (f32x2){Pb, Hb_};
            }
        }
        SEAM(P0 + 4);
        for (int rep_ = 0; rep_ < (DUP == 6 ? 1 + DUPN : 1); ++rep_)
        if (ON(6) && RUN(P0 + 5)) { LTID();
            for (int it = bid; it < NB_ * NCHUNK; it += G) {
                const int b = it / NCHUNK, j = it - b * NCHUNK; const int c = tid;
                if (l == NLAYER - 1 && j < 4) continue;
                const __amdgpu_buffer_rsrc_t crs = BUF_RSRC(carry + (size_t)b * NCHUNK * 2 * 512); const unsigned clo = (unsigned)c * 8u;
                float cf = 0.f, cbk = 0.f;
                const int pf = j, pb = j < 4 ? 3 - j : 71 - j;
#pragma unroll
                for (int hb = 0; hb < 2; ++hb) {
                    u32x2 vf[34], vb[34];
#pragma unroll
                    for (int q = 0; q < 34; ++q) { const int qq = hb * 34 + q; const int ib = qq < 4 ? 3 - qq : 71 - qq;
                        vf[q] = __builtin_amdgcn_raw_buffer_load_b64(crs, clo, (qq * 2 + 0) * 4096, 0); vb[q] = __builtin_amdgcn_raw_buffer_load_b64(crs, clo, (ib * 2 + 1) * 4096, 0); }
                    __builtin_amdgcn_sched_barrier(0);
#pragma unroll
                    for (int q = 0; q < 34; ++q) { const int qq = hb * 34 + q;
                        if (qq < pf) cf = __uint_as_float(vf[q].x) * cf + __uint_as_float(vf[q].y);
                        if (qq < pb) cbk = __uint_as_float(vb[q].x) * cbk + __uint_as_float(vb[q].y); }
                }
                const size_t t0 = (size_t)b * TPB + (size_t)j * 64;
                const char* ub = (const char*)(LAB + t0 * 2048); const unsigned lo = (unsigned)c * 8u, lo2 = (unsigned)c * 2u;
                const char* gb = (const char*)(GR + t0 * 512); char* yb = (char*)(YR + t0 * 512);
                __builtin_amdgcn_sched_barrier(0);
                u32x2 w[64];
                { const __amdgpu_buffer_rsrc_t rs = BUF_RSRC(ub);
#pragma unroll
                  for (int s = 0; s < 64; ++s) w[s] = __builtin_amdgcn_raw_buffer_load_b64(rs, lo, s * 4096, 0); }
                __builtin_amdgcn_sched_barrier(0);
#pragma unroll
                for (int s = 0; s < 64; ++s) { cf = __expf(__uint_as_float(w[s].x << 16)) * cf + __uint_as_float(w[s].x & 0xffff0000u); w[s].x = __float_as_uint(cf); }
                bf16_t ga[16], gn[16];
#pragma unroll
                for (int s = 0; s < 16; ++s) ga[s] = *(const bf16_t*)(gb + (size_t)(48 + s) * 1024 + lo2);
#pragma unroll
                for (int k = 3; k >= 0; --k) {
                    if (k > 0) {
#pragma unroll
                        for (int s = 0; s < 16; ++s) gn[s] = *(const bf16_t*)(gb + (size_t)((k - 1) * 16 + s) * 1024 + lo2); }
                    __builtin_amdgcn_sched_barrier(0);
#pragma unroll
                    for (int s = 15; s >= 0; --s) { const int ss = k * 16 + s; cbk = __expf(__uint_as_float(w[ss].y << 16)) * cbk + __uint_as_float(w[ss].y & 0xffff0000u);
                        *(bf16_t*)(yb + (size_t)ss * 1024 + lo2) = f2bf(ABL == 2 ? 0.f : (__uint_as_float(w[ss].x) + cbk) * bf2f(ga[s])); }
#pragma unroll
                    for (int s = 0; s < 16; ++s) ga[s] = gn[s];
                }
            }
        }
        SEAM(P0 + 5);
        for (int rep_ = 0; rep_ < (DUP == 7 ? 1 + DUPN : 1); ++rep_)
        if (ON(7) && RUN(P0 + 6)) { PHK();
            { SchedDense S{(const char*)CKVN, wb + W_UKV, 256, T / 256, 4, G, bid, false}; EpiUkv E{KM, VMt}; g8::gemm_phase(lds, S, E); }
            { SchedDense S{(const char*)CQN, wb + W_UQ, 256, T / 256, 3, G, bid, l == NLAYER - 1}; EpiUq E{QM, cosM, sinM}; g8::gemm_phase(lds, S, E); }
        }
        SEAM(P0 + 6);
        for (int rep_ = 0; rep_ < ((DUP == 8 || DUP == 23 || DUP == 24) ? 1 + DUPN : 1); ++rep_)
        if (ON(8) && RUN(P0 + 7)) { LTID();
            const int ng = NB_ * 8 * 8, nm = NB_ * 8 * 8, nall = ng + nm + (l == NLAYER - 1 ? 0 : 2 * NB_ * 8);
            for (int it = (DUP == 24 && rep_) ? ng + bid : bid; it < ((DUP == 23 && rep_) ? ng : (DUP == 24 && rep_) ? ng + nm : nall); it += G) {
                if (it < ng) {
                    int u = it; const int qb = u >> 6; u &= 63; const int h = u & 7, b = u >> 3; const size_t bh = (size_t)b * 8 + h, bk = (size_t)b * 2 + (h >> 2); const size_t n0 = NCTX + (size_t)qb * 512;
                    attn_run<64, 2, 2>(lds, QG + (bh * TPB + n0) * 64, KG + bk * TPB * 64, nullptr, VGt + bk * 64 * TPB, TPB, YG + ((size_t)b * TPB + n0) * 512 + h * 64);
                } else if (it < ng + nm) {
                    int u = it - ng; const int qb = u >> 6; u &= 63; const int h = u & 7, b = u >> 3; const size_t bh = (size_t)b * 8 + h; const size_t n0 = NCTX + (size_t)qb * 512;
                    attn_run<96, 2, 2>(lds, QM + (bh * TPB + n0) * 96, KM + bh * TPB * 64, KR + (size_t)b * TPB * 32, VMt + bh * 64 * TPB, TPB, YM + ((size_t)b * TPB + n0) * 512 + h * 64);
                } else {
                    int u = it - ng - nm; const int kind = u & 1; u >>= 1; const int h = u & 7, b = u >> 3; const size_t bh = (size_t)b * 8 + h;
                    if (kind == 0) attn_run<96, 1, 2>(lds, QM + (bh * TPB) * 96, KM + bh * TPB * 64, KR + (size_t)b * TPB * 32, VMt + bh * 64 * TPB, NCTX, YM + ((size_t)b * TPB) * 512 + h * 64);
                    else { const size_t bk = (size_t)b * 2 + (h >> 2); attn_run<64, 1, 2>(lds, QG + (bh * TPB) * 64, KG + bk * TPB * 64, nullptr, VGt + bk * 64 * TPB, NCTX, YG + ((size_t)b * TPB) * 512 + h * 64); }
                }
            }
        }
        SEAM(P0 + 7);
        for (int rep_ = 0; rep_ < (DUP == 12 ? 1 + DUPN : 1); ++rep_)
        if (ON(15) && RUN(P0 + 8)) { PHK();
            SchedDense S{(const char*)H8, wb + W_MG, 512, T / 256, 12, G, bid, l == NLAYER - 1}; EpiGateI8 E{(unsigned char*)RA, RS8, CMAX(l)};
            g8::gemm_phase(lds, S, E);
        }
        SEAM(P0 + 8);
        for (int rep_ = 0; rep_ < (DUP == 9 ? 1 + DUPN : 1); ++rep_)
        if (ON(9) && RUN(P0 + 9)) { PHK();
            SchedMerge S{(const char*)KP->ws, wb + W_BR, T / 256, G, bid, l == NLAYER - 1};
            EpiMerge E{Mb, (const unsigned char*)RA};
            g8::gemm_phase(lds, S, E);
        }
        SEAM(P0 + 9);
        for (int rep_ = 0; rep_ < (DUP == 10 ? 1 + DUPN : 1); ++rep_)
        if (ON(10) && RUN(P0 + 10)) { PHK();
            SchedDense S{(const char*)Mb, wb + W_OUT, 1024, T / 256, 4, G, bid, l == NLAYER - 1}; EpiOut E{rep_ ? (bf16_t*)RA : XB, l == 0 ? KP->x : (const float*)nullptr, l == 0 ? KP->ctx : (const float*)nullptr, modl};
            g8::gemm_phase(lds, S, E);
        }
        SEAM(P0 + 10);
        for (int rep_ = 0; rep_ < (DUP == 11 ? 1 + DUPN : 1); ++rep_)
        if (ON(11) && RUN(P0 + 11)) { LTID();
            LAS float* wl = (LAS float*)lds;
            { const float* src = wrt + (size_t)l * 36 * 1024; for (int e = tid; e < 36 * 1024 / 4; e += 512) *(LAS f32x4*)(wl + e * 4) = *(const f32x4*)(src + e * 4); }
            __syncthreads();
            const float* bg = KP->moe_bg + l * 4; const float* be = KP->moe_be + l * 32;
            f32x4 gfx_[4];
#pragma unroll
            for (int j = 0; j < 4; ++j) gfx_[j] = *(const f32x4*)(KP->g_ffn + (size_t)l * 1024 + (j * 64 + lane) * 4);
            for (int bb = bid; bb < T / 136; bb += G) {
            u32x2 L_v[4]; f32x4 m_sc[4], m_sh[4]; int cur_mr = -1;
#pragma unroll
            for (int j = 0; j < 4; ++j) m_sc[j] = m_sh[j] = (f32x4){0.f, 0.f, 0.f, 0.f};
#define R_ISSUE(TT) do { const bf16_t* xr_ = XB + (size_t)(TT) * 1024; _Pragma("unroll") for (int j = 0; j < 4; ++j) L_v[j] = *(const u32x2*)(xr_ + (j * 64 + lane) * 4); } while (0)
            R_ISSUE(bb * 136 + wid);
            for (int it = 0; it < 17; ++it) {
                const int t = bb * 136 + it * 8 + wid;
                const int b = t / TPB, n = t - b * TPB; const int mr = n < NCTX ? 8 : b;
                f32x4 v[4];
#pragma unroll
                for (int j = 0; j < 4; ++j) v[j] = unpack4(L_v[j]);
                if (it + 1 < 17) R_ISSUE(t + 8);
                if (mr != cur_mr) { cur_mr = mr; const float* sh = modl + (size_t)mr * 6144 + 3072;
#pragma unroll
                    for (int j = 0; j < 4; ++j) { const int col = (j * 64 + lane) * 4; m_sh[j] = *(const f32x4*)(sh + col); m_sc[j] = *(const f32x4*)(sh + 1024 + col) + 1.0f; } }
                __builtin_amdgcn_sched_barrier(0);
                if (l == NLAYER - 1 && n < NCTX) continue;
                float ss = 0.f;
#pragma unroll
                for (int j = 0; j < 4; ++j) ss += v[j][0] * v[j][0] + v[j][1] * v[j][1] + v[j][2] * v[j][2] + v[j][3] * v[j][3];
                ss = wave_sum(ss); const float rstd = rsqrtf(ss * (1.0f / 1024.0f) + 1e-6f);
#pragma unroll
                for (int j = 0; j < 4; ++j) { const int col = (j * 64 + lane) * 4;
                    v[j] = v[j] * rstd * gfx_[j] * m_sc[j] + m_sh[j]; u32x2 w; w.x = cvt_pk_bf16(v[j][0], v[j][1]); w.y = cvt_pk_bf16(v[j][2], v[j][3]);
                    *(u32x2*)(Hb + (size_t)t * 1024 + col) = w; }
                float gl[4];
#pragma unroll
                for (int g = 0; g < 4; ++g) { float a = 0.f;
#pragma unroll
                    for (int j = 0; j < 4; ++j) { const f32x4 w = *(const LAS f32x4*)(wl + g * 1024 + (j * 64 + lane) * 4); a += v[j][0] * w[0] + v[j][1] * w[1] + v[j][2] * w[2] + v[j][3] * w[3]; }
                    gl[g] = wave_sum(a) + bg[g]; }
                int gs = 0; float gm = gl[0];
#pragma unroll
                for (int g = 1; g < 4; ++g) if (gl[g] > gm) { gm = gl[g]; gs = g; }
                float den = 0.f;
#pragma unroll
                for (int g = 0; g < 4; ++g) den += __expf(gl[g] - gm);
                const float pg = 1.0f / den;
                float el[8];
#pragma unroll
                for (int e = 0; e < 8; ++e) { float a = 0.f; const LAS float* wrow = wl + (4 + gs * 8 + e) * 1024;
#pragma unroll
                    for (int j = 0; j < 4; ++j) { const f32x4 w = *(const LAS f32x4*)(wrow + (j * 64 + lane) * 4); a += v[j][0] * w[0] + v[j][1] * w[1] + v[j][2] * w[2] + v[j][3] * w[3]; }
                    el[e] = wave_sum(a) + be[gs * 8 + e]; }
                int i0 = 0; float v0 = el[0];
#pragma unroll
                for (int e = 1; e < 8; ++e) if (el[e] > v0) { v0 = el[e]; i0 = e; }
                int i1 = -1; float v1 = -INFINITY;
#pragma unroll
                for (int e = 0; e < 8; ++e) if (e != i0 && el[e] > v1) { v1 = el[e]; i1 = e; }
                const float p0 = 1.0f / (1.0f + __expf(v1 - v0)), p1 = 1.0f - p0;
                if (lane == 0 && rep_ == 0) { const int e0 = gs * 8 + i0, e1 = gs * 8 + i1;
                    const unsigned s0 = atomicAdd(cnt + e0 * 64, 1u), s1 = atomicAdd(cnt + e1 * 64, 1u);
                    int* sp = sel + (size_t)t * 8; sp[0] = e0; sp[1] = e1; sp[2] = (int)s0; sp[3] = (int)s1; ((float*)sp)[4] = p0 * pg; ((float*)sp)[5] = p1 * pg; }
            }
#undef R_ISSUE
            }
        }
        SEAM(P0 + 11);
        if (ON(12) && RUN(P0 + 12)) { LTID();
            LAS int* offs = (LAS int*)lds;
            if (tid == 0) { int o = 0; for (int e = 0; e < NEXP; ++e) { offs[e] = o; o += ((int)__hip_atomic_load(cnt + e * 64, __ATOMIC_RELAXED, __HIP_MEMORY_SCOPE_AGENT) + 255) & ~255; } offs[NEXP] = o; }
            __syncthreads();
            for (int t = bid * 512 + tid; t < T; t += G * 512) { const int* sp = sel + (size_t)t * 8;
                if (l == NLAYER - 1 && (t % TPB) < NCTX) continue;
                const int q0 = offs[sp[0]] + sp[2], q1 = offs[sp[1]] + sp[3];
                list_tok[q0] = t * 2; list_p[q0] = ((const float*)sp)[4]; list_tok[q1] = t * 2 + 1; list_p[q1] = ((const float*)sp)[5]; }
            for (int e = bid; e < NEXP; e += G) { const int c0 = offs[e] + (int)__hip_atomic_load(cnt + e * 64, __ATOMIC_RELAXED, __HIP_MEMORY_SCOPE_AGENT), c1 = offs[e + 1];
                for (int q = c0 + tid; q < c1; q += 512) { list_tok[q] = -1; list_p[q] = 0.f; }
                if (tid == 0) tile_exp[e] = offs[e] / 256; }
            if (bid == 0 && tid == 0) { ctl[CW_NT + l * 64] = (unsigned)(offs[NEXP] / 256); tile_exp[NEXP] = offs[NEXP] / 256; }
        }
        SEAM(P0 + 12);
        for (int rep_ = 0; rep_ < (DUP == 13 ? 1 + DUPN : 1); ++rep_)
        if (ON(13) && RUN(P0 + 13)) { PHK();
            const int ntl = (int)__hip_atomic_load(ctl + CW_NT + l * 64, __ATOMIC_RELAXED, __HIP_MEMORY_SCOPE_AGENT);
            LAS int* tofl = (LAS int*)(lds + g8::STAGE_BYTES);
            { int t_ = threadIdx.x; asm volatile("" : "+v"(t_)); if (t_ < 33) tofl[t_] = tile_exp[t_]; }
            __syncthreads();
            SchedMoe<true> S{(const char*)Hb, wb + W_13, list_tok, tofl, ntl, 2, 1024, G, bid, (size_t)512 * 1024 * 2}; EpiMoe1 E{HE};
            g8::gemm_phase(lds, S, E);
        }
        SEAM(P0 + 13);
        for (int rep_ = 0; rep_ < (DUP == 14 ? 1 + DUPN : 1); ++rep_)
        if (ON(14) && RUN(P0 + 14)) { PHK();
            const int ntl = (int)__hip_atomic_load(ctl + CW_NT + l * 64, __ATOMIC_RELAXED, __HIP_MEMORY_SCOPE_AGENT);
            LAS int* tofl = (LAS int*)(lds + g8::STAGE_BYTES);
            { int t_ = threadIdx.x; asm volatile("" : "+v"(t_)); if (t_ < 33) tofl[t_] = tile_exp[t_]; }
            __syncthreads();
            SchedMoe<false> S{(const char*)HE, wb + W_2T, list_tok, tofl, ntl, 4, 256, G, bid, (size_t)1024 * 256 * 2}; EpiMoe2 E{Y2, list_tok, list_p};
            g8::gemm_phase(lds, S, E);
        }
        SEAM(P0 + 14);
    }
    if (ON(16) && RUN(PH_FINAL)) { LTID();
        f32x4 gfin[4];
#pragma unroll
        for (int j = 0; j < 4; ++j) gfin[j] = *(const f32x4*)(KP->g_final + (j * 64 + lane) * 4);
        for (int bb = bid; bb < NB_ * SEQ / 128; bb += G) {
            const int b = (bb * 128) / SEQ; f32x4 gf4[4];
            { const float* gf = modv + ((size_t)(NLAYER - 1) * 9 + b) * 6144 + 5120;
#pragma unroll
              for (int j = 0; j < 4; ++j) gf4[j] = *(const f32x4*)(gf + (j * 64 + lane) * 4); }
            u32x2 L_v[4], L_ya[4], L_yb[4];
#define F_ISSUE(RR) do { const int r_ = (RR); const int n_ = r_ - b * SEQ; const bf16_t* xr_ = XB + (size_t)(b * TPB + NCTX + n_) * 1024; const bf16_t* y_ = Y2 + (size_t)(b * TPB + NCTX + n_) * 2048; \
                _Pragma("unroll") for (int j = 0; j < 4; ++j) { const int col = (j * 64 + lane) * 4; L_v[j] = *(const u32x2*)(xr_ + col); L_ya[j] = *(const u32x2*)(y_ + col); L_yb[j] = *(const u32x2*)(y_ + 1024 + col); } } while (0)
            F_ISSUE(bb * 128 + wid);
            for (int it = 0; it < 16; ++it) {
                const int r = bb * 128 + it * 8 + wid; float* xr = KP->out + (size_t)r * DM;
                f32x4 v[4]; u32x2 ya[4], yb[4];
#pragma unroll
                for (int j = 0; j < 4; ++j) { v[j] = unpack4(L_v[j]); ya[j] = L_ya[j]; yb[j] = L_yb[j]; }
                if (it + 1 < 16) F_ISSUE(r + 8);
                __builtin_amdgcn_sched_barrier(0);
                float ss = 0.f;
#pragma unroll
                for (int j = 0; j < 4; ++j) { f32x4 xv = v[j]; const f32x4 g = gf4[j]; const u32x2 a = ya[j], bq = yb[j];
                    xv[0] += g[0] * (__uint_as_float(a.x << 16) + __uint_as_float(bq.x << 16)); xv[1] += g[1] * (__uint_as_float(a.x & 0xffff0000u) + __uint_as_float(bq.x & 0xffff0000u));
                    xv[2] += g[2] * (__uint_as_float(a.y << 16) + __uint_as_float(bq.y << 16)); xv[3] += g[3] * (__uint_as_float(a.y & 0xffff0000u) + __uint_as_float(bq.y & 0xffff0000u));
                    v[j] = xv; ss += xv[0] * xv[0] + xv[1] * xv[1] + xv[2] * xv[2] + xv[3] * xv[3]; }
                ss = wave_sum(ss); const float rstd = rsqrtf(ss * (1.0f / 1024.0f) + 1e-6f);
#pragma unroll
                for (int j = 0; j < 4; ++j) *(f32x4*)(xr + (j * 64 + lane) * 4) = v[j] * rstd * gfin[j];
            }
#undef F_ISSUE
        }
    }
}

extern "C" void kernel_launch(void* const* d_in, const int* in_sizes, int n_in, void* d_out, int out_size, void* d_ws, size_t ws_size, hipStream_t stream) {
    static int grid = 0;
    if (!grid) {
        if (n_in != 32 || ws_size < WS_END) { fprintf(stderr, "kernel_launch: unexpected inputs (n_in %d, ws %zu, need %zu)\n", n_in, ws_size, (size_t)WS_END); grid = -1; return; }
        int dev = 0, cus = 0, per_cu = 0;
        hipGetDevice(&dev); hipDeviceGetAttribute(&cus, hipDeviceAttributeMultiprocessorCount, dev);
        hipFuncSetAttribute((const void*)mega, hipFuncAttributeMaxDynamicSharedMemorySize, LDS_BYTES);
        hipOccupancyMaxActiveBlocksPerMultiprocessor(&per_cu, (const void*)mega, 512, LDS_BYTES);
        if (per_cu < 1) fprintf(stderr, "kernel_launch: occupancy query says %d\n", per_cu);
        grid = cus > 0 ? cus : 256;
    }
    if (grid < 0) return;
    hipMemsetAsync((char*)d_ws + WS_CTL, 0, CTL_BYTES, stream);
    Params p{};
    const float** fp = (const float**)&p;
    for (int i = 0; i < 32; ++i) fp[i] = (const float*)d_in[i];
    p.out = (float*)d_out; p.ws = (char*)d_ws;
#if N_LAUNCH_MODE == 1
    p.lo = 0; p.hi = NPHASE;
    hipLaunchKernelGGL(mega, dim3(grid), dim3(512), LDS_BYTES, stream, p);
#else
    for (int ph = 0; ph < NPHASE; ++ph) {
        p.lo = ph; p.hi = ph + 1;
        hipLaunchKernelGGL(mega, dim3(grid), dim3(512), LDS_BYTES, stream, p);
    }
#endif
}
```

```cpp
#include <hip/hip_runtime.h>
#include <cstdio>
#include <cstdint>

#define LAS __attribute__((address_space(3)))
typedef unsigned short bf16_t;
typedef short bf16x8 __attribute__((ext_vector_type(8)));
typedef float f32x4 __attribute__((ext_vector_type(4)));
typedef float f32x2 __attribute__((ext_vector_type(2)));
typedef float f32x16 __attribute__((ext_vector_type(16)));
typedef unsigned u32x4 __attribute__((ext_vector_type(4)));
typedef unsigned u32x2 __attribute__((ext_vector_type(2)));

#ifndef PHMASK
#define PHMASK 0xFFFFFFFFu
#endif
#define ON(k) ((((unsigned)(PHMASK)) >> (k)) & 1u)
#ifndef ABL
#define ABL 0
#endif
#ifndef DUP
#define DUP -1
#endif
#ifndef DUPN
#define DUPN 3
#endif
#ifndef N_LAUNCH_MODE
#define N_LAUNCH_MODE 1
#endif

constexpr int NB_ = 8, SEQ = 4096, NCTX = 256, DM = 1024, TPB = NCTX + SEQ  , T = NB_ * TPB  , NLAYER = 2;
constexpr int DIN = 5280, NU = 2304;
constexpr int U_XR = 0, U_CKV = 512, U_KR = 640, U_GK = 672, U_GV = 800, U_RG = 928, U_CQ = 1440, U_GQ = 1696, U_MG = 2208;
constexpr int NEXP = 32, DEXP = 256;
constexpr int MAXSLOT = 2 * T + NEXP * 256;
constexpr int NCHUNK = TPB / 64;
constexpr float LOG2E = 1.4426950408889634f;
#define LOG2E_ 1.4426950408889634f
constexpr float QSCALE_G = 0.125f * LOG2E;
constexpr float QSCALE_M = 0.10206207261596575f * LOG2E;

constexpr size_t al256(size_t x) { return (x + 255) & ~(size_t)255; }
constexpr size_t WS_CTL = 0;
constexpr size_t CTL_BYTES = 98304;
constexpr size_t WS_MOD = WS_CTL + CTL_BYTES;
constexpr size_t WS_ROPE = WS_MOD + al256((size_t)2 * 9 * 6144 * 4);
constexpr size_t WS_LRUT = WS_ROPE + (size_t)4096 * 96 * 4;
constexpr size_t WS_WRT = WS_LRUT + 2 * 2 * 512 * 4;
constexpr size_t WS_CARRY = WS_WRT + (size_t)2 * 36 * 1024 * 4;
constexpr size_t WS_SEL = WS_CARRY + (size_t)NB_ * NCHUNK * 2 * 512 * 8;
constexpr size_t WS_LIST = WS_SEL + (size_t)T * 32;
constexpr size_t WS_XSC = WS_LIST + al256((size_t)MAXSLOT * 8 + 2048);
constexpr size_t WS_W = WS_XSC + (size_t)NB_ * NCTX * DM * 4;
constexpr size_t W_IN = 0, W_MG = W_IN + (size_t)NU * 1024 * 2, W_G = W_MG + (size_t)3072 * 1024 * 2, W_UKV = W_G + (size_t)2048 * 512 * 2,
                 W_UQ = W_UKV + (size_t)1024 * 256 * 2, W_BR = W_UQ + (size_t)768 * 256 * 2, W_OUT = W_BR + (size_t)3 * 1024 * 512 * 2,
                 W_13 = W_OUT + (size_t)1024 * 1024 * 2, W_2T = W_13 + (size_t)32 * 512 * 1024 * 2, W_BYTES = W_2T + (size_t)32 * 1024 * 256 * 2;
constexpr size_t WS_H = WS_W + W_BYTES;
constexpr size_t WS_A = WS_H + (size_t)T * 1024 * 2;
constexpr size_t A_BYTES = (size_t)T * NU * 2;
constexpr size_t A_U = 0, A_LAB = 0, A_KM = 0, A_QM = A_KM + (size_t)T * 8 * 64 * 2, A_VMT = A_QM + (size_t)T * 8 * 96 * 2,
                 A_M = 0, A_GT = (size_t)T * 1024 * 2, A_Y2 = 0;
constexpr size_t WS_B = WS_A + A_BYTES;
constexpr size_t B_XC = 0, B_GR = B_XC + (size_t)T * 512 * 2, B_CKVN = B_GR + (size_t)T * 512 * 2, B_CQN = B_CKVN + (size_t)T * 256 * 2,
                 B_QG = B_CQN + (size_t)T * 256 * 2, B_KG = B_QG + (size_t)T * 512 * 2, B_VGT = B_KG + (size_t)T * 128 * 2, B_KR = B_VGT + (size_t)T * 128 * 2,
                 B_BYTES = B_KR + (size_t)T * 32 * 2, B_YM = B_XC, B_YG = B_GR, B_HE = 0;
constexpr size_t WS_C = WS_B + B_BYTES;
constexpr size_t WS_END = WS_C + (size_t)T * 512 * 2;
static_assert(A_VMT + (size_t)T * 8 * 64 * 2 <= A_BYTES, "A overlay");
static_assert(A_GT + (size_t)T * 1024 * 2 <= A_BYTES, "A overlay 2");
static_assert((size_t)T * 2 * 1024 * 2 <= A_BYTES, "A overlay 3");
static_assert((size_t)MAXSLOT * 256 * 2 <= B_BYTES, "B overlay");
static_assert(B_CKVN + (size_t)T * 1024 * 2 <= B_BYTES, "B overlay (M)");
static_assert((size_t)T * 3072 <= A_BYTES, "A overlay (gates)");
static_assert(WS_END <= (size_t)536870912, "workspace");
constexpr int CW_BAR = 0;
constexpr int CW_CNT = 4096;
constexpr int CW_NT = 4096 + 2 * 32 * 64;
constexpr int CW_CMAX = 8448;
constexpr int CW_CMAX2 = CW_CMAX + 2 * 3072;
static_assert((CW_CMAX2 + 2 * 2304) * 4 <= 98304, "control words");

struct Params {
    const float *x, *c, *ctx, *c_ctx, *w_mod, *b_mod, *g_mix, *g_ffn, *w_in, *conv_w, *conv_b, *lru_wa, *lru_ba, *lru_wi, *lru_bi, *lru_lambda,
        *mla_gq, *mla_wuq, *mla_gkv, *mla_wukv, *gqa_gq, *gqa_gk, *w_branch, *w_out, *moe_wg, *moe_bg, *moe_we, *moe_be, *moe_w1, *moe_w3, *moe_w2, *g_final;
    float* out; char* ws; int lo, hi;
};

__device__ __forceinline__ float bf2f(bf16_t b) { return __uint_as_float(((unsigned)b) << 16); }
typedef __bf16 bf16x2_t __attribute__((ext_vector_type(2)));
__device__ __forceinline__ unsigned cvt_pk_bf16(float lo, float hi) { const f32x2 v = {lo, hi}; const bf16x2_t b = __builtin_convertvector(v, bf16x2_t); return __builtin_bit_cast(unsigned, b); }
__device__ __forceinline__ bf16_t f2bf(float f) { return (bf16_t)(cvt_pk_bf16(f, 0.f) & 0xffffu); }
__device__ __forceinline__ float sigmoidf_(float x) { return __builtin_amdgcn_rcpf(1.0f + __builtin_amdgcn_exp2f(-LOG2E_ * x)); }
__device__ __forceinline__ float nexpm1_small(float x) { float q = 1.0f / 720.0f; q = q * x + 1.0f / 120.0f; q = q * x + 1.0f / 24.0f; q = q * x + 1.0f / 6.0f; q = q * x + 0.5f; q = q * x + 1.0f;
    const float big = 1.0f - __builtin_amdgcn_exp2f(x * LOG2E_); return x < -0.25f ? big : -x * q; }
__device__ __forceinline__ float gelu_tanh(float x) { const float u = 0.7978845608028654f * (x + 0.044715f * x * x * x); const float e = __expf(2.0f * u); const float th = 1.0f - 2.0f / (e + 1.0f); return 0.5f * x * (1.0f + th); }
template <int CTRL> __device__ __forceinline__ float dpp_f(float v) { return __builtin_bit_cast(float, __builtin_amdgcn_update_dpp(0, __builtin_bit_cast(int, v), CTRL, 0xF, 0xF, true)); }
__device__ __forceinline__ float red4(float v) { v += dpp_f<0xB1>(v); v += dpp_f<0x4E>(v); return v; }
__device__ __forceinline__ float red8(float v) { v = red4(v); v += dpp_f<0x141>(v); return v; }
__device__ __forceinline__ float red16(float v) { v = red8(v); v += dpp_f<0x140>(v); return v; }
__device__ __forceinline__ float rdl(float v, int l) { return __builtin_bit_cast(float, __builtin_amdgcn_readlane(__builtin_bit_cast(int, v), l)); }
__device__ __forceinline__ float wave_sum(float v) { v = red16(v); return (rdl(v, 0) + rdl(v, 16)) + (rdl(v, 32) + rdl(v, 48)); }
__device__ __forceinline__ f32x4 unpack4(const u32x2 w) { return (f32x4){__uint_as_float(w.x << 16), __uint_as_float(w.x & 0xffff0000u), __uint_as_float(w.y << 16), __uint_as_float(w.y & 0xffff0000u)}; }
__device__ __forceinline__ u32x2 pack4(const f32x4 v) { u32x2 w; w.x = cvt_pk_bf16(v[0], v[1]); w.y = cvt_pk_bf16(v[2], v[3]); return w; }
__device__ __forceinline__ float wave_max_nn(float v) {
    v = fmaxf(v, dpp_f<0xB1>(v)); v = fmaxf(v, dpp_f<0x4E>(v)); v = fmaxf(v, dpp_f<0x141>(v)); v = fmaxf(v, dpp_f<0x140>(v)); return fmaxf(fmaxf(rdl(v, 0), rdl(v, 16)), fmaxf(rdl(v, 32), rdl(v, 48))); }
__device__ __forceinline__ unsigned pack_i8x4(float a, float b, float c, float d, float sc) {
    const unsigned t0 = __float_as_uint(__builtin_fmaf(a, sc, 12582912.0f)), t1 = __float_as_uint(__builtin_fmaf(b, sc, 12582912.0f)), t2 = __float_as_uint(__builtin_fmaf(c, sc, 12582912.0f)), t3 = __float_as_uint(__builtin_fmaf(d, sc, 12582912.0f));
    return __builtin_amdgcn_perm(t1, t0, 0x0c0c0400u) | __builtin_amdgcn_perm(t3, t2, 0x04000c0cu); }
__device__ __forceinline__ void unpack8(const u32x4 w, float (&f)[8]) {
    f[0] = __uint_as_float(w.x << 16); f[1] = __uint_as_float(w.x & 0xffff0000u); f[2] = __uint_as_float(w.y << 16); f[3] = __uint_as_float(w.y & 0xffff0000u);
    f[4] = __uint_as_float(w.z << 16); f[5] = __uint_as_float(w.z & 0xffff0000u); f[6] = __uint_as_float(w.w << 16); f[7] = __uint_as_float(w.w & 0xffff0000u);
}
__device__ __forceinline__ u32x4 pack8(const float (&f)[8]) { u32x4 w; w.x = cvt_pk_bf16(f[0], f[1]); w.y = cvt_pk_bf16(f[2], f[3]); w.z = cvt_pk_bf16(f[4], f[5]); w.w = cvt_pk_bf16(f[6], f[7]); return w; }
#define BUF_RSRC(p) __builtin_amdgcn_make_buffer_rsrc((void*)(p), 0, 0x7fffffff, 0x00020000)
__device__ __forceinline__ float* resid_row(float* out, char* ws, int t) {
    const int b = t / TPB, n = t - b * TPB;
    return n < NCTX ? (float*)(ws + WS_XSC) + ((size_t)b * NCTX + n) * DM : out + ((size_t)b * SEQ + (n - NCTX)) * DM;
}

#define XB_TMO      128
#define XB_XCNT(j)  (256  + 64 * (j))
#define XB_XSUB(j)  (1280 + 64 * (j))
#define XB_XGEN(j)  (2304 + 64 * (j))
#define XB_TOP      3328
#define XB_TOPGEN   3392
#define XCD_BAR_WORDS 3456
#define XB_SPIN_CAP (1u << 18)
__device__ __forceinline__ unsigned xb_ld(unsigned* p)              { return __hip_atomic_load(p, __ATOMIC_RELAXED, __HIP_MEMORY_SCOPE_AGENT); }
__device__ __forceinline__ unsigned xb_add(unsigned* p, unsigned v) { return __hip_atomic_fetch_add(p, v, __ATOMIC_RELAXED, __HIP_MEMORY_SCOPE_AGENT); }
__device__ __forceinline__ unsigned xb_xcc_id() { return (unsigned)__builtin_amdgcn_s_getreg((3 << 11) | 20) & 0xFu; }
#define XB_SPIN(cond, bar) do { unsigned _sp = 0; while (cond) { __builtin_amdgcn_s_sleep(1); \
    if ((++_sp & 255u) == 0u) { if (xb_ld(&(bar)[XB_TMO])) break; if (_sp > XB_SPIN_CAP) { atomicAdd(&(bar)[XB_TMO], 1u); break; } } } } while (0)
struct XcdBarrier { unsigned* bar; unsigned x; volatile LAS unsigned* st; };
__device__ __forceinline__ XcdBarrier xcd_barrier_post(unsigned* bar, volatile LAS unsigned* st) {
    XcdBarrier b; b.bar = bar; b.x = xb_xcc_id(); b.st = st;
    if (threadIdx.x == 0) (void)xb_add(&bar[XB_XCNT(b.x)], 1u);
    return b;
}
__device__ __forceinline__ void xcd_barrier_complete(unsigned* bar, unsigned x, unsigned& nloc, unsigned& nx) {
    const unsigned G = gridDim.x * gridDim.y * gridDim.z;
    unsigned sum, cnt, mine, sp = 0u;
    for (;;) {
        sum = 0u; cnt = 0u; mine = 0u;
#pragma unroll
        for (unsigned j = 0; j < 16; ++j) { const unsigned c = xb_ld(&bar[XB_XCNT(j)]); sum += c; cnt += (c > 0u) ? 1u : 0u; mine = (j == x) ? c : mine; }
        if (sum == G) break;
        __builtin_amdgcn_s_sleep(1);
        if ((++sp & 255u) == 0u) { if (xb_ld(&bar[XB_TMO])) break; if (sp > XB_SPIN_CAP) { atomicAdd(&bar[XB_TMO], 1u); break; } }
    }
    nloc = mine > 0u ? mine : 1u; nx = cnt > 0u ? cnt : 1u;
}
__device__ __forceinline__ void xcd_barrier(const XcdBarrier& b) {
    asm volatile("s_waitcnt vmcnt(0)" ::: "memory");
    __syncthreads();
    if (threadIdx.x == 0) {
        unsigned* bar = b.bar;
        __builtin_amdgcn_s_waitcnt(0);
        unsigned nloc = b.st[0], nx = b.st[1];
        if (nloc == 0u) { xcd_barrier_complete(bar, b.x, nloc, nx); b.st[0] = nloc; b.st[1] = nx; }
        const unsigned old = xb_add(&bar[XB_XSUB(b.x)], 1u);
        const unsigned gen = old / nloc;
        if (old + 1u == (gen + 1u) * nloc) {
            __builtin_amdgcn_fence(__ATOMIC_RELEASE, "agent");
            asm volatile("s_waitcnt vmcnt(0)" ::: "memory");
            const unsigned og = xb_add(&bar[XB_TOP], 1u);
            const unsigned tg = og / nx;
            if (og + 1u == (tg + 1u) * nx) xb_add(&bar[XB_TOPGEN], 1u);
            else XB_SPIN(xb_ld(&bar[XB_TOPGEN]) == tg, bar);
            __builtin_amdgcn_fence(__ATOMIC_ACQUIRE, "agent");
            xb_add(&bar[XB_XGEN(b.x)], 1u);
            asm volatile("s_waitcnt vmcnt(0)" ::: "memory");
        } else {
            XB_SPIN(xb_ld(&bar[XB_XGEN(b.x)]) == gen, bar);
            __builtin_amdgcn_fence(__ATOMIC_ACQUIRE, "agent");
            asm volatile("s_waitcnt vmcnt(0)" ::: "memory");
        }
    }
    __syncthreads();
}

namespace g8 {
constexpr int BM = 256, BK = 64, HALF = 128, HTB = HALF * BK * 2, STAGE_BYTES = 8 * HTB, NXCD = 8, WGM = 8;
__device__ __forceinline__ int lds_byte(int r, int c) { const int st = (r >> 4) * 2 + (c >> 5), rr = r & 15, cc = c & 31, ob = rr * 64 + cc * 2; return st * 1024 + (ob ^ (((ob >> 9) & 1) << 5)); }
__device__ __forceinline__ void stage_rc(int b, int& R, int& C) { const int st = b / 1024, sb = b % 1024, swz = sb ^ (((sb >> 9) & 1) << 5); R = (st >> 1) * 16 + swz / 64; C = (st & 1) * 32 + (swz % 64) / 2; }
__device__ __forceinline__ int perm32(int rho) { const int n = rho >> 4, i = rho & 15; return 8 * (i >> 2) + 4 * n + (i & 3); }

struct Unit { const char* A; const char* B; const int* gidx; int pitchA, pitchB, nt; int pm, pn, aux; int eidx; size_t bstride; int hmask; };

__device__ __forceinline__ bool deal_unit(int i, int G, int c, int nwg, int& uid, int& hmask) {
    const long L = (long)i * G + c; const int full = (nwg / G) * G, rem = nwg - full;
    if (L < full) { uid = (int)L; hmask = 3; return true; }
    const int j = (int)(L - full);
    if (2 * rem <= G) { if (j >= 2 * rem) return false; uid = full + (j >> 1); hmask = 1 << (j & 1); return true; }
    if (j >= rem) return false; uid = full + j; hmask = 3; return true;
}
__device__ __forceinline__ void tile_of(int wgid, int nM, int nN, int& pm, int& pn) {
    const int nwg = nM * nN;
    { const int q = nwg / NXCD, r = nwg % NXCD, xcd = wgid % NXCD, off = wgid / NXCD; wgid = (xcd < r ? xcd * (q + 1) : r * (q + 1) + (xcd - r) * q) + off; }
    const int nig = WGM * nN, gid = wgid / nig, fm = gid * WGM, gsz = (nM - fm) < WGM ? (nM - fm) : WGM;
    pm = fm + ((wgid % nig) % gsz); pn = (wgid % nig) / gsz;
}
__device__ __forceinline__ bool static_tile(int i, int G, int c, int nM, int nN, int& pm, int& pn, int& hmask) {
    int uid; if (!deal_unit(i, G, c, nM * nN, uid, hmask)) return false;
    tile_of(uid, nM, nN, pm, pn); return true;
}

__device__ __forceinline__ void load_gidx(const Unit& u, int tid, int (&gi)[4]) {
#pragma unroll
    for (int i = 0; i < 2; ++i) { int R, C; stage_rc(tid * 16 + i * 8192, R, C);
#pragma unroll
        for (int h = 0; h < 2; ++h) gi[h * 2 + i] = u.gidx[h * HALF + R]; }
}
template <bool PERM, bool GATHER>
__device__ __forceinline__ void calc_voff(const Unit& u, int tid, unsigned (&vA)[2][2], unsigned (&vB)[2], const int (&gi)[4]) {
#pragma unroll
    for (int i = 0; i < 2; ++i) {
        int R, C; stage_rc(tid * 16 + i * 8192, R, C); const int Rb = PERM ? ((R & ~31) + perm32(R & 31)) : R;
        vB[i] = (unsigned)Rb * (unsigned)u.pitchB + (unsigned)C * 2u;
        if (GATHER) {
#pragma unroll
            for (int h = 0; h < 2; ++h) { int g = gi[h * 2 + i]; asm volatile("" : "+v"(g));        const int rowA = g < 0 ? 0 : (g >> 1); vA[h][i] = (unsigned)rowA * (unsigned)u.pitchA + (unsigned)C * 2u; }
        } else { vA[0][i] = (unsigned)R * (unsigned)u.pitchA + (unsigned)C * 2u; vA[1][i] = vA[0][i]; }
    }
}

template <class E, class = void> struct epi_i8 { static constexpr bool value = false; };
template <class E> struct epi_i8<E, decltype((void)E::I8)> { static constexpr bool value = E::I8; };
typedef int i32x4 __attribute__((ext_vector_type(4)));
template <bool I8> __device__ __forceinline__ f32x4 mma16(const bf16x8 a, const bf16x8 b, const f32x4 c) {
    if constexpr (I8) return __builtin_bit_cast(f32x4, __builtin_amdgcn_mfma_i32_16x16x64_i8(__builtin_bit_cast(i32x4, a), __builtin_bit_cast(i32x4, b), __builtin_bit_cast(i32x4, c), 0, 0, 0));
    else return __builtin_amdgcn_mfma_f32_16x16x32_bf16(a, b, c, 0, 0, 0);
}
template <class Epi, class Sched>
__device__ __forceinline__ void gemm_phase(LAS unsigned char* lds, const Sched& S, const Epi& E) {
    int tid_l = threadIdx.x; asm volatile("" : "+v"(tid_l));
    const int tid = tid_l, wid = __builtin_amdgcn_readfirstlane(tid >> 6), lane = tid & 63, wr = wid >> 2, wc = wid & 3, fr = lane & 15, fq = lane >> 4;
    const unsigned ldsw = (unsigned)wid * 1024u;
    const int aoff = lds_byte(wr * 64 + fr, fq * 8), boff = lds_byte(wc * 32 + fr, fq * 8);
#define G8_SA(b, h) (((b) * 2 + (h)) * HTB)
#define G8_SB(b, h) ((4 + (b) * 2 + (h)) * HTB)
#define G8_STAGE(bufoff, gbase, koff, voff) do { _Pragma("unroll") for (int _i = 0; _i < 2; ++_i) \
        __builtin_amdgcn_global_load_lds((const unsigned*)((const char*)(gbase) + (unsigned)((voff)[_i] + (unsigned)(koff))), (LAS unsigned*)(lds + (bufoff) + ldsw + _i * 8192), 16, 0, 0); } while (0)
#define G8_LDA(dst, b, h) do { _Pragma("unroll") for (int m = 0; m < 4; ++m) _Pragma("unroll") for (int k = 0; k < 2; ++k) dst[m][k] = *(const LAS bf16x8*)(lds + G8_SA(b, h) + aoff + m * 2048 + k * 1024); } while (0)
#define G8_LDB(dst, b, h) do { _Pragma("unroll") for (int n = 0; n < 2; ++n) _Pragma("unroll") for (int k = 0; k < 2; ++k) dst[n][k] = *(const LAS bf16x8*)(lds + G8_SB(b, h) + boff + n * 2048 + k * 1024); } while (0)
#define G8_MMA(ai, bj, At, Bt) do { __builtin_amdgcn_s_setprio(1); _Pragma("unroll") for (int m = 0; m < 4; ++m) _Pragma("unroll") for (int n = 0; n < 2; ++n) _Pragma("unroll") for (int k = 0; k < 2; ++k) \
        acc[ai][bj][m][n] = mma16<epi_i8<Epi>::value>(Bt[n][k], At[m][k], acc[ai][bj][m][n]); __builtin_amdgcn_s_setprio(0); } while (0)
#define G8_WAIT_V(n) asm volatile("s_waitcnt vmcnt(" #n ")" ::: "memory")
#define G8_WAIT_L(n) asm volatile("s_waitcnt lgkmcnt(" #n ")" ::: "memory")
#define G8_BAR __builtin_amdgcn_s_barrier()
#define G8_SCHED __builtin_amdgcn_sched_barrier(0)
    Unit cur, nxt; int ui = 0;
    if (!S.next(0, cur)) return;
    f32x4 acc[2][2][4][2];
#pragma unroll
    for (int a = 0; a < 2; ++a)
#pragma unroll
        for (int b = 0; b < 2; ++b)
#pragma unroll
            for (int m = 0; m < 4; ++m)
#pragma unroll
                for (int n = 0; n < 2; ++n) acc[a][b][m][n] = (f32x4){0.f, 0.f, 0.f, 0.f};
    bf16x8 At[4][2], B0[2][2], B1[2][2];
    constexpr bool GA = Sched::GATHER; constexpr int H1 = GA ? 1 : 0;
    unsigned vA[2][2], vB[2];
    { int gi0[4] = {0, 0, 0, 0}; if (GA) load_gidx(cur, tid, gi0); calc_voff<Epi::PERM, GA>(cur, tid, vA, vB, gi0); }
    unsigned hA = GA ? 0u : (unsigned)(HALF * cur.pitchA), hB = (unsigned)(HALF * cur.pitchB);
    const char* cA = cur.A; const char* cB = cur.B + (size_t)cur.eidx * cur.bstride; int nt = cur.nt;
    constexpr unsigned kstep = BK * 2;
    G8_STAGE(G8_SB(0, 0), cB, 0u, vB); G8_STAGE(G8_SB(0, 1), cB, hB, vB); G8_STAGE(G8_SA(0, 0), cA, 0u, vA[0]); G8_STAGE(G8_SA(0, 1), cA, hA, vA[H1]);
    if (wr == 1) G8_BAR;
    G8_WAIT_V(2); G8_BAR;
    G8_STAGE(G8_SB(1, 0), cB, kstep, vB); G8_STAGE(G8_SA(1, 0), cA, kstep, vA[0]); G8_STAGE(G8_SB(1, 1), cB, kstep + hB, vB);
    G8_WAIT_V(6); G8_BAR;
    for (;;) {
        const bool has_next = S.next(ui + 1, nxt);
        int gi[4] = {0, 0, 0, 0};
        if (GA && has_next) load_gidx(nxt, tid, gi);
        const char* nA = has_next ? nxt.A : cA; const char* nB = cB;
        const bool hm0 = (cur.hmask & 1) != 0, hm1 = (cur.hmask & 2) != 0;
        for (int t = 0; t < nt; t += 2) {
            const bool last = (t == nt - 2);
            const unsigned k1 = (unsigned)(t + 1) * kstep, k2 = last ? 0u : (unsigned)(t + 2) * kstep, k3 = k2 + kstep;
            if (last && has_next) { int e = nxt.eidx; asm volatile("" : "+v"(e)); nB = nxt.B + (size_t)__builtin_amdgcn_readfirstlane(e) * nxt.bstride; }
            const char* a2 = last ? nA : cA; const char* b2 = last ? nB : cB;
            G8_LDB(B0, 0, 0); G8_LDB(B1, 0, 1); G8_SCHED; G8_LDA(At, 0, 0); G8_STAGE(G8_SA(1, 1), cA, k1 + hA, vA[H1]);
            if (last && has_next) { calc_voff<Epi::PERM, GA>(nxt, tid, vA, vB, gi); hA = GA ? 0u : (unsigned)(HALF * nxt.pitchA); hB = (unsigned)(HALF * nxt.pitchB); }
            G8_WAIT_V(8); G8_WAIT_L(0); G8_BAR; if (hm0) { G8_MMA(0, 0, At, B0); G8_MMA(0, 1, At, B1); } G8_BAR; G8_SCHED;
            G8_LDA(At, 0, 1); G8_STAGE(G8_SB(0, 0), b2, k2, vB); G8_STAGE(G8_SB(0, 1), b2, k2 + hB, vB); G8_STAGE(G8_SA(0, 0), a2, k2, vA[0]);
            G8_WAIT_V(8); G8_WAIT_L(0); G8_BAR; if (hm1) { G8_MMA(1, 0, At, B0); G8_MMA(1, 1, At, B1); } G8_BAR; G8_SCHED;
            G8_LDB(B0, 1, 0); G8_LDB(B1, 1, 1); G8_SCHED; G8_LDA(At, 1, 0); G8_STAGE(G8_SA(0, 1), a2, k2 + hA, vA[H1]);
            G8_WAIT_V(8); G8_WAIT_L(0); G8_BAR; if (hm0) { G8_MMA(0, 0, At, B0); G8_MMA(0, 1, At, B1); } G8_BAR; G8_SCHED;
            G8_LDA(At, 1, 1); G8_STAGE(G8_SB(1, 0), b2, k3, vB); G8_STAGE(G8_SB(1, 1), b2, k3 + hB, vB); G8_STAGE(G8_SA(1, 0), a2, k3, vA[0]);
            G8_WAIT_V(8); G8_WAIT_L(0); G8_BAR; if (hm1) { G8_MMA(1, 0, At, B0); G8_MMA(1, 1, At, B1); } G8_BAR; G8_SCHED;
        }
        if (wr == 0) G8_BAR;
        G8_SCHED; E(acc, cur, wr, wc, fr, fq); G8_SCHED;
        if (!has_next) break;
        if (!Epi::keeps(cur)) {
#pragma unroll
        for (int a = 0; a < 2; ++a)
#pragma unroll
            for (int b = 0; b < 2; ++b)
#pragma unroll
                for (int m = 0; m < 4; ++m)
#pragma unroll
                    for (int n = 0; n < 2; ++n) acc[a][b][m][n] = (f32x4){0.f, 0.f, 0.f, 0.f};
        }
        cur = nxt; cA = nA; cB = nB; nt = cur.nt; ++ui;
        if (wr == 1) G8_BAR;
    }
    G8_WAIT_V(0);
    G8_BAR;
#undef G8_SA
#undef G8_SB
#undef G8_STAGE
#undef G8_LDA
#undef G8_LDB
#undef G8_MMA
#undef G8_WAIT_V
#undef G8_WAIT_L
#undef G8_BAR
#undef G8_SCHED
}
typedef f32x4 Acc[2][2][4][2];
}
using g8::Unit;

struct SchedDense {
    static constexpr bool GATHER = false;
    const char* A; const char* B; int K, nM, nN, G, c; bool skip;
    __device__ __forceinline__ bool next(int i, Unit& u) const {
        int pm, pn, hm; if (!g8::static_tile(i, G, c, skip ? (nM / 17) * 16 : nM, nN, pm, pn, hm)) return false;
        if (skip) pm = (pm >> 4) * 17 + 1 + (pm & 15);
        u.hmask = hm; u.pitchA = K * 2; u.pitchB = K * 2; u.nt = K / 64; u.pm = pm; u.pn = pn; u.aux = 0; u.gidx = nullptr; u.eidx = 0; u.bstride = 0;
        u.A = A + (size_t)pm * 256 * K * 2; u.B = B + (size_t)pn * 256 * K * 2; return true;
    }
};
struct SchedGate {
    static constexpr bool GATHER = false;
    const char* A; const char* B; int nM, G, c;
    __device__ __forceinline__ bool next(int i, Unit& u) const {
        int pm, pn, hm; if (!g8::static_tile(i, G, c, nM, 8, pm, pn, hm)) return false;
        u.hmask = hm;
        int two = 2; asm volatile("" : "+s"(two));
        u.pitchA = 1024; u.pitchB = 256; u.nt = two; u.pm = pm; u.pn = pn; u.aux = 0; u.gidx = nullptr; u.eidx = 0; u.bstride = 0;
        u.A = A + (size_t)pm * 256 * 1024 + (size_t)(pn >> 1) * 256; u.B = B + (size_t)pn * 256 * 256; return true;
    }
};
struct SchedMerge {
    static constexpr bool GATHER = false;
    const char* wsb; const char* WBR; int nM, G, c; bool skip;
    __device__ __forceinline__ bool next(int i, Unit& u) const {
        const int ti = i / 3, k = i - ti * 3;
        int pm, pn, hm; if (!g8::static_tile(ti, G, c, skip ? (nM / 17) * 16 : nM, 4, pm, pn, hm)) return false;
        u.hmask = hm;
        if (skip) pm = (pm >> 4) * 17 + 1 + (pm & 15);
        u.pm = pm; u.pn = pn; u.aux = k; u.gidx = nullptr; u.eidx = 0; u.bstride = 0;
        u.pitchA = 1024; u.pitchB = 1024; u.nt = 8; { const size_t yo = k == 0 ? WS_C : (k == 1 ? WS_B + B_YM : WS_B + B_YG); u.A = wsb + yo + (size_t)pm * 256 * 1024; } u.B = WBR + ((size_t)k * 1024 + pn * 256) * 1024;
        return true;
    }
};
template <bool GA_> struct SchedMoe {
    static constexpr bool GATHER = GA_;
    const char* A; const char* Bw; const int* list; const LAS int* toffs; int ntiles, nN, K, G, c; size_t strideB;
    __device__ __forceinline__ bool next(int i, Unit& u) const {
        int uid, hm; if (!g8::deal_unit(i, G, c, ntiles * nN, uid, hm)) return false;
        const int tile = uid / nN, pn = uid - tile * nN; u.hmask = hm;
        int e = 0;
#pragma unroll
        for (int st = 16; st >= 1; st >>= 1) if (toffs[e + st] <= tile) e += st;
        u.pm = tile; u.pn = pn; u.aux = 0; u.pitchA = K * 2; u.pitchB = K * 2; u.nt = K / 64; u.eidx = 0; u.bstride = 0;
        u.gidx = GA_ ? list + (size_t)tile * 256 : nullptr; u.A = GA_ ? A : A + (size_t)tile * 256 * K * 2;
        u.B = Bw + (size_t)e * strideB + (size_t)pn * 256 * K * 2; return true;
    }
};

struct EpiBf16Plain {
    static __device__ __forceinline__ bool keeps(const Unit&) { return false; }
    static constexpr bool PERM = true;
    bf16_t* O; int ldc;
    __device__ __forceinline__ void operator()(const g8::Acc& acc, const Unit& u, int wr, int wc, int fr, int fq) const {
        const int row0 = u.pm * 256 + wr * 64 + fr, col0 = u.pn * 256 + wc * 32 + 8 * fq;
#pragma unroll
        for (int ai = 0; ai < 2; ++ai) if ((u.hmask >> ai) & 1)
#pragma unroll
            for (int m = 0; m < 4; ++m) { bf16_t* rowp = O + (size_t)(row0 + ai * 128 + m * 16) * ldc + col0;
#pragma unroll
                for (int bj = 0; bj < 2; ++bj) { const f32x4 v0 = acc[ai][bj][m][0], v1 = acc[ai][bj][m][1];
                    u32x4 w; w.x = cvt_pk_bf16(v0[0], v0[1]); w.y = cvt_pk_bf16(v0[2], v0[3]); w.z = cvt_pk_bf16(v1[0], v1[1]); w.w = cvt_pk_bf16(v1[2], v1[3]);
                    *(u32x4*)(rowp + bj * 128) = w; } }
    }
};
struct EpiBf16I8 {
    static __device__ __forceinline__ bool keeps(const Unit&) { return false; }
    static constexpr bool PERM = true;
    static constexpr bool I8 = true;
    bf16_t* O; int ldc; const float* rs_; const float* cm_;
    __device__ __forceinline__ void operator()(const g8::Acc& acc, const Unit& u, int wr, int wc, int fr, int fq) const {
        asm volatile("" : "+v"(fr), "+v"(fq));
        const int row0 = u.pm * 256 + wr * 64 + fr, col0 = u.pn * 256 + wc * 32 + 8 * fq;
        f32x4 cs[2][2];
#pragma unroll
        for (int bj = 0; bj < 2; ++bj)
#pragma unroll
            for (int h = 0; h < 2; ++h) cs[bj][h] = *(const f32x4*)(cm_ + col0 + bj * 128 + 4 * h) * (1.0f / 127.0f);
        float rsv[2][4];
#pragma unroll
        for (int ai = 0; ai < 2; ++ai)
#pragma unroll
            for (int m = 0; m < 4; ++m) rsv[ai][m] = rs_[row0 + ai * 128 + m * 16];
#pragma unroll
        for (int ai = 0; ai < 2; ++ai) if ((u.hmask >> ai) & 1)
#pragma unroll
            for (int m = 0; m < 4; ++m) { bf16_t* rowp = O + (size_t)(row0 + ai * 128 + m * 16) * ldc + col0; const float rs = rsv[ai][m];
#pragma unroll
                for (int bj = 0; bj < 2; ++bj) { const g8::i32x4 i0 = __builtin_bit_cast(g8::i32x4, acc[ai][bj][m][0]), i1 = __builtin_bit_cast(g8::i32x4, acc[ai][bj][m][1]);
                    const f32x4 v0 = (f32x4){(float)i0[0], (float)i0[1], (float)i0[2], (float)i0[3]} * rs * cs[bj][0], v1 = (f32x4){(float)i1[0], (float)i1[1], (float)i1[2], (float)i1[3]} * rs * cs[bj][1];
                    u32x4 w; w.x = cvt_pk_bf16(v0[0], v0[1]); w.y = cvt_pk_bf16(v0[2], v0[3]); w.z = cvt_pk_bf16(v1[0], v1[1]); w.w = cvt_pk_bf16(v1[2], v1[3]);
                    *(u32x4*)(rowp + bj * 128) = w; } }
    }
};
struct EpiGate {
    static __device__ __forceinline__ bool keeps(const Unit&) { return false; }
    static constexpr bool PERM = false;
    const bf16_t* xc_; bf16_t* lab_; const float* ba; const float* bi; const float* logu;
    __device__ __forceinline__ void operator()(const g8::Acc& acc, const Unit& u, int wr, int wc, int fr_, int fq_) const {
        int fr = fr_, fq = fq_; asm volatile("" : "+v"(fr), "+v"(fq));
        const int row0 = u.pm * 256 + wr * 64 + fr; const int c = u.pn * 64 + wc * 16 + fq * 4;
        const f32x4 baf = *(const f32x4*)(ba + c), bif = *(const f32x4*)(bi + c), bab = *(const f32x4*)(ba + 512 + c), bib = *(const f32x4*)(bi + 512 + c), luf = *(const f32x4*)(logu + c), lub = *(const f32x4*)(logu + 512 + c);
        u32x2 xw[2][4];
#pragma unroll
        for (int ai = 0; ai < 2; ++ai) if ((u.hmask >> ai) & 1)
#pragma unroll
            for (int m = 0; m < 4; ++m) xw[ai][m] = *(const u32x2*)(xc_ + (size_t)(row0 + ai * 128 + m * 16) * 512 + c);
        asm volatile("" ::: "memory");
#pragma unroll
        for (int ai = 0; ai < 2; ++ai) if ((u.hmask >> ai) & 1)
#pragma unroll
            for (int m = 0; m < 4; ++m) {
                const size_t row = (size_t)(row0 + ai * 128 + m * 16);
                const float xc[4] = {__uint_as_float(xw[ai][m].x << 16), __uint_as_float(xw[ai][m].x & 0xffff0000u), __uint_as_float(xw[ai][m].y << 16), __uint_as_float(xw[ai][m].y & 0xffff0000u)};
                unsigned w[8];
#pragma unroll
                for (int i = 0; i < 4; ++i) {
                    const float rf = sigmoidf_(acc[ai][0][m][0][i] + baf[i]), i_f = sigmoidf_(acc[ai][0][m][1][i] + bif[i]), rb = sigmoidf_(acc[ai][1][m][0][i] + bab[i]), ib = sigmoidf_(acc[ai][1][m][1][i] + bib[i]);
                    const float laf = rf * luf[i], lab = rb * lub[i];
                    const float bf_ = __builtin_amdgcn_sqrtf(nexpm1_small(2.0f * laf)) * i_f * xc[i], bb_ = __builtin_amdgcn_sqrtf(nexpm1_small(2.0f * lab)) * ib * xc[i];
                    w[2 * i] = cvt_pk_bf16(laf, bf_); w[2 * i + 1] = cvt_pk_bf16(lab, bb_);
                }
                u32x4* dp = (u32x4*)(lab_ + (row * 512 + c) * 4);
                dp[0] = (u32x4){w[0], w[1], w[2], w[3]}; dp[1] = (u32x4){w[4], w[5], w[6], w[7]};
            }
    }
};
struct EpiUkv {
    static __device__ __forceinline__ bool keeps(const Unit&) { return false; }
    static constexpr bool PERM = false;
    bf16_t* km_; bf16_t* vmt_;
    __device__ __forceinline__ void operator()(const g8::Acc& acc, const Unit& u, int wr, int wc, int fr, int fq) const {
        const int b = u.pm / 17, nb = (u.pm - b * 17) * 256 + wr * 64 + fr;
#pragma unroll
        for (int bj = 0; bj < 2; ++bj) { const int h = u.pn * 2 + bj; const size_t bh = (size_t)b * 8 + h;
#pragma unroll
            for (int n = 0; n < 2; ++n) { const int j = wc * 32 + n * 16 + fq * 4;
#pragma unroll
                for (int ai = 0; ai < 2; ++ai) if ((u.hmask >> ai) & 1)
#pragma unroll
                    for (int m = 0; m < 4; ++m) { const int nn = nb + ai * 128 + m * 16; const f32x4 v = acc[ai][bj][m][n];
                        if (wc < 2) { u32x2 w; w.x = cvt_pk_bf16(v[0], v[1]); w.y = cvt_pk_bf16(v[2], v[3]); *(u32x2*)(km_ + (bh * TPB + nn) * 64 + j) = w; }
                        else {
                            float a0 = v[0], a1 = v[1], a2 = v[2], a3 = v[3];
                            { const bool bq = (fr & 2) != 0; const float s0 = bq ? a0 : a2, s1 = bq ? a1 : a3; const float r0 = dpp_f<0x4E>(s0), r1 = dpp_f<0x4E>(s1); if (bq) { a0 = r0; a1 = r1; } else { a2 = r0; a3 = r1; } }
                            { const bool cq = (fr & 1) != 0; const float s0 = cq ? a0 : a1, s1 = cq ? a2 : a3; const float r0 = dpp_f<0xB1>(s0), r1 = dpp_f<0xB1>(s1); if (cq) { a0 = r0; a2 = r1; } else { a1 = r0; a3 = r1; } }
                            u32x2 w; w.x = cvt_pk_bf16(a0, a1); w.y = cvt_pk_bf16(a2, a3);
                            *(u32x2*)(vmt_ + (bh * 64 + (j - 64) + (fr & 3)) * TPB + (nn & ~3)) = w; } } } }
    }
};
struct EpiUq {
    static __device__ __forceinline__ bool keeps(const Unit&) { return false; }
    static constexpr bool PERM = false;
    bf16_t* qm_; const float* cm_; const float* sm_;
    __device__ __forceinline__ void operator()(const g8::Acc& acc, const Unit& u, int wr, int wc, int fr, int fq) const {
        const int b = u.pm / 17, nb = (u.pm - b * 17) * 256 + wr * 64 + fr; const bool lat = (u.pm - b * 17) != 0;
#pragma unroll
        for (int bj = 0; bj < 2; ++bj) { const int G = (u.pn * 256 + bj * 128 + wc * 32) >> 5, h = G / 3, gg = G - h * 3; const size_t bh = (size_t)b * 8 + h;
#pragma unroll
            for (int ai = 0; ai < 2; ++ai) if ((u.hmask >> ai) & 1)
#pragma unroll
                for (int m = 0; m < 4; ++m) { const int nn = nb + ai * 128 + m * 16; f32x4 v0 = acc[ai][bj][m][0] * QSCALE_M, v1 = acc[ai][bj][m][1] * QSCALE_M;
                    bf16_t* qp = qm_ + (bh * TPB + nn) * 96 + gg * 32 + fq * 4;
                    if (ABL != 5 && gg == 2 && lat) { const f32x4 cs = *(const f32x4*)(cm_ + (size_t)(nn - NCTX) * 16 + fq * 4), sn = *(const f32x4*)(sm_ + (size_t)(nn - NCTX) * 16 + fq * 4);
                        const f32x4 o0 = v0 * cs - v1 * sn, o1 = v0 * sn + v1 * cs; v0 = o0; v1 = o1; }
                    u32x2 w0, w1; w0.x = cvt_pk_bf16(v0[0], v0[1]); w0.y = cvt_pk_bf16(v0[2], v0[3]); w1.x = cvt_pk_bf16(v1[0], v1[1]); w1.y = cvt_pk_bf16(v1[2], v1[3]);
                    *(u32x2*)qp = w0; *(u32x2*)(qp + 16) = w1; } }
    }
};
struct EpiGateU8 {
    static __device__ __forceinline__ bool keeps(const Unit&) { return false; }
    static constexpr bool PERM = true;
    unsigned char* g8_;
    __device__ __forceinline__ void operator()(const g8::Acc& acc, const Unit& u, int wr, int wc, int fr, int fq) const {
        const int row0 = u.pm * 256 + wr * 64 + fr, col0 = u.pn * 256 + wc * 32 + 8 * fq;
#pragma unroll
        for (int ai = 0; ai < 2; ++ai) if ((u.hmask >> ai) & 1)
#pragma unroll
            for (int m = 0; m < 4; ++m)
#pragma unroll
                for (int bj = 0; bj < 2; ++bj) { const f32x4 v0 = acc[ai][bj][m][0], v1 = acc[ai][bj][m][1]; const float f[8] = {v0[0], v0[1], v0[2], v0[3], v1[0], v1[1], v1[2], v1[3]};
                    u32x2 w = {0u, 0u};
#pragma unroll
                    for (int j = 0; j < 4; ++j) { w.x = __builtin_amdgcn_cvt_pk_u8_f32(fmaxf(sigmoidf_(f[j]) * 255.0f, 1.0f), j, w.x); w.y = __builtin_amdgcn_cvt_pk_u8_f32(fmaxf(sigmoidf_(f[4 + j]) * 255.0f, 1.0f), j, w.y); }
                    *(u32x2*)(g8_ + (size_t)(row0 + ai * 128 + m * 16) * 3072 + col0 + bj * 128) = w; }
    }
};
struct EpiGateI8 {
    static __device__ __forceinline__ bool keeps(const Unit&) { return false; }
    static constexpr bool PERM = true;
    static constexpr bool I8 = true;
    unsigned char* g8_; const float* rs_; const float* cm_;
    __device__ __forceinline__ void operator()(const g8::Acc& acc, const Unit& u, int wr, int wc, int fr, int fq) const {
        asm volatile("" : "+v"(fr), "+v"(fq));
        const int row0 = u.pm * 256 + wr * 64 + fr, col0 = u.pn * 256 + wc * 32 + 8 * fq;
        f32x4 cs[2][2];
#pragma unroll
        for (int bj = 0; bj < 2; ++bj)
#pragma unroll
            for (int h = 0; h < 2; ++h) cs[bj][h] = *(const f32x4*)(cm_ + col0 + bj * 128 + 4 * h) * (-LOG2E_ / 127.0f);
        float rsv[2][4];
#pragma unroll
        for (int ai = 0; ai < 2; ++ai)
#pragma unroll
            for (int m = 0; m < 4; ++m) rsv[ai][m] = rs_[row0 + ai * 128 + m * 16];
#pragma unroll
        for (int ai = 0; ai < 2; ++ai) if ((u.hmask >> ai) & 1)
#pragma unroll
            for (int m = 0; m < 4; ++m)
#pragma unroll
                for (int bj = 0; bj < 2; ++bj) { const g8::i32x4 v0 = __builtin_bit_cast(g8::i32x4, acc[ai][bj][m][0]), v1 = __builtin_bit_cast(g8::i32x4, acc[ai][bj][m][1]); const float rs = rsv[ai][m];
                    u32x2 w = {0u, 0u};
#pragma unroll
                    for (int j = 0; j < 4; ++j) {
                        const float s0 = __builtin_amdgcn_rcpf(1.0f + __builtin_amdgcn_exp2f((float)v0[j] * rs * cs[bj][0][j])), s1 = __builtin_amdgcn_rcpf(1.0f + __builtin_amdgcn_exp2f((float)v1[j] * rs * cs[bj][1][j]));
                        w.x = __builtin_amdgcn_cvt_pk_u8_f32(fmaxf(s0 * 255.0f, 1.0f), j, w.x); w.y = __builtin_amdgcn_cvt_pk_u8_f32(fmaxf(s1 * 255.0f, 1.0f), j, w.y); }
                    *(u32x2*)(g8_ + (size_t)(row0 + ai * 128 + m * 16) * 3072 + col0 + bj * 128) = w; }
    }
};
struct EpiMerge {
    static constexpr bool PERM = true;
    static __device__ __forceinline__ bool keeps(const Unit& u) { return u.aux < 2; }
    bf16_t* mb_; const unsigned char* g8_;
    __device__ __forceinline__ void operator()(g8::Acc& acc, const Unit& u, int wr, int wc, int fr_, int fq_) const {
        int fr = fr_, fq = fq_; asm volatile("" : "+v"(fr), "+v"(fq));
        const int row0 = u.pm * 256 + wr * 64 + fr, col0 = u.pn * 256 + wc * 32 + 8 * fq; const int k = u.aux;
        const unsigned char* ga = g8_ + k * 1024 + col0; const unsigned char* gb = g8_ + (k < 2 ? k + 1 : k) * 1024 + col0;
#pragma unroll
        for (int am = 0; am < 4; ++am) {
            const int ai = am >> 1, m0 = (am & 1) * 2;
            if (!((u.hmask >> ai) & 1)) continue;
            u32x2 wa[2][2], wb2[2][2];
#pragma unroll
            for (int mm = 0; mm < 2; ++mm)
#pragma unroll
                for (int bj = 0; bj < 2; ++bj) { const size_t o = (size_t)(row0 + ai * 128 + (m0 + mm) * 16) * 3072 + bj * 128; wa[mm][bj] = *(const u32x2*)(ga + o); wb2[mm][bj] = *(const u32x2*)(gb + o); }
            asm volatile("" ::: "memory");
#pragma unroll
            for (int mm = 0; mm < 2; ++mm)
#pragma unroll
                for (int bj = 0; bj < 2; ++bj) { const int m = m0 + mm;
                    float sc[8];
#pragma unroll
                    for (int j = 0; j < 8; ++j) { const float a = (float)(((j < 4 ? wa[mm][bj].x : wa[mm][bj].y) >> (8 * (j & 3))) & 255u), bq = (float)(((j < 4 ? wb2[mm][bj].x : wb2[mm][bj].y) >> (8 * (j & 3))) & 255u);
                        sc[j] = k == 2 ? a * (1.0f / 255.0f) : a * __builtin_amdgcn_rcpf(bq); }
                    const f32x4 v0 = acc[ai][bj][m][0] * (f32x4){sc[0], sc[1], sc[2], sc[3]}, v1 = acc[ai][bj][m][1] * (f32x4){sc[4], sc[5], sc[6], sc[7]};
                    acc[ai][bj][m][0] = v0; acc[ai][bj][m][1] = v1;
                    if (k == 2) { u32x4 w; w.x = cvt_pk_bf16(v0[0], v0[1]); w.y = cvt_pk_bf16(v0[2], v0[3]); w.z = cvt_pk_bf16(v1[0], v1[1]); w.w = cvt_pk_bf16(v1[2], v1[3]);
                        *(u32x4*)(mb_ + (size_t)(row0 + ai * 128 + m * 16) * 1024 + col0 + bj * 128) = w; }
                }
            asm volatile("" ::: "memory");
        }
    }
};
struct EpiOut {
    static __device__ __forceinline__ bool keeps(const Unit&) { return false; }
    static constexpr bool PERM = false;
    bf16_t* xb_; const float* in_; const float* inc_; const float* mod_;
    __device__ __forceinline__ void operator()(const g8::Acc& acc, const Unit& u, int wr, int wc, int fr, int fq) const {
        const int b = u.pm / 17, pt = u.pm - b * 17; const bool isctx = pt == 0;
        if (ABL == 7 && isctx) return;
        const float* ga = mod_ + (size_t)(isctx ? 8 : b) * 6144 + 2048;
        const int r0 = wr * 64 + fr, col0 = u.pn * 256 + wc * 32 + 4 * fq;
        bf16_t* xrow = xb_ + (size_t)(u.pm * 256 + r0) * DM + col0;
        f32x4 g[2][2];
#pragma unroll
        for (int bj = 0; bj < 2; ++bj)
#pragma unroll
            for (int n = 0; n < 2; ++n) g[bj][n] = *(const f32x4*)(ga + col0 + bj * 128 + n * 16);
#pragma unroll
        for (int ai = 0; ai < 2; ++ai) { if (!((u.hmask >> ai) & 1)) continue;
            f32x4 r[4][2][2];
            if (in_) { const float* rbase = (isctx ? inc_ + (size_t)b * NCTX * DM : in_ + ((size_t)b * SEQ + (size_t)(pt - 1) * 256) * DM) + (size_t)r0 * DM + col0;
#pragma unroll
                for (int m = 0; m < 4; ++m)
#pragma unroll
                    for (int bj = 0; bj < 2; ++bj)
#pragma unroll
                        for (int n = 0; n < 2; ++n) r[m][bj][n] = *(const f32x4*)(rbase + (size_t)(ai * 128 + m * 16) * DM + bj * 128 + n * 16);
            } else { u32x2 q[4][2][2];
#pragma unroll
                for (int m = 0; m < 4; ++m)
#pragma unroll
                    for (int bj = 0; bj < 2; ++bj)
#pragma unroll
                        for (int n = 0; n < 2; ++n) q[m][bj][n] = *(const u32x2*)(xrow + (size_t)(ai * 128 + m * 16) * DM + bj * 128 + n * 16);
                asm volatile("" ::: "memory");
#pragma unroll
                for (int m = 0; m < 4; ++m)
#pragma unroll
                    for (int bj = 0; bj < 2; ++bj)
#pragma unroll
                        for (int n = 0; n < 2; ++n) r[m][bj][n] = unpack4(q[m][bj][n]);
            }
            asm volatile("" ::: "memory");
#pragma unroll
            for (int m = 0; m < 4; ++m)
#pragma unroll
                for (int bj = 0; bj < 2; ++bj)
#pragma unroll
                    for (int n = 0; n < 2; ++n) *(u32x2*)(xrow + (size_t)(ai * 128 + m * 16) * DM + bj * 128 + n * 16) = pack4(r[m][bj][n] + g[bj][n] * acc[ai][bj][m][n]);
            asm volatile("" ::: "memory");
        }
    }
};
struct EpiMoe1 {
    static __device__ __forceinline__ bool keeps(const Unit&) { return false; }
    static constexpr bool PERM = false;
    bf16_t* he_;
    __device__ __forceinline__ void operator()(const g8::Acc& acc, const Unit& u, int wr, int wc, int fr, int fq) const {
        const int row0 = u.pm * 256 + wr * 64 + fr;
#pragma unroll
        for (int bj = 0; bj < 2; ++bj) { const int j0 = u.pn * 128 + bj * 64 + wc * 16 + fq * 4;
#pragma unroll
            for (int ai = 0; ai < 2; ++ai) if ((u.hmask >> ai) & 1)
#pragma unroll
                for (int m = 0; m < 4; ++m) { const f32x4 a = acc[ai][bj][m][0], bb = acc[ai][bj][m][1]; float o[4];
#pragma unroll
                    for (int j = 0; j < 4; ++j) o[j] = a[j] * sigmoidf_(a[j]) * bb[j];
                    u32x2 w; w.x = cvt_pk_bf16(o[0], o[1]); w.y = cvt_pk_bf16(o[2], o[3]);
                    *(u32x2*)(he_ + (size_t)(row0 + ai * 128 + m * 16) * 256 + j0) = w; } }
    }
};
struct EpiMoe2 {
    static __device__ __forceinline__ bool keeps(const Unit&) { return false; }
    static constexpr bool PERM = true;
    bf16_t* y2_; const int* ltok_; const float* lp_;
    __device__ __forceinline__ void operator()(const g8::Acc& acc, const Unit& u, int wr, int wc, int fr_, int fq_) const {
        int fr = fr_, fq = fq_; asm volatile("" : "+v"(fr), "+v"(fq));
        const int row0 = u.pm * 256 + wr * 64 + fr, col0 = u.pn * 256 + wc * 32 + 8 * fq;
        int tk[2][4]; float pw[2][4];
#pragma unroll
        for (int ai = 0; ai < 2; ++ai) if ((u.hmask >> ai) & 1)
#pragma unroll
            for (int m = 0; m < 4; ++m) { const int slot = row0 + ai * 128 + m * 16; tk[ai][m] = ltok_[slot]; pw[ai][m] = lp_[slot]; }
#pragma unroll
        for (int ai = 0; ai < 2; ++ai) if ((u.hmask >> ai) & 1)
#pragma unroll
            for (int m = 0; m < 4; ++m) {
                if (tk[ai][m] >= 0) { bf16_t* rowp = y2_ + (size_t)tk[ai][m] * 1024 + col0;
                    const float pq = ABL == 3 ? 0.f : pw[ai][m];
#pragma unroll
                    for (int bj = 0; bj < 2; ++bj) { const f32x4 v0 = acc[ai][bj][m][0] * pq, v1 = acc[ai][bj][m][1] * pq;
                        u32x4 w; w.x = cvt_pk_bf16(v0[0], v0[1]); w.y = cvt_pk_bf16(v0[2], v0[3]); w.z = cvt_pk_bf16(v1[0], v1[1]); w.w = cvt_pk_bf16(v1[2], v1[3]);
                        *(u32x4*)(rowp + bj * 128) = w; } } }
    }
};

__device__ __forceinline__ float half_max(float m) { auto rr = __builtin_amdgcn_permlane32_swap(__float_as_uint(m), __float_as_uint(m), false, false); return __builtin_fmaxf(__uint_as_float(rr[0]), __uint_as_float(rr[1])); }
__device__ __forceinline__ float half_sum(float m) { auto rr = __builtin_amdgcn_permlane32_swap(__float_as_uint(m), __float_as_uint(m), false, false); return __uint_as_float(rr[0]) + __uint_as_float(rr[1]); }
__device__ __forceinline__ float max3f(float a, float b, float c) { return __builtin_fmaxf(__builtin_fmaxf(a, b), c); }
__device__ __forceinline__ float max2f(float a, float b) { return __builtin_fmaxf(a, b); }
template <int DQK, int NQ, int NS, bool SAFE>
__device__ __forceinline__ bool attn_unit(
    LAS unsigned char* lds, const bf16_t* Q, const bf16_t* Kn, const bf16_t* Kr, const bf16_t* Vt, int nkeys, bf16_t* O  ) {
    constexpr int KB = 8192, RB_ = (DQK == 96) ? 4096 : 0, VB = 8192, SUB = KB + RB_ + VB, BUF = NS * SUB;
    constexpr int ND = DQK / 16;
    constexpr float THR = 8.0f;
    int tid_l = threadIdx.x; asm volatile("" : "+v"(tid_l));
    const int tid = tid_l, lane = tid & 63, r32 = lane & 31, hi = lane >> 5; const int wid = __builtin_amdgcn_readfirstlane(tid >> 6);
    LAS float* scr = (LAS float*)(lds + 2 * BUF) + wid * 32;
    bf16x8 qf[NQ][ND];
#pragma unroll
    for (int q = 0; q < NQ; ++q) { const bf16_t* qrow = Q + (size_t)((wid * NQ + q) * 32 + r32) * DQK + hi * 8;
#pragma unroll
      for (int d0 = 0; d0 < ND; ++d0) qf[q][d0] = *(const bf16x8*)(qrow + d0 * 16); }
    const int drow = wid * 8 + (lane >> 3), dch = (lane & 7) ^ ((drow >> 1) & 7);
    const unsigned ksrc = (unsigned)(drow * 128 + dch * 16);
    const unsigned vsrc = (unsigned)(drow * (TPB * 2) + dch * 16);
    const int rrow = (wid & 3) * 16 + (lane >> 2), rch = (lane & 3) ^ ((rrow >> 2) & 3);
    const unsigned rsrc = (unsigned)(rrow * 64 + rch * 16);
    const int NT = nkeys / (64 * NS);
    auto dma = [&](int t, int boff) {
#pragma unroll
        for (int u = 0; u < NS; ++u) { const int k0 = (t * NS + u) * 64; LAS unsigned char* sb = lds + boff + u * SUB;
            __builtin_amdgcn_global_load_lds((const unsigned*)((const char*)Kn + (unsigned)(ksrc + (unsigned)k0 * 128u)), (LAS unsigned*)(sb + wid * 1024), 16, 0, 0);
            if (DQK == 96) { if (wid < 4) __builtin_amdgcn_global_load_lds((const unsigned*)((const char*)Kr + (unsigned)(rsrc + (unsigned)k0 * 64u)), (LAS unsigned*)(sb + KB + wid * 1024), 16, 0, 0); }
            __builtin_amdgcn_global_load_lds((const unsigned*)((const char*)Vt + (unsigned)(vsrc + (unsigned)k0 * 2u)), (LAS unsigned*)(sb + KB + RB_ + wid * 1024), 16, 0, 0); }
    };
    dma(0, 0);
    asm volatile("s_waitcnt vmcnt(0)" ::: "memory");
    __syncthreads();
    f32x16 o0[NQ], o1[NQ]; float m_run[NQ], l_run[NQ]; bool zref[NQ];
#pragma unroll
    for (int q = 0; q < NQ; ++q) { o0[q] = f32x16{}; o1[q] = f32x16{}; m_run[q] = 0.f; l_run[q] = 0.f; zref[q] = true; }
    const int ksw = (r32 & 19) | ((r32 & 4) << 1) | ((r32 & 8) >> 1);
    const int kro = ksw * 128, ksx = (ksw >> 1) & 7, rro = ksw * 64, rsx = (ksw >> 2) & 3, vro = r32 * 128, vsx = (r32 >> 1) & 7;
    for (int t = 0; t < NT; ++t) {
        if (t + 1 < NT) dma(t + 1, ((t + 1) & 1) * BUF);
        const LAS unsigned char* bb = lds + (t & 1) * BUF;
#pragma unroll
        for (int u = 0; u < NS; ++u) {
            const LAS unsigned char* kb = bb + u * SUB; const LAS unsigned char* rb = kb + KB; const LAS unsigned char* vb = rb + RB_;
            f32x16 p0[NQ], p1[NQ];
#pragma unroll
            for (int q = 0; q < NQ; ++q) { p0[q] = f32x16{}; p1[q] = f32x16{}; }
            __builtin_amdgcn_s_setprio(1);
#pragma unroll
            for (int d0 = 0; d0 < ND; ++d0) {
                bf16x8 a0, a1;
                if (d0 < 4) { const int off = kro + (((2 * d0 + hi) ^ ksx) << 4); a0 = *(const LAS bf16x8*)(kb + off); a1 = *(const LAS bf16x8*)(kb + 4096 + off); }
                else { const int off = rro + (((2 * (d0 - 4) + hi) ^ rsx) << 4); a0 = *(const LAS bf16x8*)(rb + off); a1 = *(const LAS bf16x8*)(rb + 2048 + off); }
#pragma unroll
                for (int q = 0; q < NQ; ++q) { p0[q] = __builtin_amdgcn_mfma_f32_32x32x16_bf16(a0, qf[q][d0], p0[q], 0, 0, 0); p1[q] = __builtin_amdgcn_mfma_f32_32x32x16_bf16(a1, qf[q][d0], p1[q], 0, 0, 0); }
            }
            __builtin_amdgcn_s_setprio(0);
            bf16x8 pa[NQ][4];
#pragma unroll
            for (int q = 0; q < NQ; ++q) {
                if (ABL == 4) { p0[q] = f32x16{}; p1[q] = f32x16{}; }
                if (SAFE) {
                    float mx = max2f(p0[q][0], p1[q][0]);
#pragma unroll
                    for (int r = 1; r < 16; ++r) mx = max3f(mx, p0[q][r], p1[q][r]);
                    mx = half_max(mx);
                    const bool first = (t == 0 && u == 0);
                    if (first ? __any(__builtin_fabsf(mx) > THR) : __any(mx - m_run[q] > THR)) {
                        const float m_new = first ? mx : max2f(m_run[q], mx); const float alpha = first ? 1.0f : __builtin_amdgcn_exp2f(m_run[q] - m_new);
                        m_run[q] = m_new; l_run[q] *= alpha; zref[q] = false;
                        if (hi == 0) scr[r32] = alpha;
#pragma unroll
                        for (int r = 0; r < 16; ++r) { const float al = scr[(r & 3) + 8 * (r >> 2) + 4 * hi]; o0[q][r] *= al; o1[q][r] *= al; }
                    }
                }
                float ps = 0.f;
                if (!SAFE || zref[q]) {
#pragma unroll
                    for (int r = 0; r < 16; ++r) { p0[q][r] = __builtin_amdgcn_exp2f(p0[q][r]); ps += p0[q][r]; }
#pragma unroll
                    for (int r = 0; r < 16; ++r) { p1[q][r] = __builtin_amdgcn_exp2f(p1[q][r]); ps += p1[q][r]; }
                } else {
                    const float mr = m_run[q];
#pragma unroll
                    for (int r = 0; r < 16; ++r) { p0[q][r] = __builtin_amdgcn_exp2f(p0[q][r] - mr); ps += p0[q][r]; }
#pragma unroll
                    for (int r = 0; r < 16; ++r) { p1[q][r] = __builtin_amdgcn_exp2f(p1[q][r] - mr); ps += p1[q][r]; }
                }
                l_run[q] += ps;
                u32x4 w; const f32x16& a = p0[q]; const f32x16& c = p1[q];
                w.x = cvt_pk_bf16(a[0], a[1]); w.y = cvt_pk_bf16(a[2], a[3]); w.z = cvt_pk_bf16(a[4], a[5]); w.w = cvt_pk_bf16(a[6], a[7]); pa[q][0] = __builtin_bit_cast(bf16x8, w);
                w.x = cvt_pk_bf16(a[8], a[9]); w.y = cvt_pk_bf16(a[10], a[11]); w.z = cvt_pk_bf16(a[12], a[13]); w.w = cvt_pk_bf16(a[14], a[15]); pa[q][1] = __builtin_bit_cast(bf16x8, w);
                w.x = cvt_pk_bf16(c[0], c[1]); w.y = cvt_pk_bf16(c[2], c[3]); w.z = cvt_pk_bf16(c[4], c[5]); w.w = cvt_pk_bf16(c[6], c[7]); pa[q][2] = __builtin_bit_cast(bf16x8, w);
                w.x = cvt_pk_bf16(c[8], c[9]); w.y = cvt_pk_bf16(c[10], c[11]); w.z = cvt_pk_bf16(c[12], c[13]); w.w = cvt_pk_bf16(c[14], c[15]); pa[q][3] = __builtin_bit_cast(bf16x8, w);
            }
#pragma unroll
            for (int s = 0; s < 4; ++s) {
                const int off = vro + (((2 * s + hi) ^ vsx) << 4);
                const bf16x8 v0 = *(const LAS bf16x8*)(vb + off);
                const bf16x8 v1 = *(const LAS bf16x8*)(vb + 4096 + off);
#pragma unroll
                for (int q = 0; q < NQ; ++q) { o0[q] = __builtin_amdgcn_mfma_f32_32x32x16_bf16(pa[q][s], v0, o0[q], 0, 0, 0); o1[q] = __builtin_amdgcn_mfma_f32_32x32x16_bf16(pa[q][s], v1, o1[q], 0, 0, 0); }
            }
            if (NQ > 1) __builtin_amdgcn_sched_barrier(0);
        }
        asm volatile("s_waitcnt vmcnt(0)" ::: "memory");
        __syncthreads();
    }
    bool bad = false;
#pragma unroll
    for (int q = 0; q < NQ; ++q) {
        const float lt = half_sum(l_run[q]);
        bad = bad || !(lt > 7.9e-31f && lt < 1.2e30f);
        if (hi == 0) scr[r32] = 1.0f / lt;
        bf16_t* orow = O + (size_t)((wid * NQ + q) * 32) * 512;
#pragma unroll
        for (int r = 0; r < 16; ++r) { const int qq = (r & 3) + 8 * (r >> 2) + 4 * hi; const float il = scr[qq];
            orow[(size_t)qq * 512 + r32] = f2bf(ABL == 1 ? 0.f : o0[q][r] * il); orow[(size_t)qq * 512 + 32 + r32] = f2bf(ABL == 1 ? 0.f : o1[q][r] * il); }
    }
    __syncthreads();
    return !SAFE && (__any(bad) || ABL == 6);
}
#ifndef ATTN_PRIO
#define ATTN_PRIO 4
#endif
template <int DQK, int NS>
__device__ __forceinline__ bool attn16_unit(LAS unsigned char* lds, const bf16_t* Q, const bf16_t* Kn, const bf16_t* Kr, const bf16_t* Vt, int nkeys, bf16_t* O) {
    constexpr int KB = 8192, RB_ = (DQK == 96) ? 4096 : 0, VB = 8192, SUB = KB + RB_ + VB, BUF = NS * SUB;
    constexpr int KS = DQK / 32;
    int tid_l = threadIdx.x; asm volatile("" : "+v"(tid_l));
    const int tid = tid_l, lane = tid & 63, li = lane & 15, g = lane >> 4; const int wid = __builtin_amdgcn_readfirstlane(tid >> 6);
    LAS float* scr = (LAS float*)(lds + 2 * BUF) + wid * 64;
    bf16x8 qf[4][KS];
#pragma unroll
    for (int qt = 0; qt < 4; ++qt) { const bf16_t* qrow = Q + (size_t)(wid * 64 + qt * 16 + li) * DQK + g * 8;
#pragma unroll
        for (int ks = 0; ks < KS; ++ks) qf[qt][ks] = *(const bf16x8*)(qrow + ks * 32); }
    const int drow = wid * 8 + (lane >> 3), dch = (lane & 7) ^ (2 * ((drow >> 1) & 1) + 4 * ((drow >> 3) & 1));
    const unsigned ksrc = (unsigned)(drow * 128 + dch * 16), vsrc = (unsigned)(drow * (TPB * 2) + dch * 16);
    const int rrow = (wid & 3) * 16 + (lane >> 2), rch = (lane & 3) ^ (2 * ((rrow >> 3) & 1));
    const unsigned rsrc = (unsigned)(rrow * 64 + rch * 16);
    const int NT = nkeys / (64 * NS);
    auto dma = [&](int t, int boff) {
#pragma unroll
        for (int u = 0; u < NS; ++u) { const int k0 = (t * NS + u) * 64; LAS unsigned char* sb = lds + boff + u * SUB;
            __builtin_amdgcn_global_load_lds((const unsigned*)((const char*)Kn + (unsigned)(ksrc + (unsigned)k0 * 128u)), (LAS unsigned*)(sb + wid * 1024), 16, 0, 0);
            if (DQK == 96) { if (wid < 4) __builtin_amdgcn_global_load_lds((const unsigned*)((const char*)Kr + (unsigned)(rsrc + (unsigned)k0 * 64u)), (LAS unsigned*)(sb + KB + wid * 1024), 16, 0, 0); }
            __builtin_amdgcn_global_load_lds((const unsigned*)((const char*)Vt + (unsigned)(vsrc + (unsigned)k0 * 2u)), (LAS unsigned*)(sb + KB + RB_ + wid * 1024), 16, 0, 0); }
    };
    dma(0, 0);
    asm volatile("s_waitcnt vmcnt(0)" ::: "memory");
    __syncthreads();
    f32x4 o[4][4], ol[4];
#pragma unroll
    for (int qt = 0; qt < 4; ++qt) { ol[qt] = (f32x4){0.f, 0.f, 0.f, 0.f};
#pragma unroll
        for (int dt = 0; dt < 4; ++dt) o[qt][dt] = (f32x4){0.f, 0.f, 0.f, 0.f}; }
    const bf16x8 ones = {(short)0x3F80, (short)0x3F80, (short)0x3F80, (short)0x3F80, (short)0x3F80, (short)0x3F80, (short)0x3F80, (short)0x3F80};
    const int krow = 8 * (li >> 2) + (li & 3), fk = 2 * ((li >> 1) & 1) + 4 * ((li >> 2) & 1), fr = 2 * ((li >> 2) & 1);
    const int fv = 2 * ((li >> 1) & 1) + 4 * ((li >> 3) & 1);
    for (int t = 0; t < NT; ++t) {
        if (t + 1 < NT) dma(t + 1, ((t + 1) & 1) * BUF);
        const LAS unsigned char* bb = lds + (t & 1) * BUF;
#pragma unroll
        for (int u = 0; u < NS; ++u) {
            const LAS unsigned char* kb = bb + u * SUB; const LAS unsigned char* rb = kb + KB; const LAS unsigned char* vb = rb + RB_;
#pragma unroll
            for (int b32 = 0; b32 < 2; ++b32) {
                f32x4 sT[2][4];
#pragma unroll
                for (int T2 = 0; T2 < 2; ++T2)
#pragma unroll
                    for (int qt = 0; qt < 4; ++qt) sT[T2][qt] = (f32x4){0.f, 0.f, 0.f, 0.f};
                if (ATTN_PRIO) __builtin_amdgcn_s_setprio(ATTN_PRIO == 4 ? 2 : 1);
#pragma unroll
                for (int ks = 0; ks < KS; ++ks) {
                    bf16x8 kf[2];
#pragma unroll
                    for (int T2 = 0; T2 < 2; ++T2) { const int row = 32 * b32 + 4 * T2 + krow;
                        kf[T2] = ks < 2 ? *(const LAS bf16x8*)(kb + row * 128 + (((4 * ks + g) ^ fk) << 4)) : *(const LAS bf16x8*)(rb + row * 64 + ((g ^ fr) << 4)); }
#pragma unroll
                    for (int T2 = 0; T2 < 2; ++T2)
#pragma unroll
                        for (int qt = 0; qt < 4; ++qt) sT[T2][qt] = __builtin_amdgcn_mfma_f32_16x16x32_bf16(kf[T2], qf[qt][ks], sT[T2][qt], 0, 0, 0);
                }
                if (ATTN_PRIO && ATTN_PRIO != 3) __builtin_amdgcn_s_setprio(ATTN_PRIO == 4 ? 1 : 0);
                bf16x8 pf[4];
#pragma unroll
                for (int qt = 0; qt < 4; ++qt) {
                    float e[8];
#pragma unroll
                    for (int j = 0; j < 4; ++j) { e[j] = __builtin_amdgcn_exp2f(ABL == 4 ? 0.f : sT[0][qt][j]); e[4 + j] = __builtin_amdgcn_exp2f(ABL == 4 ? 0.f : sT[1][qt][j]); }
                    u32x4 w; w.x = cvt_pk_bf16(e[0], e[1]); w.y = cvt_pk_bf16(e[2], e[3]); w.z = cvt_pk_bf16(e[4], e[5]); w.w = cvt_pk_bf16(e[6], e[7]); pf[qt] = __builtin_bit_cast(bf16x8, w);
                }
                bf16x8 vf[4];
#pragma unroll
                for (int dt = 0; dt < 4; ++dt) vf[dt] = *(const LAS bf16x8*)(vb + (16 * dt + li) * 128 + (((4 * b32 + g) ^ fv) << 4));
                if (ATTN_PRIO == 3 || ATTN_PRIO == 4) __builtin_amdgcn_s_setprio(0);
                if (ATTN_PRIO == 2) __builtin_amdgcn_s_setprio(1);
#pragma unroll
                for (int qt = 0; qt < 4; ++qt) {
#pragma unroll
                    for (int dt = 0; dt < 4; ++dt) o[qt][dt] = __builtin_amdgcn_mfma_f32_16x16x32_bf16(pf[qt], vf[dt], o[qt][dt], 0, 0, 0);
                    ol[qt] = __builtin_amdgcn_mfma_f32_16x16x32_bf16(pf[qt], ones, ol[qt], 0, 0, 0); }
                if (ATTN_PRIO == 2) __builtin_amdgcn_s_setprio(0);
                __builtin_amdgcn_sched_barrier(0);
            }
        }
        asm volatile("s_waitcnt vmcnt(0)" ::: "memory");
        __syncthreads();
    }
    bool bad = false;
#pragma unroll
    for (int qt = 0; qt < 4; ++qt)
#pragma unroll
        for (int r = 0; r < 4; ++r) { const float lt = ol[qt][r]; bad = bad || !(lt > 7.9e-31f && lt < 1.2e30f); }
#pragma unroll
    for (int qt = 0; qt < 4; ++qt)
#pragma unroll
        for (int r = 0; r < 4; ++r) { const float il = 1.0f / ol[qt][r]; bf16_t* orow = O + (size_t)(wid * 64 + qt * 16 + 4 * g + r) * 512 + li;
#pragma unroll
            for (int dt = 0; dt < 4; ++dt) orow[dt * 16] = f2bf(ABL == 1 ? 0.f : o[qt][dt][r] * il); }
    __syncthreads();
    return __any(bad) || ABL == 6;
}

template <int DQK, int NQ, int NS>
__device__ __forceinline__ void attn_run(LAS unsigned char* lds, const bf16_t* Q, const bf16_t* Kn, const bf16_t* Kr, const bf16_t* Vt, int nkeys, bf16_t* O) {
    const bool bad = NQ == 2 ? attn16_unit<DQK, NS>(lds, Q, Kn, Kr, Vt, nkeys, O) : attn_unit<DQK, NQ, NS, false>(lds, Q, Kn, Kr, Vt, nkeys, O);
    LAS unsigned* flag = (LAS unsigned*)(lds + 160 * 1024 - 64);
    int t_ = threadIdx.x; asm volatile("" : "+v"(t_));
    if (t_ == 0) *flag = 0u;
    __syncthreads();
    if (bad && (t_ & 63) == 0) *flag = 1u;
    __syncthreads();
    const unsigned any_bad = *flag;
    __syncthreads();
    if (any_bad) {
#pragma unroll
        for (int h = 0; h < NQ; ++h) attn_unit<DQK, 1, NS, true>(lds, Q + (size_t)h * 256 * DQK, Kn, Kr, Vt, nkeys, O + (size_t)h * 256 * 512);
    }
}

template <class F>
__device__ __forceinline__ void cvt_tile(LAS unsigned char* buf, bf16_t* dst, int dst_ld, int tid, F srcp) {
    const int w = tid >> 6, lane = tid & 63;
    f32x4 v[8];
#pragma unroll
    for (int i = 0; i < 8; ++i) { const float* sp = srcp(8 * w + i, lane); v[i] = sp ? *(const f32x4*)sp : (f32x4){0.f, 0.f, 0.f, 0.f}; }
#pragma unroll
    for (int j = 0; j < 4; ++j) { u32x4 o; o.x = cvt_pk_bf16(v[0][j], v[1][j]); o.y = cvt_pk_bf16(v[2][j], v[3][j]); o.z = cvt_pk_bf16(v[4][j], v[5][j]); o.w = cvt_pk_bf16(v[6][j], v[7][j]);
        const int n = 4 * lane + j; *(LAS u32x4*)(buf + n * 128 + ((w ^ (lane & 7)) << 4)) = o; }
    __syncthreads();
#pragma unroll
    for (int i = 0; i < 4; ++i) { const int e = tid + i * 512, n = e >> 3, c = e & 7; const u32x4 o = *(const LAS u32x4*)(buf + n * 128 + ((c ^ ((n >> 2) & 7)) << 4));
        *(u32x4*)(dst + (size_t)n * dst_ld + c * 8) = o; }
}

template <class F>
__device__ __forceinline__ void cvt_tile_i8(LAS unsigned char* buf, unsigned char* dst, int dst_ld, int tid, const float* cmax, F srcp) {
    const int w = tid >> 6, lane = tid & 63;
    f32x4 v[8];
#pragma unroll
    for (int i = 0; i < 8; ++i) { const float* sp = srcp(8 * w + i, lane); v[i] = sp ? *(const f32x4*)sp : (f32x4){0.f, 0.f, 0.f, 0.f}; }
    const f32x4 cm = *(const f32x4*)(cmax + 4 * lane);
#pragma unroll
    for (int j = 0; j < 4; ++j) { const float sc = 127.0f / fmaxf(cm[j], 1e-30f); u32x2 o; o.x = pack_i8x4(v[0][j], v[1][j], v[2][j], v[3][j], sc); o.y = pack_i8x4(v[4][j], v[5][j], v[6][j], v[7][j], sc);
        *(LAS u32x2*)(buf + (4 * lane + j) * 64 + w * 8) = o; }
    __syncthreads();
#pragma unroll
    for (int i = 0; i < 2; ++i) { const int e = tid + i * 512, n = e >> 2, c = e & 3; *(u32x4*)(dst + (size_t)n * dst_ld + c * 16) = *(const LAS u32x4*)(buf + n * 64 + c * 16); }
}

constexpr int LDS_BYTES = 163840;
constexpr int NPH_PRO = 1;
constexpr int NPH_LAYER = 15;
constexpr int PH_FINAL = NPH_PRO + NLAYER * NPH_LAYER;
constexpr int NPHASE = PH_FINAL + 1;

__global__ void __launch_bounds__(512, 2) mega(Params kp) {
    extern __shared__ __attribute__((aligned(16))) unsigned char lds_raw[];
    LAS unsigned char* lds = (LAS unsigned char*)lds_raw;
    const int ph_lo = kp.lo, ph_hi = kp.hi;
    typedef const __attribute__((address_space(4))) Params* KPtr;
#define PHK() int koff_ = 0, Gl_ = gridDim.x, bidl_ = blockIdx.x; asm volatile("" : "+s"(koff_), "+s"(Gl_), "+s"(bidl_)); const int G = Gl_, bid = bidl_; (void)G; (void)bid; const KPtr KP = (KPtr)((const __attribute__((address_space(4))) char*)__builtin_amdgcn_kernarg_segment_ptr() + koff_)
#define LTID() PHK(); int tid_l = threadIdx.x; asm volatile("" : "+v"(tid_l)); const int tid = tid_l, lane = tid & 63; const int wid = __builtin_amdgcn_readfirstlane(tid >> 6); (void)lane; (void)wid
    unsigned* ctl = (unsigned*)(kp.ws + WS_CTL);
    volatile LAS unsigned* xbw = (volatile LAS unsigned*)(lds + LDS_BYTES - 16);
    if (threadIdx.x == 0) { xbw[0] = 0u; xbw[1] = 0u; xbw[2] = 0u; xbw[3] = 0u; }
    __syncthreads();
    XcdBarrier bar = xcd_barrier_post(ctl + CW_BAR, xbw);
#define RUN(id) (ph_lo <= (id) && (id) < ph_hi)
#define SEAM(id) do { if (ph_lo <= (id) && (id) + 1 < ph_hi) { xcd_barrier(bar); if (DUP == 15) xcd_barrier(bar); } } while (0)

#define modv ((float*)(KP->ws + WS_MOD))
#define cosG ((float*)(KP->ws + WS_ROPE))
#define sinG (cosG + 4096 * 32)
#define cosM (cosG + 2 * 4096 * 32)
#define sinM (cosG + 2 * 4096 * 32 + 4096 * 16)
#define lrut ((float*)(KP->ws + WS_LRUT))
#define wrt ((float*)(KP->ws + WS_WRT))
#define carry ((f32x2*)(KP->ws + WS_CARRY))
#define sel ((int*)(KP->ws + WS_SEL))
#define list_tok ((int*)(KP->ws + WS_LIST))
#define list_p ((float*)(KP->ws + WS_LIST + (size_t)MAXSLOT * 4))
#define tile_exp ((int*)(KP->ws + WS_LIST + (size_t)MAXSLOT * 8))
#define xsc ((float*)(KP->ws + WS_XSC))
#define wb (KP->ws + WS_W)
#define Hb ((bf16_t*)KP->out)
#define H8 ((unsigned char*)KP->out + (size_t)T * 1024 * 2)
#define RS8 ((float*)((char*)KP->out + (size_t)T * 1024 * 3))
#define CMAX(l_) ((const float*)(KP->ws + WS_CTL) + CW_CMAX + (l_) * 3072)
#define CMAX2(l_) ((const float*)(KP->ws + WS_CTL) + CW_CMAX2 + (l_) * 2304)
#define XB ((bf16_t*)(KP->ws + WS_H))
#define RA (KP->ws + WS_A)
#define RB (KP->ws + WS_B)
#define Ub ((bf16_t*)(RA + A_U))
#define LAB ((bf16_t*)(RA + A_LAB))
#define KM ((bf16_t*)(RA + A_KM))
#define QM ((bf16_t*)(RA + A_QM))
#define VMt ((bf16_t*)(RA + A_VMT))
#define Mb ((bf16_t*)(RB + B_CKVN))
#define GT ((bf16_t*)(RA + A_GT))
#define Y2 ((bf16_t*)(RA + A_Y2))
#define XC ((bf16_t*)(RB + B_XC))
#define GR ((bf16_t*)(RB + B_GR))
#define CKVN ((bf16_t*)(RB + B_CKVN))
#define CQN ((bf16_t*)(RB + B_CQN))
#define QG ((bf16_t*)(RB + B_QG))
#define KG ((bf16_t*)(RB + B_KG))
#define VGt ((bf16_t*)(RB + B_VGT))
#define KR ((bf16_t*)(RB + B_KR))
#define YM ((bf16_t*)(RB + B_YM))
#define YG ((bf16_t*)(RB + B_YG))
#define HE ((bf16_t*)(RB + B_HE))
#define YR ((bf16_t*)(KP->ws + WS_C))

    for (int rep_ = 0; rep_ < (DUP == 0 ? 1 + DUPN : 1); ++rep_)
    if (ON(0) && RUN(0)) { LTID();
        LAS float* sc_ = (LAS float*)lds;
        LAS float* red = sc_ + 9 * 1024;
        for (int e = tid; e < 9 * 1024; e += 512) { const int r = e >> 10, k = e & 1023; const float v = r < 8 ? KP->c[r * 1024 + k] : KP->c_ctx[k]; sc_[e] = v / (1.0f + __expf(-v)); }
        __syncthreads();
        for (int cb = bid; cb < 256; cb += G) {
            const int colg = cb * 48, l = colg / 6144, n0 = colg - l * 6144;
            const int cs = tid % 48, kg = tid / 48;
            float a[9] = {0.f, 0.f, 0.f, 0.f, 0.f, 0.f, 0.f, 0.f, 0.f};
            if (kg < 10) { const int k0 = kg * 103, k1 = (k0 + 103) < 1024 ? (k0 + 103) : 1024; const float* wp = KP->w_mod + (size_t)l * 1024 * 6144 + n0 + cs;
                for (int k = k0; k < k1; k += 8) { float w[8];
#pragma unroll
                    for (int u = 0; u < 8; ++u) w[u] = (k + u < k1) ? wp[(size_t)(k + u) * 6144] : 0.f;
#pragma unroll
                    for (int u = 0; u < 8; ++u) { const int kk = (k + u < k1) ? k + u : k;
#pragma unroll
                        for (int r = 0; r < 9; ++r) a[r] += sc_[r * 1024 + kk] * w[u]; } }
#pragma unroll
                for (int r = 0; r < 9; ++r) red[(kg * 48 + cs) * 9 + r] = a[r]; }
            __syncthreads();
            if (tid < 48 * 9) { const int c2 = tid / 9, r = tid - c2 * 9; float s = KP->b_mod[l * 6144 + n0 + c2];
                for (int g = 0; g < 10; ++g) s += red[(g * 48 + c2) * 9 + r];
                modv[((size_t)l * 9 + r) * 6144 + n0 + c2] = s; }
            __syncthreads();
        }
        { LAS float* cmx = (LAS float*)lds;
          for (int ti = bid; ti < 2 * 21 * 16; ti += G) { const int l2 = ti / 336, q = ti - l2 * 336, ns = q % 21, ks = q / 21;
              const int n = ns * 256 + 4 * lane, col = n < U_MG ? n : (n < NU ? -1 : n - (NU - U_MG));
              const float* src = KP->w_in + (size_t)l2 * 1024 * DIN + (size_t)(ks * 64 + 8 * wid) * DIN + (col < 0 ? 0 : col);
              f32x4 mx = {0.f, 0.f, 0.f, 0.f};
#pragma unroll
              for (int i = 0; i < 8; ++i) { const f32x4 v = col < 0 ? (f32x4){0.f, 0.f, 0.f, 0.f} : *(const f32x4*)(src + (size_t)i * DIN); mx[0] = fmaxf(mx[0], __builtin_fabsf(v[0])); mx[1] = fmaxf(mx[1], __builtin_fabsf(v[1])); mx[2] = fmaxf(mx[2], __builtin_fabsf(v[2])); mx[3] = fmaxf(mx[3], __builtin_fabsf(v[3])); }
              *(LAS f32x4*)(cmx + wid * 256 + 4 * lane) = mx;
              __syncthreads();
              if (tid < 256) { float m = cmx[tid];
#pragma unroll
                  for (int w = 1; w < 8; ++w) m = fmaxf(m, cmx[w * 256 + tid]);
                  atomicMax((unsigned*)(KP->ws + WS_CTL) + (ns < 9 ? CW_CMAX2 + l2 * 2304 + ns * 256 : CW_CMAX + l2 * 3072 + (ns - 9) * 256) + tid, __float_as_uint(m)); }
              __syncthreads(); } }
        for (int e = bid * 512 + tid; e < 4096 * 48; e += G * 512) {
            const int pos = e / 48, j = e - pos * 48; const float row = (float)(pos >> 6), col = (float)(pos & 63);
            if (j < 32) { const int q = j & 15; const float f = powf(10000.0f, -(float)q / 16.0f); const float ang = (j < 16 ? row : col) * f; float s, c; sincosf(ang, &s, &c); cosG[pos * 32 + j] = c; sinG[pos * 32 + j] = s; }
            else { const int jj = j - 32, q = jj & 7; const float f = powf(10000.0f, -(float)q / 8.0f); const float ang = (jj < 8 ? row : col) * f; float s, c; sincosf(ang, &s, &c); cosM[pos * 16 + jj] = c; sinM[pos * 16 + jj] = s; }
        }
        for (int e = bid * 512 + tid; e < 2 * 2 * 512; e += G * 512) { const float lam = KP->lru_lambda[e]; const float sp = (-lam > 20.f) ? -lam : log1pf(__expf(-lam)); lrut[e] = -8.0f * sp; }
        for (int e = bid * 512 + tid; e < 2 * 36 * 1024; e += G * 512) { const int l = e / (36 * 1024), r = (e / 1024) % 36, k = e & 1023;
            wrt[e] = r < 4 ? KP->moe_wg[((size_t)l * 1024 + k) * 4 + r] : KP->moe_we[((size_t)l * 1024 + k) * 32 + (r - 4)]; }
    }
    SEAM(0);

    for (int l = 0; l < NLAYER; ++l) {
        const int P0 = NPH_PRO + l * NPH_LAYER;
#define modl (modv + (size_t)l * 9 * 6144)
        unsigned* cnt = ctl + CW_CNT + l * 32 * 64;
        if (ON(1) && RUN(P0 + 0)) { LTID();
            for (int rep_ = 0; rep_ < (DUP == 1 ? 1 + DUPN : 1); ++rep_) {
            int par = 0;
            for (int ti = bid; ti < 2060; ti += G, par ^= 1) {
                LAS unsigned char* buf = lds + par * 32768;
                if (ti < 336 && ti % 21 >= 9) { const int ns = ti % 21 - 9, ks = ti / 21; const float* src = KP->w_in + (size_t)l * 1024 * DIN + (size_t)ks * 64 * DIN + U_MG + ns * 256;
                    cvt_tile_i8(buf, (unsigned char*)(wb + W_MG) + (size_t)ns * 256 * 1024 + ks * 64, 1024, tid, CMAX(l) + ns * 256, [=](int kk, int ln) -> const float* { return src + (size_t)kk * DIN + 4 * ln; });
                } else if (ti < 336) { const int ns = ti % 21, ks = ti / 21; const float* src = KP->w_in + (size_t)l * 1024 * DIN + (size_t)ks * 64 * DIN;
                    cvt_tile_i8(buf, (unsigned char*)(wb + W_IN) + (size_t)ns * 256 * 1024 + ks * 64, 1024, tid, CMAX2(l) + ns * 256, [=](int kk, int ln) -> const float* { const int n = ns * 256 + 4 * ln; return n < U_MG ? src + (size_t)kk * DIN + n : nullptr; });
                } else if (ti < 352) { const int q = ti - 336, ns = q & 3, ks = q >> 2; const float* src = KP->mla_wukv + (size_t)l * 128 * 1024 + (size_t)ks * 64 * 1024 + ns * 256;
                    cvt_tile(buf, (bf16_t*)(wb + W_UKV) + (size_t)ns * 256 * 256 + ks * 64, 256, tid, [=](int kk, int ln) -> const float* { return ks < 2 ? src + (size_t)kk * 1024 + 4 * ln : nullptr; });
                } else if (ti < 364) { const int q = ti - 352, ns = q % 3, ks = q / 3; const float* src = KP->mla_wuq + (size_t)l * 256 * 768 + (size_t)ks * 64 * 768 + ns * 256;
                    cvt_tile(buf, (bf16_t*)(wb + W_UQ) + (size_t)ns * 256 * 256 + ks * 64, 256, tid, [=](int kk, int ln) -> const float* { return src + (size_t)kk * 768 + 4 * ln; });
                } else if (ti < 460) { const int q = ti - 364, br = q >> 5, r = q & 31, ns = r & 3, ks = r >> 2; const float* src = KP->w_branch + ((size_t)l * 3 + br) * 512 * 1024 + (size_t)ks * 64 * 1024 + ns * 256;
                    cvt_tile(buf, (bf16_t*)(wb + W_BR) + (size_t)br * 1024 * 512 + (size_t)ns * 256 * 512 + ks * 64, 512, tid, [=](int kk, int ln) -> const float* { return src + (size_t)kk * 1024 + 4 * ln; });
                } else if (ti < 524) { const int q = ti - 460, ns = q & 3, ks = q >> 2; const float* src = KP->w_out + (size_t)l * 1024 * 1024 + (size_t)ks * 64 * 1024 + ns * 256;
                    cvt_tile(buf, (bf16_t*)(wb + W_OUT) + (size_t)ns * 256 * 1024 + ks * 64, 1024, tid, [=](int kk, int ln) -> const float* { return src + (size_t)kk * 1024 + 4 * ln; });
                } else if (ti < 1548) { const int q = ti - 524, e = q >> 5, r = q & 31, ns = r & 1, ks = r >> 1;
                    const float* s1 = KP->moe_w1 + ((size_t)l * NEXP + e) * 1024 * 256 + (size_t)ks * 64 * 256; const float* s3 = KP->moe_w3 + ((size_t)l * NEXP + e) * 1024 * 256 + (size_t)ks * 64 * 256;
                    cvt_tile(buf, (bf16_t*)(wb + W_13) + (size_t)e * 512 * 1024 + (size_t)ns * 256 * 1024 + ks * 64, 1024, tid, [=](int kk, int ln) -> const float* { const int n = ns * 256 + 4 * ln, g = n >> 5, i = n & 31; return (i < 16 ? s1 : s3) + (size_t)kk * 256 + 16 * g + (i & 15); });
                } else { const int q = ti - 1548, e = q >> 4, r = q & 15, ns = r & 3, ks = r >> 2; const float* src = KP->moe_w2 + ((size_t)l * NEXP + e) * 256 * 1024 + (size_t)ks * 64 * 1024 + ns * 256;
                    cvt_tile(buf, (bf16_t*)(wb + W_2T) + (size_t)e * 1024 * 256 + (size_t)ns * 256 * 256 + ks * 64, 256, tid, [=](int kk, int ln) -> const float* { return src + (size_t)kk * 1024 + 4 * ln; });
                }
            }
            __syncthreads();
            for (int e = bid * 512 + tid; e < 8 * 256 * 128; e += G * 512) {
                const int pn = e >> 15, r = (e >> 7) & 255, k = e & 127; const int g = 2 * (r >> 7) + ((r >> 4) & 1), cl = 16 * ((r >> 5) & 3) + (r & 15), dir = g >> 1; float v = 0.f;
                if ((k >> 6) == (pn & 1)) { const float* w = (g & 1) ? KP->lru_wi : KP->lru_wa; v = w[((((size_t)l * 2 + dir) * 8 + pn) * 64 + (k & 63)) * 64 + cl]; }
                ((bf16_t*)(wb + W_G))[e] = f2bf(v);
            }
            }
            for (int rep2_ = 0; rep2_ < ((DUP == 20 && l == 0) ? 2 : 1); ++rep2_) {
            f32x4 gmx[4];
#pragma unroll
            for (int j = 0; j < 4; ++j) gmx[j] = *(const f32x4*)(KP->g_mix + (size_t)l * 1024 + (j * 64 + lane) * 4);
            for (int bb = bid; bb < T / 136; bb += G) {
                f32x4 L_v[4]; u32x2 L_xb[4], L_ya[4], L_yb[4]; f32x4 m_sc[4], m_sh[4], m_gf[4]; int cur_mr = -1;
#pragma unroll
                for (int j = 0; j < 4; ++j) { L_v[j] = (f32x4){0.f, 0.f, 0.f, 0.f}; L_xb[j] = (u32x2){0u, 0u}; L_ya[j] = (u32x2){0u, 0u}; L_yb[j] = (u32x2){0u, 0u}; m_sc[j] = m_sh[j] = m_gf[j] = (f32x4){0.f, 0.f, 0.f, 0.f}; }
#define N1_ISSUE(TT) do { const int t_ = (TT); const int b_ = t_ / TPB, n_ = t_ - b_ * TPB; \
                    if (l == 0) { const float* src_ = n_ < NCTX ? KP->ctx + ((size_t)b_ * NCTX + n_) * DM : KP->x + ((size_t)b_ * SEQ + (n_ - NCTX)) * DM; \
                        _Pragma("unroll") for (int j = 0; j < 4; ++j) L_v[j] = *(const f32x4*)(src_ + (j * 64 + lane) * 4); } \
                    else { const bf16_t* x_ = XB + (size_t)t_ * 1024; const bf16_t* y_ = Y2 + (size_t)t_ * 2048; _Pragma("unroll") for (int j = 0; j < 4; ++j) { L_xb[j] = *(const u32x2*)(x_ + (j * 64 + lane) * 4); L_ya[j] = *(const u32x2*)(y_ + (j * 64 + lane) * 4); L_yb[j] = *(const u32x2*)(y_ + 1024 + (j * 64 + lane) * 4); } } } while (0)
                N1_ISSUE(bb * 136 + wid);
                for (int it = 0; it < 17; ++it) {
                    const int t = bb * 136 + it * 8 + wid; const int b = t / TPB, n = t - b * TPB; const int mr = n < NCTX ? 8 : b;
                    f32x4 v[4]; u32x2 ya[4], yb[4];
#pragma unroll
                    for (int j = 0; j < 4; ++j) { v[j] = l == 0 ? L_v[j] : unpack4(L_xb[j]); ya[j] = L_ya[j]; yb[j] = L_yb[j]; }
                    if (it + 1 < 17) N1_ISSUE(t + 8);
                    if (mr != cur_mr) { cur_mr = mr; const float* sh = modl + (size_t)mr * 6144; const float* gf = modv + ((size_t)(l > 0 ? l - 1 : 0) * 9 + mr) * 6144 + 5120;
#pragma unroll
                        for (int j = 0; j < 4; ++j) { const int col = (j * 64 + lane) * 4; m_sh[j] = *(const f32x4*)(sh + col); m_sc[j] = *(const f32x4*)(sh + 1024 + col) + 1.0f; m_gf[j] = *(const f32x4*)(gf + col); } }
                    __builtin_amdgcn_sched_barrier(0);
                    if (l != 0 && !(ABL == 7 && n < NCTX)) {
#pragma unroll
                        for (int j = 0; j < 4; ++j) { f32x4 xv = v[j]; const f32x4 g = m_gf[j]; const u32x2 a = ya[j], bq = yb[j];
                            xv[0] += g[0] * (__uint_as_float(a.x << 16) + __uint_as_float(bq.x << 16)); xv[1] += g[1] * (__uint_as_float(a.x & 0xffff0000u) + __uint_as_float(bq.x & 0xffff0000u));
                            xv[2] += g[2] * (__uint_as_float(a.y << 16) + __uint_as_float(bq.y << 16)); xv[3] += g[3] * (__uint_as_float(a.y & 0xffff0000u) + __uint_as_float(bq.y & 0xffff0000u));
                            v[j] = xv; } }
                    if (l != 0) {
#pragma unroll
                        for (int j = 0; j < 4; ++j) *(u32x2*)(XB + (size_t)t * 1024 + (j * 64 + lane) * 4) = pack4(v[j]); }
                    float ss = 0.f;
#pragma unroll
                    for (int j = 0; j < 4; ++j) ss += v[j][0] * v[j][0] + v[j][1] * v[j][1] + v[j][2] * v[j][2] + v[j][3] * v[j][3];
                    ss = wave_sum(ss); const float rstd = rsqrtf(ss * (1.0f / 1024.0f) + 1e-6f);
#pragma unroll
                    for (int j = 0; j < 4; ++j) { const int col = (j * 64 + lane) * 4;
                        const f32x4 h = v[j] * rstd * gmx[j] * m_sc[j] + m_sh[j]; v[j] = h; (void)col; }
                    {
                        float am = 0.f;
#pragma unroll
                        for (int j = 0; j < 4; ++j) am = fmaxf(fmaxf(am, fmaxf(__builtin_fabsf(v[j][0]), __builtin_fabsf(v[j][1]))), fmaxf(__builtin_fabsf(v[j][2]), __builtin_fabsf(v[j][3])));
                        am = fmaxf(wave_max_nn(am), 1e-30f); const float sc = 127.0f / am;
#pragma unroll
                        for (int j = 0; j < 4; ++j) *(unsigned*)(H8 + (size_t)t * 1024 + (j * 64 + lane) * 4) = pack_i8x4(v[j][0], v[j][1], v[j][2], v[j][3], sc);
                        if (lane == 0) RS8[t] = am * (1.0f / 127.0f);
                    }
                }
#undef N1_ISSUE
            }
            }
        }
        SEAM(P0 + 0);
        for (int rep_ = 0; rep_ < (DUP == 2 ? 1 + DUPN : 1); ++rep_)
        if (ON(2) && RUN(P0 + 1)) { PHK();
            SchedDense S{(const char*)H8, wb + W_IN, 512, T / 256, NU / 256, G, bid, false}; EpiBf16I8 E{Ub, NU, RS8, CMAX2(l)};
            g8::gemm_phase(lds, S, E);
        }
        SEAM(P0 + 1);
        for (int rep_ = 0; rep_ < (DUP == 3 ? 1 + DUPN : 1); ++rep_)
        if (ON(3) && RUN(P0 + 2)) { LTID();
            f32x4 cwv[4][2]; f32x4 cbv[2];
            { const float* cw = KP->conv_w + (size_t)l * 4 * 512 + lane * 8; const float* cbias = KP->conv_b + (size_t)l * 512 + lane * 8;
#pragma unroll
              for (int k = 0; k < 4; ++k) { cwv[k][0] = *(const f32x4*)(cw + k * 512); cwv[k][1] = *(const f32x4*)(cw + k * 512 + 4); }
              cbv[0] = *(const f32x4*)cbias; cbv[1] = *(const f32x4*)(cbias + 4); }
            const f32x2 gkv2 = *(const f32x2*)(KP->mla_gkv + (size_t)l * 128 + lane * 2);
            const f32x4 gqm4 = *(const f32x4*)(KP->mla_gq + (size_t)l * 256 + lane * 4);
            const int qa = lane & 7, qh = lane >> 3;
            const f32x4 ggqA = *(const f32x4*)(KP->gqa_gq + (size_t)l * 64 + qa * 4), ggqB = *(const f32x4*)(KP->gqa_gq + (size_t)l * 64 + 32 + qa * 4);
            const int ki = lane & 15, kh = (lane >> 4) & 1;
            const f32x2 ggkA = *(const f32x2*)(KP->gqa_gk + (size_t)l * 64 + ki * 2), ggkB = *(const f32x2*)(KP->gqa_gk + (size_t)l * 64 + 32 + ki * 2);
            LAS bf16_t* vst = (LAS bf16_t*)lds;
            constexpr int VSTP = 138;
            for (int bb = bid; bb < T / 136; bb += G) {
            __syncthreads();
            u32x4 L_xr[4], L_rg; unsigned L_ckv, L_gka, L_gkb, L_gv; u32x2 L_cq, L_gqa, L_gqb; bf16_t L_kr1, L_kr2; f32x4 L_qc, L_qs; f32x2 L_kc, L_ks; float L_rc, L_rs;
#define P3_ISSUE(TT) do { const int t_ = (TT); const int b_ = t_ / TPB, n_ = t_ - b_ * TPB; const bool ic_ = n_ < NCTX; const int s0_ = ic_ ? 0 : NCTX, s1_ = ic_ ? NCTX : TPB; \
                const int pp_ = ic_ ? 0 : n_ - NCTX; const bf16_t* ur_ = Ub + (size_t)t_ * NU; \
                _Pragma("unroll") for (int k = 0; k < 4; ++k) { const int nn = n_ + k - 2; L_xr[k] = (nn >= s0_ && nn < s1_) ? *(const u32x4*)(ur_ + (ptrdiff_t)(k - 2) * NU + U_XR + lane * 8) : (u32x4){0u, 0u, 0u, 0u}; } \
                L_rg = *(const u32x4*)(ur_ + U_RG + lane * 8); L_ckv = *(const unsigned*)(ur_ + U_CKV + lane * 2); L_cq = *(const u32x2*)(ur_ + U_CQ + lane * 4); \
                L_kr1 = ur_[U_KR + ki]; L_kr2 = ur_[U_KR + 16 + ki]; L_gka = *(const unsigned*)(ur_ + U_GK + kh * 64 + ki * 2); L_gkb = *(const unsigned*)(ur_ + U_GK + kh * 64 + 32 + ki * 2); \
                L_gv = *(const unsigned*)(ur_ + U_GV + lane * 2); L_gqa = *(const u32x2*)(ur_ + U_GQ + qh * 64 + qa * 4); L_gqb = *(const u32x2*)(ur_ + U_GQ + qh * 64 + 32 + qa * 4); \
                L_qc = *(const f32x4*)(cosG + pp_ * 32 + qa * 4); L_qs = *(const f32x4*)(sinG + pp_ * 32 + qa * 4); L_kc = *(const f32x2*)(cosG + pp_ * 32 + ki * 2); L_ks = *(const f32x2*)(sinG + pp_ * 32 + ki * 2); \
                L_rc = cosM[pp_ * 16 + ki]; L_rs = sinM[pp_ * 16 + ki]; } while (0)
            P3_ISSUE(bb * 136 + wid);
            for (int it = 0; it < 17; ++it) {
                const int tl = it * 8 + wid; const int t = bb * 136 + tl;
                const int b = t / TPB, n = t - b * TPB; const bool isctx = n < NCTX;
                u32x4 xr4[4]; xr4[0] = L_xr[0]; xr4[1] = L_xr[1]; xr4[2] = L_xr[2]; xr4[3] = L_xr[3];
                const u32x4 rg4 = L_rg; const unsigned ckvw = L_ckv, gka = L_gka, gkb = L_gkb, gvw = L_gv; const u32x2 cqw = L_cq, gqa_ = L_gqa, gqb_ = L_gqb; const bf16_t kr1 = L_kr1, kr2 = L_kr2;
                const f32x4 qc = L_qc, qs = L_qs; const f32x2 kc = L_kc, ks = L_ks; const float rc = L_rc, rs_ = L_rs;
                if (it + 1 < 17) P3_ISSUE(t + 8);
                __builtin_amdgcn_sched_barrier(0);
                { f32x4 a0 = cbv[0], a1 = cbv[1];
#pragma unroll
                  for (int k = 0; k < 4; ++k) { float xv[8]; unpack8(xr4[k], xv); a0 += cwv[k][0] * (f32x4){xv[0], xv[1], xv[2], xv[3]}; a1 += cwv[k][1] * (f32x4){xv[4], xv[5], xv[6], xv[7]}; }
                  const float a[8] = {a0[0], a0[1], a0[2], a0[3], a1[0], a1[1], a1[2], a1[3]};
                  *(u32x4*)(XC + (size_t)t * 512 + lane * 8) = pack8(a); }
                { float xv[8]; unpack8(rg4, xv);
#pragma unroll
                  for (int j = 0; j < 8; ++j) xv[j] = gelu_tanh(xv[j]);
                  *(u32x4*)(GR + (size_t)t * 512 + lane * 8) = pack8(xv); }
                { const float x0 = __uint_as_float(ckvw << 16), x1 = __uint_as_float(ckvw & 0xffff0000u);
                  const float ss = wave_sum(x0 * x0 + x1 * x1); const float rs = rsqrtf(ss * (1.0f / 128.0f) + 1e-6f);
                  *(unsigned*)(CKVN + (size_t)t * 256 + lane * 2) = cvt_pk_bf16(x0 * rs * gkv2.x, x1 * rs * gkv2.y);
                  *(unsigned*)(CKVN + (size_t)t * 256 + 128 + lane * 2) = 0u; }
                { const float x0 = __uint_as_float(cqw.x << 16), x1 = __uint_as_float(cqw.x & 0xffff0000u), x2 = __uint_as_float(cqw.y << 16), x3 = __uint_as_float(cqw.y & 0xffff0000u);
                  const float ss = wave_sum(x0 * x0 + x1 * x1 + x2 * x2 + x3 * x3); const float rs = rsqrtf(ss * (1.0f / 256.0f) + 1e-6f);
                  u32x2 o; o.x = cvt_pk_bf16(x0 * rs * gqm4[0], x1 * rs * gqm4[1]); o.y = cvt_pk_bf16(x2 * rs * gqm4[2], x3 * rs * gqm4[3]);
                  *(u32x2*)(CQN + (size_t)t * 256 + lane * 4) = o; }
                { float x1 = bf2f(kr1), x2 = bf2f(kr2);
                  if (ABL != 5 && !isctx) { const float o1 = x1 * rc - x2 * rs_, o2 = x1 * rs_ + x2 * rc; x1 = o1; x2 = o2; }
                  if (lane < 16) { KR[(size_t)t * 32 + lane] = f2bf(x1); KR[(size_t)t * 32 + 16 + lane] = f2bf(x2); } }
                { float a0 = __uint_as_float(gka << 16), a1 = __uint_as_float(gka & 0xffff0000u), b0 = __uint_as_float(gkb << 16), b1 = __uint_as_float(gkb & 0xffff0000u);
                  const float ss = red16(a0 * a0 + a1 * a1 + b0 * b0 + b1 * b1); const float rs = rsqrtf(ss * (1.0f / 64.0f) + 1e-6f);
                  a0 *= rs * ggkA.x; a1 *= rs * ggkA.y; b0 *= rs * ggkB.x; b1 *= rs * ggkB.y;
                  if (ABL != 5 && !isctx) { const float o0 = a0 * kc.x - b0 * ks.x, o1 = a1 * kc.y - b1 * ks.y, o2 = a0 * ks.x + b0 * kc.x, o3 = a1 * ks.y + b1 * kc.y; a0 = o0; a1 = o1; b0 = o2; b1 = o3; }
                  if (lane < 32) { bf16_t* kp = KG + (((size_t)b * 2 + kh) * TPB + n) * 64; *(unsigned*)(kp + ki * 2) = cvt_pk_bf16(a0, a1); *(unsigned*)(kp + 32 + ki * 2) = cvt_pk_bf16(b0, b1); } }
                { vst[(lane * 2) * VSTP + tl] = (bf16_t)(gvw & 0xffffu); vst[(lane * 2 + 1) * VSTP + tl] = (bf16_t)(gvw >> 16); }
                { f32x4 xA = {__uint_as_float(gqa_.x << 16), __uint_as_float(gqa_.x & 0xffff0000u), __uint_as_float(gqa_.y << 16), __uint_as_float(gqa_.y & 0xffff0000u)};
                  f32x4 xB = {__uint_as_float(gqb_.x << 16), __uint_as_float(gqb_.x & 0xffff0000u), __uint_as_float(gqb_.y << 16), __uint_as_float(gqb_.y & 0xffff0000u)};
                  const f32x4 sq = xA * xA + xB * xB; const float ss = red8((sq[0] + sq[1]) + (sq[2] + sq[3])); const float rs = rsqrtf(ss * (1.0f / 64.0f) + 1e-6f);
                  xA = xA * rs * ggqA; xB = xB * rs * ggqB;
                  if (ABL != 5 && !isctx) { const f32x4 oA = xA * qc - xB * qs, oB = xA * qs + xB * qc; xA = oA; xB = oB; }
                  xA = xA * QSCALE_G; xB = xB * QSCALE_G;
                  bf16_t* qp = QG + (((size_t)b * 8 + qh) * TPB + n) * 64; u32x2 oa, ob; oa.x = cvt_pk_bf16(xA[0], xA[1]); oa.y = cvt_pk_bf16(xA[2], xA[3]); ob.x = cvt_pk_bf16(xB[0], xB[1]); ob.y = cvt_pk_bf16(xB[2], xB[3]);
                  *(u32x2*)(qp + qa * 4) = oa; *(u32x2*)(qp + 32 + qa * 4) = ob; }
            }
#undef P3_ISSUE
            __syncthreads();
            { const int b = (bb * 136) / TPB, n0 = bb * 136 - b * TPB;
#pragma unroll 4
              for (int r = 0; r < 16; ++r) { const int row = wid * 16 + r; bf16_t* gp = VGt + (((size_t)b * 2 + (row >> 6)) * 64 + (row & 63)) * TPB + n0;
                  *(unsigned*)(gp + lane * 2) = *(const LAS unsigned*)(vst + row * VSTP + lane * 2);
                  if (lane < 4) *(unsigned*)(gp + 128 + lane * 2) = *(const LAS unsigned*)(vst + row * VSTP + 128 + lane * 2); } }
            }
        }
        SEAM(P0 + 2);
        for (int rep_ = 0; rep_ < (DUP == 4 ? 1 + DUPN : 1); ++rep_)
        if (ON(4) && RUN(P0 + 3)) { PHK();
            SchedGate S{(const char*)XC, wb + W_G, T / 256, G, bid};
            EpiGate E{XC, LAB, KP->lru_ba + (size_t)l * 1024, KP->lru_bi + (size_t)l * 1024, lrut + (size_t)l * 1024};
            g8::gemm_phase(lds, S, E);
        }
        SEAM(P0 + 3);
        for (int rep_ = 0; rep_ < (DUP == 5 ? 1 + DUPN : 1); ++rep_)
        if (ON(5) && RUN(P0 + 4)) { LTID();
            for (int it = bid; it < NB_ * NCHUNK; it += G) {
                const int b = it / NCHUNK, j = it - b * NCHUNK; const int c = tid;
                const char* ub = (const char*)(LAB + ((size_t)b * TPB + (size_t)j * 64) * 2048); const unsigned lo = (unsigned)c * 8u;
                u32x2 w[64];
                { const __amdgpu_buffer_rsrc_t rs = BUF_RSRC(ub);
#pragma unroll
                  for (int s = 0; s < 64; ++s) w[s] = __builtin_amdgcn_raw_buffer_load_b64(rs, lo, s * 4096, 0); }
                __builtin_amdgcn_sched_barrier(0);
                float Pf = 1.f, Hf = 0.f, Pb = 1.f, Hb_ = 0.f;
#pragma unroll
                for (int s = 0; s < 64; ++s) { const float af = __expf(__uint_as_float(w[s].x << 16)); Hf = af * Hf + __uint_as_float(w[s].x & 0xffff0000u); Pf *= af; }
#pragma unroll
                for (int s = 63; s >= 0; --s) { const float ab = __expf(__uint_as_float(w[s].y << 16)); Hb_ = ab * Hb_ + __uint_as_float(w[s].y & 0xffff0000u); Pb *= ab; }
                __builtin_amdgcn_sched_barrier(0);
                carry[(((size_t)b * NCHUNK + j) * 2 + 0) * 512 + c] = (f32x2){Pf, Hf};
                carry[(((size_t)b * NCHUNK + j) * 2 + 1) * 512 + c] = (f32x2){Pb, Hb_};
            }
        }
        SEAM(P0 + 4);
        for (int rep_ = 0; rep_ < (DUP == 6 ? 1 + DUPN : 1); ++rep_)
        if (ON(6) && RUN(P0 + 5)) { LTID();
            for (int it = bid; it < NB_ * NCHUNK; it += G) {
                const int b = it / NCHUNK, j = it - b * NCHUNK; const int c = tid;
                if (l == NLAYER - 1 && j < 4) continue;
                const __amdgpu_buffer_rsrc_t crs = BUF_RSRC(carry + (size_t)b * NCHUNK * 2 * 512); const unsigned clo = (unsigned)c * 8u;
                float cf = 0.f, cbk = 0.f;
                const int pf = j, pb = j < 4 ? 3 - j : 71 - j;
#pragma unroll
                for (int hb = 0; hb < 2; ++hb) {
                    u32x2 vf[34], vb[34];
#pragma unroll
                    for (int q = 0; q < 34; ++q) { const int qq = hb * 34 + q; const int ib = qq < 4 ? 3 - qq : 71 - qq;
                        vf[q] = __builtin_amdgcn_raw_buffer_load_b64(crs, clo, (qq * 2 + 0) * 4096, 0); vb[q] = __builtin_amdgcn_raw_buffer_load_b64(crs, clo, (ib * 2 + 1) * 4096, 0); }
                    __builtin_amdgcn_sched_barrier(0);
#pragma unroll
                    for (int q = 0; q < 34; ++q) { const int qq = hb * 34 + q;
                        if (qq < pf) cf = __uint_as_float(vf[q].x) * cf + __uint_as_float(vf[q].y);
                        if (qq < pb) cbk = __uint_as_float(vb[q].x) * cbk + __uint_as_float(vb[q].y); }
                }
                const size_t t0 = (size_t)b * TPB + (size_t)j * 64;
                const char* ub = (const char*)(LAB + t0 * 2048); const unsigned lo = (unsigned)c * 8u, lo2 = (unsigned)c * 2u;
                const char* gb = (const char*)(GR + t0 * 512); char* yb = (char*)(YR + t0 * 512);
                __builtin_amdgcn_sched_barrier(0);
                u32x2 w[64];
                { const __amdgpu_buffer_rsrc_t rs = BUF_RSRC(ub);
#pragma unroll
                  for (int s = 0; s < 64; ++s) w[s] = __builtin_amdgcn_raw_buffer_load_b64(rs, lo, s * 4096, 0); }
                __builtin_amdgcn_sched_barrier(0);
#pragma unroll
                for (int s = 0; s < 64; ++s) { cf = __expf(__uint_as_float(w[s].x << 16)) * cf + __uint_as_float(w[s].x & 0xffff0000u); w[s].x = __float_as_uint(cf); }
                bf16_t ga[16], gn[16];
#pragma unroll
                for (int s = 0; s < 16; ++s) ga[s] = *(const bf16_t*)(gb + (size_t)(48 + s) * 1024 + lo2);
#pragma unroll
                for (int k = 3; k >= 0; --k) {
                    if (k > 0) {
#pragma unroll
                        for (int s = 0; s < 16; ++s) gn[s] = *(const bf16_t*)(gb + (size_t)((k - 1) * 16 + s) * 1024 + lo2); }
                    __builtin_amdgcn_sched_barrier(0);
#pragma unroll
                    for (int s = 15; s >= 0; --s) { const int ss = k * 16 + s; cbk = __expf(__uint_as_float(w[ss].y << 16)) * cbk + __uint_as_float(w[ss].y & 0xffff0000u);
                        *(bf16_t*)(yb + (size_t)ss * 1024 + lo2) = f2bf(ABL == 2 ? 0.f : (__uint_as_float(w[ss].x) + cbk) * bf2f(ga[s])); }
#pragma unroll
                    for (int s = 0; s < 16; ++s) ga[s] = gn[s];
                }
            }
        }
        SEAM(P0 + 5);
        for (int rep_ = 0; rep_ < (DUP == 7 ? 1 + DUPN : 1); ++rep_)
        if (ON(7) && RUN(P0 + 6)) { PHK();
            { SchedDense S{(const char*)CKVN, wb + W_UKV, 256, T / 256, 4, G, bid, false}; EpiUkv E{KM, VMt}; g8::gemm_phase(lds, S, E); }
            { SchedDense S{(const char*)CQN, wb + W_UQ, 256, T / 256, 3, G, bid, l == NLAYER - 1}; EpiUq E{QM, cosM, sinM}; g8::gemm_phase(lds, S, E); }
        }
        SEAM(P0 + 6);
        for (int rep_ = 0; rep_ < ((DUP == 8 || DUP == 23 || DUP == 24) ? 1 + DUPN : 1); ++rep_)
        if (ON(8) && RUN(P0 + 7)) { LTID();
            const int ng = NB_ * 8 * 8, nm = NB_ * 8 * 8, nall = ng + nm + (l == NLAYER - 1 ? 0 : 2 * NB_ * 8);
            for (int it = (DUP == 24 && rep_) ? ng + bid : bid; it < ((DUP == 23 && rep_) ? ng : (DUP == 24 && rep_) ? ng + nm : nall); it += G) {
                if (it < ng) {
                    int u = it; const int qb = u >> 6; u &= 63; const int h = u & 7, b = u >> 3; const size_t bh = (size_t)b * 8 + h, bk = (size_t)b * 2 + (h >> 2); const size_t n0 = NCTX + (size_t)qb * 512;
                    attn_run<64, 2, 2>(lds, QG + (bh * TPB + n0) * 64, KG + bk * TPB * 64, nullptr, VGt + bk * 64 * TPB, TPB, YG + ((size_t)b * TPB + n0) * 512 + h * 64);
                } else if (it < ng + nm) {
                    int u = it - ng; const int qb = u >> 6; u &= 63; const int h = u & 7, b = u >> 3; const size_t bh = (size_t)b * 8 + h; const size_t n0 = NCTX + (size_t)qb * 512;
                    attn_run<96, 2, 2>(lds, QM + (bh * TPB + n0) * 96, KM + bh * TPB * 64, KR + (size_t)b * TPB * 32, VMt + bh * 64 * TPB, TPB, YM + ((size_t)b * TPB + n0) * 512 + h * 64);
                } else {
                    int u = it - ng - nm; const int kind = u & 1; u >>= 1; const int h = u & 7, b = u >> 3; const size_t bh = (size_t)b * 8 + h;
                    if (kind == 0) attn_run<96, 1, 2>(lds, QM + (bh * TPB) * 96, KM + bh * TPB * 64, KR + (size_t)b * TPB * 32, VMt + bh * 64 * TPB, NCTX, YM + ((size_t)b * TPB) * 512 + h * 64);
                    else { const size_t bk = (size_t)b * 2 + (h >> 2); attn_run<64, 1, 2>(lds, QG + (bh * TPB) * 64, KG + bk * TPB * 64, nullptr, VGt + bk * 64 * TPB, NCTX, YG + ((size_t)b * TPB) * 512 + h * 64); }
                }
            }
        }
        SEAM(P0 + 7);
        for (int rep_ = 0; rep_ < (DUP == 12 ? 1 + DUPN : 1); ++rep_)
        if (ON(15) && RUN(P0 + 8)) { PHK();
            SchedDense S{(const char*)H8, wb + W_MG, 512, T / 256, 12, G, bid, l == NLAYER - 1}; EpiGateI8 E{(unsigned char*)RA, RS8, CMAX(l)};
            g8::gemm_phase(lds, S, E);
        }
        SEAM(P0 + 8);
        for (int rep_ = 0; rep_ < (DUP == 9 ? 1 + DUPN : 1); ++rep_)
        if (ON(9) && RUN(P0 + 9)) { PHK();
            SchedMerge S{(const char*)KP->ws, wb + W_BR, T / 256, G, bid, l == NLAYER - 1};
            EpiMerge E{Mb, (const unsigned char*)RA};
            g8::gemm_phase(lds, S, E);
        }
        SEAM(P0 + 9);
        for (int rep_ = 0; rep_ < (DUP == 10 ? 1 + DUPN : 1); ++rep_)
        if (ON(10) && RUN(P0 + 10)) { PHK();
            SchedDense S{(const char*)Mb, wb + W_OUT, 1024, T / 256, 4, G, bid, l == NLAYER - 1}; EpiOut E{rep_ ? (bf16_t*)RA : XB, l == 0 ? KP->x : (const float*)nullptr, l == 0 ? KP->ctx : (const float*)nullptr, modl};
            g8::gemm_phase(lds, S, E);
        }
        SEAM(P0 + 10);
        for (int rep_ = 0; rep_ < (DUP == 11 ? 1 + DUPN : 1); ++rep_)
        if (ON(11) && RUN(P0 + 11)) { LTID();
            LAS float* wl = (LAS float*)lds;
            { const float* src = wrt + (size_t)l * 36 * 1024; for (int e = tid; e < 36 * 1024 / 4; e += 512) *(LAS f32x4*)(wl + e * 4) = *(const f32x4*)(src + e * 4); }
            __syncthreads();
            const float* bg = KP->moe_bg + l * 4; const float* be = KP->moe_be + l * 32;
            f32x4 gfx_[4];
#pragma unroll
            for (int j = 0; j < 4; ++j) gfx_[j] = *(const f32x4*)(KP->g_ffn + (size_t)l * 1024 + (j * 64 + lane) * 4);
            for (int bb = bid; bb < T / 136; bb += G) {
            u32x2 L_v[4]; f32x4 m_sc[4], m_sh[4]; int cur_mr = -1;
#pragma unroll
            for (int j = 0; j < 4; ++j) m_sc[j] = m_sh[j] = (f32x4){0.f, 0.f, 0.f, 0.f};
#define R_ISSUE(TT) do { const bf16_t* xr_ = XB + (size_t)(TT) * 1024; _Pragma("unroll") for (int j = 0; j < 4; ++j) L_v[j] = *(const u32x2*)(xr_ + (j * 64 + lane) * 4); } while (0)
            R_ISSUE(bb * 136 + wid);
            for (int it = 0; it < 17; ++it) {
                const int t = bb * 136 + it * 8 + wid;
                const int b = t / TPB, n = t - b * TPB; const int mr = n < NCTX ? 8 : b;
                f32x4 v[4];
#pragma unroll
                for (int j = 0; j < 4; ++j) v[j] = unpack4(L_v[j]);
                if (it + 1 < 17) R_ISSUE(t + 8);
                if (mr != cur_mr) { cur_mr = mr; const float* sh = modl + (size_t)mr * 6144 + 3072;
#pragma unroll
                    for (int j = 0; j < 4; ++j) { const int col = (j * 64 + lane) * 4; m_sh[j] = *(const f32x4*)(sh + col); m_sc[j] = *(const f32x4*)(sh + 1024 + col) + 1.0f; } }
                __builtin_amdgcn_sched_barrier(0);
                if (l == NLAYER - 1 && n < NCTX) continue;
                float ss = 0.f;
#pragma unroll
                for (int j = 0; j < 4; ++j) ss += v[j][0] * v[j][0] + v[j][1] * v[j][1] + v[j][2] * v[j][2] + v[j][3] * v[j][3];
                ss = wave_sum(ss); const float rstd = rsqrtf(ss * (1.0f / 1024.0f) + 1e-6f);
#pragma unroll
                for (int j = 0; j < 4; ++j) { const int col = (j * 64 + lane) * 4;
                    v[j] = v[j] * rstd * gfx_[j] * m_sc[j] + m_sh[j]; u32x2 w; w.x = cvt_pk_bf16(v[j][0], v[j][1]); w.y = cvt_pk_bf16(v[j][2], v[j][3]);
                    *(u32x2*)(Hb + (size_t)t * 1024 + col) = w; }
                float gl[4];
#pragma unroll
                for (int g = 0; g < 4; ++g) { float a = 0.f;
#pragma unroll
                    for (int j = 0; j < 4; ++j) { const f32x4 w = *(const LAS f32x4*)(wl + g * 1024 + (j * 64 + lane) * 4); a += v[j][0] * w[0] + v[j][1] * w[1] + v[j][2] * w[2] + v[j][3] * w[3]; }
                    gl[g] = wave_sum(a) + bg[g]; }
                int gs = 0; float gm = gl[0];
#pragma unroll
                for (int g = 1; g < 4; ++g) if (gl[g] > gm) { gm = gl[g]; gs = g; }
                float den = 0.f;
#pragma unroll
                for (int g = 0; g < 4; ++g) den += __expf(gl[g] - gm);
                const float pg = 1.0f / den;
                float el[8];
#pragma unroll
                for (int e = 0; e < 8; ++e) { float a = 0.f; const LAS float* wrow = wl + (4 + gs * 8 + e) * 1024;
#pragma unroll
                    for (int j = 0; j < 4; ++j) { const f32x4 w = *(const LAS f32x4*)(wrow + (j * 64 + lane) * 4); a += v[j][0] * w[0] + v[j][1] * w[1] + v[j][2] * w[2] + v[j][3] * w[3]; }
                    el[e] = wave_sum(a) + be[gs * 8 + e]; }
                int i0 = 0; float v0 = el[0];
#pragma unroll
                for (int e = 1; e < 8; ++e) if (el[e] > v0) { v0 = el[e]; i0 = e; }
                int i1 = -1; float v1 = -INFINITY;
#pragma unroll
                for (int e = 0; e < 8; ++e) if (e != i0 && el[e] > v1) { v1 = el[e]; i1 = e; }
                const float p0 = 1.0f / (1.0f + __expf(v1 - v0)), p1 = 1.0f - p0;
                if (lane == 0 && rep_ == 0) { const int e0 = gs * 8 + i0, e1 = gs * 8 + i1;
                    const unsigned s0 = atomicAdd(cnt + e0 * 64, 1u), s1 = atomicAdd(cnt + e1 * 64, 1u);
                    int* sp = sel + (size_t)t * 8; sp[0] = e0; sp[1] = e1; sp[2] = (int)s0; sp[3] = (int)s1; ((float*)sp)[4] = p0 * pg; ((float*)sp)[5] = p1 * pg; }
            }
#undef R_ISSUE
            }
        }
        SEAM(P0 + 11);
        if (ON(12) && RUN(P0 + 12)) { LTID();
            LAS int* offs = (LAS int*)lds;
            if (tid == 0) { int o = 0; for (int e = 0; e < NEXP; ++e) { offs[e] = o; o += ((int)__hip_atomic_load(cnt + e * 64, __ATOMIC_RELAXED, __HIP_MEMORY_SCOPE_AGENT) + 255) & ~255; } offs[NEXP] = o; }
            __syncthreads();
            for (int t = bid * 512 + tid; t < T; t += G * 512) { const int* sp = sel + (size_t)t * 8;
                if (l == NLAYER - 1 && (t % TPB) < NCTX) continue;
                const int q0 = offs[sp[0]] + sp[2], q1 = offs[sp[1]] + sp[3];
                list_tok[q0] = t * 2; list_p[q0] = ((const float*)sp)[4]; list_tok[q1] = t * 2 + 1; list_p[q1] = ((const float*)sp)[5]; }
            for (int e = bid; e < NEXP; e += G) { const int c0 = offs[e] + (int)__hip_atomic_load(cnt + e * 64, __ATOMIC_RELAXED, __HIP_MEMORY_SCOPE_AGENT), c1 = offs[e + 1];
                for (int q = c0 + tid; q < c1; q += 512) { list_tok[q] = -1; list_p[q] = 0.f; }
                if (tid == 0) tile_exp[e] = offs[e] / 256; }
            if (bid == 0 && tid == 0) { ctl[CW_NT + l * 64] = (unsigned)(offs[NEXP] / 256); tile_exp[NEXP] = offs[NEXP] / 256; }
        }
        SEAM(P0 + 12);
        for (int rep_ = 0; rep_ < (DUP == 13 ? 1 + DUPN : 1); ++rep_)
        if (ON(13) && RUN(P0 + 13)) { PHK();
            const int ntl = (int)__hip_atomic_load(ctl + CW_NT + l * 64, __ATOMIC_RELAXED, __HIP_MEMORY_SCOPE_AGENT);
            LAS int* tofl = (LAS int*)(lds + g8::STAGE_BYTES);
            { int t_ = threadIdx.x; asm volatile("" : "+v"(t_)); if (t_ < 33) tofl[t_] = tile_exp[t_]; }
            __syncthreads();
            SchedMoe<true> S{(const char*)Hb, wb + W_13, list_tok, tofl, ntl, 2, 1024, G, bid, (size_t)512 * 1024 * 2}; EpiMoe1 E{HE};
            g8::gemm_phase(lds, S, E);
        }
        SEAM(P0 + 13);
        for (int rep_ = 0; rep_ < (DUP == 14 ? 1 + DUPN : 1); ++rep_)
        if (ON(14) && RUN(P0 + 14)) { PHK();
            const int ntl = (int)__hip_atomic_load(ctl + CW_NT + l * 64, __ATOMIC_RELAXED, __HIP_MEMORY_SCOPE_AGENT);
            LAS int* tofl = (LAS int*)(lds + g8::STAGE_BYTES);
            { int t_ = threadIdx.x; asm volatile("" : "+v"(t_)); if (t_ < 33) tofl[t_] = tile_exp[t_]; }
            __syncthreads();
            SchedMoe<false> S{(const char*)HE, wb + W_2T, list_tok, tofl, ntl, 4, 256, G, bid, (size_t)1024 * 256 * 2}; EpiMoe2 E{Y2, list_tok, list_p};
            g8::gemm_phase(lds, S, E);
        }
        SEAM(P0 + 14);
    }
    if (ON(16) && RUN(PH_FINAL)) { LTID();
        f32x4 gfin[4];
#pragma unroll
        for (int j = 0; j < 4; ++j) gfin[j] = *(const f32x4*)(KP->g_final + (j * 64 + lane) * 4);
        for (int bb = bid; bb < NB_ * SEQ / 128; bb += G) {
            const int b = (bb * 128) / SEQ; f32x4 gf4[4];
            { const float* gf = modv + ((size_t)(NLAYER - 1) * 9 + b) * 6144 + 5120;
#pragma unroll
              for (int j = 0; j < 4; ++j) gf4[j] = *(const f32x4*)(gf + (j * 64 + lane) * 4); }
            u32x2 L_v[4], L_ya[4], L_yb[4];
#define F_ISSUE(RR) do { const int r_ = (RR); const int n_ = r_ - b * SEQ; const bf16_t* xr_ = XB + (size_t)(b * TPB + NCTX + n_) * 1024; const bf16_t* y_ = Y2 + (size_t)(b * TPB + NCTX + n_) * 2048; \
                _Pragma("unroll") for (int j = 0; j < 4; ++j) { const int col = (j * 64 + lane) * 4; L_v[j] = *(const u32x2*)(xr_ + col); L_ya[j] = *(const u32x2*)(y_ + col); L_yb[j] = *(const u32x2*)(y_ + 1024 + col); } } while (0)
            F_ISSUE(bb * 128 + wid);
            for (int it = 0; it < 16; ++it) {
                const int r = bb * 128 + it * 8 + wid; float* xr = KP->out + (size_t)r * DM;
                f32x4 v[4]; u32x2 ya[4], yb[4];
#pragma unroll
                for (int j = 0; j < 4; ++j) { v[j] = unpack4(L_v[j]); ya[j] = L_ya[j]; yb[j] = L_yb[j]; }
                if (it + 1 < 16) F_ISSUE(r + 8);
                __builtin_amdgcn_sched_barrier(0);
                float ss = 0.f;
#pragma unroll
                for (int j = 0; j < 4; ++j) { f32x4 xv = v[j]; const f32x4 g = gf4[j]; const u32x2 a = ya[j], bq = yb[j];
                    xv[0] += g[0] * (__uint_as_float(a.x << 16) + __uint_as_float(bq.x << 16)); xv[1] += g[1] * (__uint_as_float(a.x & 0xffff0000u) + __uint_as_float(bq.x & 0xffff0000u));
                    xv[2] += g[2] * (__uint_as_float(a.y << 16) + __uint_as_float(bq.y << 16)); xv[3] += g[3] * (__uint_as_float(a.y & 0xffff0000u) + __uint_as_float(bq.y & 0xffff0000u));
                    v[j] = xv; ss += xv[0] * xv[0] + xv[1] * xv[1] + xv[2] * xv[2] + xv[3] * xv[3]; }
                ss = wave_sum(ss); const float rstd = rsqrtf(ss * (1.0f / 1024.0f) + 1e-6f);
#pragma unroll
                for (int j = 0; j < 4; ++j) *(f32x4*)(xr + (j * 64 + lane) * 4) = v[j] * rstd * gfin[j];
            }
#undef F_ISSUE
        }
    }
}

extern "C" void kernel_launch(void* const* d_in, const int* in_sizes, int n_in, void* d_out, int out_size, void* d_ws, size_t ws_size, hipStream_t stream) {
    static int grid = 0;
    if (!grid) {
        if (n_in != 32 || ws_size < WS_END) { fprintf(stderr, "kernel_launch: unexpected inputs (n_in %d, ws %zu, need %zu)\n", n_in, ws_size, (size_t)WS_END); grid = -1; return; }
        int dev = 0, cus = 0, per_cu = 0;
        hipGetDevice(&dev); hipDeviceGetAttribute(&cus, hipDeviceAttributeMultiprocessorCount, dev);
        hipFuncSetAttribute((const void*)mega, hipFuncAttributeMaxDynamicSharedMemorySize, LDS_BYTES);
        hipOccupancyMaxActiveBlocksPerMultiprocessor(&per_cu, (const void*)mega, 512, LDS_BYTES);
        if (per_cu < 1) fprintf(stderr, "kernel_launch: occupancy query says %d\n", per_cu);
        grid = cus > 0 ? cus : 256;
    }
    if (grid < 0) return;
    hipMemsetAsync((char*)d_ws + WS_CTL, 0, CTL_BYTES, stream);
    Params p{};
    const float** fp = (const float**)&p;
    for (int i = 0; i < 32; ++i) fp[i] = (const float*)d_in[i];
    p.out = (float*)d_out; p.ws = (char*)d_ws;
#if N_LAUNCH_MODE == 1
    p.lo = 0; p.hi = NPHASE;
    hipLaunchKernelGGL(mega, dim3(grid), dim3(512), LDS_BYTES, stream, p);
#else
    for (int ph = 0; ph < NPHASE; ++ph) {
        p.lo = ph; p.hi = ph + 1;
        hipLaunchKernelGGL(mega, dim3(grid), dim3(512), LDS_BYTES, stream, p);
    }
#endif
}
```

```cpp
#include <hip/hip_runtime.h>
#include <cstdio>
#include <cstdint>

#define LAS __attribute__((address_space(3)))
typedef unsigned short bf16_t;
typedef short bf16x8 __attribute__((ext_vector_type(8)));
typedef float f32x4 __attribute__((ext_vector_type(4)));
typedef float f32x2 __attribute__((ext_vector_type(2)));
typedef float f32x16 __attribute__((ext_vector_type(16)));
typedef unsigned u32x4 __attribute__((ext_vector_type(4)));
typedef unsigned u32x2 __attribute__((ext_vector_type(2)));

#ifndef PHMASK
#define PHMASK 0xFFFFFFFFu
#endif
#define ON(k) ((((unsigned)(PHMASK)) >> (k)) & 1u)
#ifndef ABL
#define ABL 0
#endif
#ifndef DUP
#define DUP -1
#endif
#ifndef DUPN
#define DUPN 3
#endif
#ifndef N_LAUNCH_MODE
#define N_LAUNCH_MODE 1
#endif

constexpr int NB_ = 8, SEQ = 4096, NCTX = 256, DM = 1024, TPB = NCTX + SEQ  , T = NB_ * TPB  , NLAYER = 2;
constexpr int DIN = 5280, NU = 2304;
constexpr int U_XR = 0, U_CKV = 512, U_KR = 640, U_GK = 672, U_GV = 800, U_RG = 928, U_CQ = 1440, U_GQ = 1696, U_MG = 2208;
constexpr int NEXP = 32, DEXP = 256;
constexpr int MAXSLOT = 2 * T + NEXP * 256;
constexpr int NCHUNK = TPB / 64;
constexpr float LOG2E = 1.4426950408889634f;
#define LOG2E_ 1.4426950408889634f
constexpr float QSCALE_G = 0.125f * LOG2E;
constexpr float QSCALE_M = 0.10206207261596575f * LOG2E;

constexpr size_t al256(size_t x) { return (x + 255) & ~(size_t)255; }
constexpr size_t WS_CTL = 0;
constexpr size_t CTL_BYTES = 98304;
constexpr size_t WS_MOD = WS_CTL + CTL_BYTES;
constexpr size_t WS_ROPE = WS_MOD + al256((size_t)2 * 9 * 6144 * 4);
constexpr size_t WS_LRUT = WS_ROPE + (size_t)4096 * 96 * 4;
constexpr size_t WS_WRT = WS_LRUT + 2 * 2 * 512 * 4;
constexpr size_t WS_CARRY = WS_WRT + (size_t)2 * 36 * 1024 * 4;
constexpr size_t WS_SEL = WS_CARRY + (size_t)NB_ * NCHUNK * 2 * 512 * 8;
constexpr size_t WS_LIST = WS_SEL + (size_t)T * 32;
constexpr size_t WS_XSC = WS_LIST + al256((size_t)MAXSLOT * 8 + 2048);
constexpr size_t WS_W = WS_XSC + (size_t)NB_ * NCTX * DM * 4;
constexpr size_t W_IN = 0, W_MG = W_IN + (size_t)NU * 1024 * 2, W_G = W_MG + (size_t)3072 * 1024 * 2, W_UKV = W_G + (size_t)2048 * 512 * 2,
                 W_UQ = W_UKV + (size_t)1024 * 256 * 2, W_BR = W_UQ + (size_t)768 * 256 * 2, W_OUT = W_BR + (size_t)3 * 1024 * 512 * 2,
                 W_13 = W_OUT + (size_t)1024 * 1024 * 2, W_2T = W_13 + (size_t)32 * 512 * 1024 * 2, W_BYTES = W_2T + (size_t)32 * 1024 * 256 * 2;
constexpr size_t WS_H = WS_W + W_BYTES;
constexpr size_t WS_A = WS_H + (size_t)T * 1024 * 2;
constexpr size_t A_BYTES = (size_t)T * NU * 2;
constexpr size_t A_U = 0, A_LAB = 0, A_KM = 0, A_QM = A_KM + (size_t)T * 8 * 64 * 2, A_VMT = A_QM + (size_t)T * 8 * 96 * 2,
                 A_M = 0, A_GT = (size_t)T * 1024 * 2, A_Y2 = 0;
constexpr size_t WS_B = WS_A + A_BYTES;
constexpr size_t B_XC = 0, B_GR = B_XC + (size_t)T * 512 * 2, B_CKVN = B_GR + (size_t)T * 512 * 2, B_CQN = B_CKVN + (size_t)T * 256 * 2,
                 B_QG = B_CQN + (size_t)T * 256 * 2, B_KG = B_QG + (size_t)T * 512 * 2, B_VGT = B_KG + (size_t)T * 128 * 2, B_KR = B_VGT + (size_t)T * 128 * 2,
                 B_BYTES = B_KR + (size_t)T * 32 * 2, B_YM = B_XC, B_YG = B_GR, B_HE = 0;
constexpr size_t WS_C = WS_B + B_BYTES;
constexpr size_t WS_END = WS_C + (size_t)T * 512 * 2;
static_assert(A_VMT + (size_t)T * 8 * 64 * 2 <= A_BYTES, "A overlay");
static_assert(A_GT + (size_t)T * 1024 * 2 <= A_BYTES, "A overlay 2");
static_assert((size_t)T * 2 * 1024 * 2 <= A_BYTES, "A overlay 3");
static_assert((size_t)MAXSLOT * 256 * 2 <= B_BYTES, "B overlay");
static_assert(B_CKVN + (size_t)T * 1024 * 2 <= B_BYTES, "B overlay (M)");
static_assert((size_t)T * 3072 <= A_BYTES, "A overlay (gates)");
static_assert(WS_END <= (size_t)536870912, "workspace");
constexpr int CW_BAR = 0;
constexpr int CW_CNT = 4096;
constexpr int CW_NT = 4096 + 2 * 32 * 64;
constexpr int CW_CMAX = 8448;
constexpr int CW_CMAX2 = CW_CMAX + 2 * 3072;
static_assert((CW_CMAX2 + 2 * 2304) * 4 <= 98304, "control words");

struct Params {
    const float *x, *c, *ctx, *c_ctx, *w_mod, *b_mod, *g_mix, *g_ffn, *w_in, *conv_w, *conv_b, *lru_wa, *lru_ba, *lru_wi, *lru_bi, *lru_lambda,
        *mla_gq, *mla_wuq, *mla_gkv, *mla_wukv, *gqa_gq, *gqa_gk, *w_branch, *w_out, *moe_wg, *moe_bg, *moe_we, *moe_be, *moe_w1, *moe_w3, *moe_w2, *g_final;
    float* out; char* ws; int lo, hi;
};

__device__ __forceinline__ float bf2f(bf16_t b) { return __uint_as_float(((unsigned)b) << 16); }
typedef __bf16 bf16x2_t __attribute__((ext_vector_type(2)));
__device__ __forceinline__ unsigned cvt_pk_bf16(float lo, float hi) { const f32x2 v = {lo, hi}; const bf16x2_t b = __builtin_convertvector(v, bf16x2_t); return __builtin_bit_cast(unsigned, b); }
__device__ __forceinline__ bf16_t f2bf(float f) { return (bf16_t)(cvt_pk_bf16(f, 0.f) & 0xffffu); }
__device__ __forceinline__ float sigmoidf_(float x) { return __builtin_amdgcn_rcpf(1.0f + __builtin_amdgcn_exp2f(-LOG2E_ * x)); }
__device__ __forceinline__ float nexpm1_small(float x) { float q = 1.0f / 720.0f; q = q * x + 1.0f / 120.0f; q = q * x + 1.0f / 24.0f; q = q * x + 1.0f / 6.0f; q = q * x + 0.5f; q = q * x + 1.0f;
    const float big = 1.0f - __builtin_amdgcn_exp2f(x * LOG2E_); return x < -0.25f ? big : -x * q; }
__device__ __forceinline__ float gelu_tanh(float x) { const float u = 0.7978845608028654f * (x + 0.044715f * x * x * x); const float e = __expf(2.0f * u); const float th = 1.0f - 2.0f / (e + 1.0f); return 0.5f * x * (1.0f + th); }
template <int CTRL> __device__ __forceinline__ float dpp_f(float v) { return __builtin_bit_cast(float, __builtin_amdgcn_update_dpp(0, __builtin_bit_cast(int, v), CTRL, 0xF, 0xF, true)); }
__device__ __forceinline__ float red4(float v) { v += dpp_f<0xB1>(v); v += dpp_f<0x4E>(v); return v; }
__device__ __forceinline__ float red8(float v) { v = red4(v); v += dpp_f<0x141>(v); return v; }
__device__ __forceinline__ float red16(float v) { v = red8(v); v += dpp_f<0x140>(v); return v; }
__device__ __forceinline__ float rdl(float v, int l) { return __builtin_bit_cast(float, __builtin_amdgcn_readlane(__builtin_bit_cast(int, v), l)); }
__device__ __forceinline__ float wave_sum(float v) { v = red16(v); return (rdl(v, 0) + rdl(v, 16)) + (rdl(v, 32) + rdl(v, 48)); }
__device__ __forceinline__ f32x4 unpack4(const u32x2 w) { return (f32x4){__uint_as_float(w.x << 16), __uint_as_float(w.x & 0xffff0000u), __uint_as_float(w.y << 16), __uint_as_float(w.y & 0xffff0000u)}; }
__device__ __forceinline__ u32x2 pack4(const f32x4 v) { u32x2 w; w.x = cvt_pk_bf16(v[0], v[1]); w.y = cvt_pk_bf16(v[2], v[3]); return w; }
__device__ __forceinline__ float wave_max_nn(float v) {
    v = fmaxf(v, dpp_f<0xB1>(v)); v = fmaxf(v, dpp_f<0x4E>(v)); v = fmaxf(v, dpp_f<0x141>(v)); v = fmaxf(v, dpp_f<0x140>(v)); return fmaxf(fmaxf(rdl(v, 0), rdl(v, 16)), fmaxf(rdl(v, 32), rdl(v, 48))); }
__device__ __forceinline__ unsigned pack_i8x4(float a, float b, float c, float d, float sc) {
    const unsigned t0 = __float_as_uint(__builtin_fmaf(a, sc, 12582912.0f)), t1 = __float_as_uint(__builtin_fmaf(b, sc, 12582912.0f)), t2 = __float_as_uint(__builtin_fmaf(c, sc, 12582912.0f)), t3 = __float_as_uint(__builtin_fmaf(d, sc, 12582912.0f));
    return __builtin_amdgcn_perm(t1, t0, 0x0c0c0400u) | __builtin_amdgcn_perm(t3, t2, 0x04000c0cu); }
__device__ __forceinline__ void unpack8(const u32x4 w, float (&f)[8]) {
    f[0] = __uint_as_float(w.x << 16); f[1] = __uint_as_float(w.x & 0xffff0000u); f[2] = __uint_as_float(w.y << 16); f[3] = __uint_as_float(w.y & 0xffff0000u);
    f[4] = __uint_as_float(w.z << 16); f[5] = __uint_as_float(w.z & 0xffff0000u); f[6] = __uint_as_float(w.w << 16); f[7] = __uint_as_float(w.w & 0xffff0000u);
}
__device__ __forceinline__ u32x4 pack8(const float (&f)[8]) { u32x4 w; w.x = cvt_pk_bf16(f[0], f[1]); w.y = cvt_pk_bf16(f[2], f[3]); w.z = cvt_pk_bf16(f[4], f[5]); w.w = cvt_pk_bf16(f[6], f[7]); return w; }
#define BUF_RSRC(p) __builtin_amdgcn_make_buffer_rsrc((void*)(p), 0, 0x7fffffff, 0x00020000)
__device__ __forceinline__ float* resid_row(float* out, char* ws, int t) {
    const int b = t / TPB, n = t - b * TPB;
    return n < NCTX ? (float*)(ws + WS_XSC) + ((size_t)b * NCTX + n) * DM : out + ((size_t)b * SEQ + (n - NCTX)) * DM;
}

#define XB_TMO      128
#define XB_XCNT(j)  (256  + 64 * (j))
#define XB_XSUB(j)  (1280 + 64 * (j))
#define XB_XGEN(j)  (2304 + 64 * (j))
#define XB_TOP      3328
#define XB_TOPGEN   3392
#define XCD_BAR_WORDS 3456
#define XB_SPIN_CAP (1u << 18)
__device__ __forceinline__ unsigned xb_ld(unsigned* p)              { return __hip_atomic_load(p, __ATOMIC_RELAXED, __HIP_MEMORY_SCOPE_AGENT); }
__device__ __forceinline__ unsigned xb_add(unsigned* p, unsigned v) { return __hip_atomic_fetch_add(p, v, __ATOMIC_RELAXED, __HIP_MEMORY_SCOPE_AGENT); }
__device__ __forceinline__ unsigned xb_xcc_id() { return (unsigned)__builtin_amdgcn_s_getreg((3 << 11) | 20) & 0xFu; }
#define XB_SPIN(cond, bar) do { unsigned _sp = 0; while (cond) { __builtin_amdgcn_s_sleep(1); \
    if ((++_sp & 255u) == 0u) { if (xb_ld(&(bar)[XB_TMO])) break; if (_sp > XB_SPIN_CAP) { atomicAdd(&(bar)[XB_TMO], 1u); break; } } } } while (0)
struct XcdBarrier { unsigned* bar; unsigned x; volatile LAS unsigned* st; };
__device__ __forceinline__ XcdBarrier xcd_barrier_post(unsigned* bar, volatile LAS unsigned* st) {
    XcdBarrier b; b.bar = bar; b.x = xb_xcc_id(); b.st = st;
    if (threadIdx.x == 0) (void)xb_add(&bar[XB_XCNT(b.x)], 1u);
    return b;
}
__device__ __forceinline__ void xcd_barrier_complete(unsigned* bar, unsigned x, unsigned& nloc, unsigned& nx) {
    const unsigned G = gridDim.x * gridDim.y * gridDim.z;
    unsigned sum, cnt, mine, sp = 0u;
    for (;;) {
        sum = 0u; cnt = 0u; mine = 0u;
#pragma unroll
        for (unsigned j = 0; j < 16; ++j) { const unsigned c = xb_ld(&bar[XB_XCNT(j)]); sum += c; cnt += (c > 0u) ? 1u : 0u; mine = (j == x) ? c : mine; }
        if (sum == G) break;
        __builtin_amdgcn_s_sleep(1);
        if ((++sp & 255u) == 0u) { if (xb_ld(&bar[XB_TMO])) break; if (sp > XB_SPIN_CAP) { atomicAdd(&bar[XB_TMO], 1u); break; } }
    }
    nloc = mine > 0u ? mine : 1u; nx = cnt > 0u ? cnt : 1u;
}
__device__ __forceinline__ void xcd_barrier(const XcdBarrier& b) {
    asm volatile("s_waitcnt vmcnt(0)" ::: "memory");
    __syncthreads();
    if (threadIdx.x == 0) {
        unsigned* bar = b.bar;
        __builtin_amdgcn_s_waitcnt(0);
        unsigned nloc = b.st[0], nx = b.st[1];
        if (nloc == 0u) { xcd_barrier_complete(bar, b.x, nloc, nx); b.st[0] = nloc; b.st[1] = nx; }
        const unsigned old = xb_add(&bar[XB_XSUB(b.x)], 1u);
        const unsigned gen = old / nloc;
        if (old + 1u == (gen + 1u) * nloc) {
            __builtin_amdgcn_fence(__ATOMIC_RELEASE, "agent");
            asm volatile("s_waitcnt vmcnt(0)" ::: "memory");
            const unsigned og = xb_add(&bar[XB_TOP], 1u);
            const unsigned tg = og / nx;
            if (og + 1u == (tg + 1u) * nx) xb_add(&bar[XB_TOPGEN], 1u);
            else XB_SPIN(xb_ld(&bar[XB_TOPGEN]) == tg, bar);
            __builtin_amdgcn_fence(__ATOMIC_ACQUIRE, "agent");
            xb_add(&bar[XB_XGEN(b.x)], 1u);
            asm volatile("s_waitcnt vmcnt(0)" ::: "memory");
        } else {
            XB_SPIN(xb_ld(&bar[XB_XGEN(b.x)]) == gen, bar);
            __builtin_amdgcn_fence(__ATOMIC_ACQUIRE, "agent");
            asm volatile("s_waitcnt vmcnt(0)" ::: "memory");
        }
    }
    __syncthreads();
}

namespace g8 {
constexpr int BM = 256, BK = 64, HALF = 128, HTB = HALF * BK * 2, STAGE_BYTES = 8 * HTB, NXCD = 8, WGM = 8;
__device__ __forceinline__ int lds_byte(int r, int c) { const int st = (r >> 4) * 2 + (c >> 5), rr = r & 15, cc = c & 31, ob = rr * 64 + cc * 2; return st * 1024 + (ob ^ (((ob >> 9) & 1) << 5)); }
__device__ __forceinline__ void stage_rc(int b, int& R, int& C) { const int st = b / 1024, sb = b % 1024, swz = sb ^ (((sb >> 9) & 1) << 5); R = (st >> 1) * 16 + swz / 64; C = (st & 1) * 32 + (swz % 64) / 2; }
__device__ __forceinline__ int perm32(int rho) { const int n = rho >> 4, i = rho & 15; return 8 * (i >> 2) + 4 * n + (i & 3); }

struct Unit { const char* A; const char* B; const int* gidx; int pitchA, pitchB, nt; int pm, pn, aux; int eidx; size_t bstride; int hmask; };

__device__ __forceinline__ bool deal_unit(int i, int G, int c, int nwg, int& uid, int& hmask) {
    const long L = (long)i * G + c; const int full = (nwg / G) * G, rem = nwg - full;
    if (L < full) { uid = (int)L; hmask = 3; return true; }
    const int j = (int)(L - full);
    if (2 * rem <= G) { if (j >= 2 * rem) return false; uid = full + (j >> 1); hmask = 1 << (j & 1); return true; }
    if (j >= rem) return false; uid = full + j; hmask = 3; return true;
}
__device__ __forceinline__ void tile_of(int wgid, int nM, int nN, int& pm, int& pn) {
    const int nwg = nM * nN;
    { const int q = nwg / NXCD, r = nwg % NXCD, xcd = wgid % NXCD, off = wgid / NXCD; wgid = (xcd < r ? xcd * (q + 1) : r * (q + 1) + (xcd - r) * q) + off; }
    const int nig = WGM * nN, gid = wgid / nig, fm = gid * WGM, gsz = (nM - fm) < WGM ? (nM - fm) : WGM;
    pm = fm + ((wgid % nig) % gsz); pn = (wgid % nig) / gsz;
}
__device__ __forceinline__ bool static_tile(int i, int G, int c, int nM, int nN, int& pm, int& pn, int& hmask) {
    int uid; if (!deal_unit(i, G, c, nM * nN, uid, hmask)) return false;
    tile_of(uid, nM, nN, pm, pn); return true;
}

__device__ __forceinline__ void load_gidx(const Unit& u, int tid, int (&gi)[4]) {
#pragma unroll
    for (int i = 0; i < 2; ++i) { int R, C; stage_rc(tid * 16 + i * 8192, R, C);
#pragma unroll
        for (int h = 0; h < 2; ++h) gi[h * 2 + i] = u.gidx[h * HALF + R]; }
}
template <bool PERM, bool GATHER>
__device__ __forceinline__ void calc_voff(const Unit& u, int tid, unsigned (&vA)[2][2], unsigned (&vB)[2], const int (&gi)[4]) {
#pragma unroll
    for (int i = 0; i < 2; ++i) {
        int R, C; stage_rc(tid * 16 + i * 8192, R, C); const int Rb = PERM ? ((R & ~31) + perm32(R & 31)) : R;
        vB[i] = (unsigned)Rb * (unsigned)u.pitchB + (unsigned)C * 2u;
        if (GATHER) {
#pragma unroll
            for (int h = 0; h < 2; ++h) { int g = gi[h * 2 + i]; asm volatile("" : "+v"(g));        const int rowA = g < 0 ? 0 : (g >> 1); vA[h][i] = (unsigned)rowA * (unsigned)u.pitchA + (unsigned)C * 2u; }
        } else { vA[0][i] = (unsigned)R * (unsigned)u.pitchA + (unsigned)C * 2u; vA[1][i] = vA[0][i]; }
    }
}

template <class E, class = void> struct epi_i8 { static constexpr bool value = false; };
template <class E> struct epi_i8<E, decltype((void)E::I8)> { static constexpr bool value = E::I8; };
typedef int i32x4 __attribute__((ext_vector_type(4)));
template <bool I8> __device__ __forceinline__ f32x4 mma16(const bf16x8 a, const bf16x8 b, const f32x4 c) {
    if constexpr (I8) return __builtin_bit_cast(f32x4, __builtin_amdgcn_mfma_i32_16x16x64_i8(__builtin_bit_cast(i32x4, a), __builtin_bit_cast(i32x4, b), __builtin_bit_cast(i32x4, c), 0, 0, 0));
    else return __builtin_amdgcn_mfma_f32_16x16x32_bf16(a, b, c, 0, 0, 0);
}
template <class Epi, class Sched>
__device__ __forceinline__ void gemm_phase(LAS unsigned char* lds, const Sched& S, const Epi& E) {
    int tid_l = threadIdx.x; asm volatile("" : "+v"(tid_l));
    const int tid = tid_l, wid = __builtin_amdgcn_readfirstlane(tid >> 6), lane = tid & 63, wr = wid >> 2, wc = wid & 3, fr = lane & 15, fq = lane >> 4;
    const unsigned ldsw = (unsigned)wid * 1024u;
    const int aoff = lds_byte(wr * 64 + fr, fq * 8), boff = lds_byte(wc * 32 + fr, fq * 8);
#define G8_SA(b, h) (((b) * 2 + (h)) * HTB)
#define G8_SB(b, h) ((4 + (b) * 2 + (h)) * HTB)
#define G8_STAGE(bufoff, gbase, koff, voff) do { _Pragma("unroll") for (int _i = 0; _i < 2; ++_i) \
        __builtin_amdgcn_global_load_lds((const unsigned*)((const char*)(gbase) + (unsigned)((voff)[_i] + (unsigned)(koff))), (LAS unsigned*)(lds + (bufoff) + ldsw + _i * 8192), 16, 0, 0); } while (0)
#define G8_LDA(dst, b, h) do { _Pragma("unroll") for (int m = 0; m < 4; ++m) _Pragma("unroll") for (int k = 0; k < 2; ++k) dst[m][k] = *(const LAS bf16x8*)(lds + G8_SA(b, h) + aoff + m * 2048 + k * 1024); } while (0)
#define G8_LDB(dst, b, h) do { _Pragma("unroll") for (int n = 0; n < 2; ++n) _Pragma("unroll") for (int k = 0; k < 2; ++k) dst[n][k] = *(const LAS bf16x8*)(lds + G8_SB(b, h) + boff + n * 2048 + k * 1024); } while (0)
#define G8_MMA(ai, bj, At, Bt) do { __builtin_amdgcn_s_setprio(1); _Pragma("unroll") for (int m = 0; m < 4; ++m) _Pragma("unroll") for (int n = 0; n < 2; ++n) _Pragma("unroll") for (int k = 0; k < 2; ++k) \
        acc[ai][bj][m][n] = mma16<epi_i8<Epi>::value>(Bt[n][k], At[m][k], acc[ai][bj][m][n]); __builtin_amdgcn_s_setprio(0); } while (0)
#define G8_WAIT_V(n) asm volatile("s_waitcnt vmcnt(" #n ")" ::: "memory")
#define G8_WAIT_L(n) asm volatile("s_waitcnt lgkmcnt(" #n ")" ::: "memory")
#define G8_BAR __builtin_amdgcn_s_barrier()
#define G8_SCHED __builtin_amdgcn_sched_barrier(0)
    Unit cur, nxt; int ui = 0;
    if (!S.next(0, cur)) return;
    f32x4 acc[2][2][4][2];
#pragma unroll
    for (int a = 0; a < 2; ++a)
#pragma unroll
        for (int b = 0; b < 2; ++b)
#pragma unroll
            for (int m = 0; m < 4; ++m)
#pragma unroll
                for (int n = 0; n < 2; ++n) acc[a][b][m][n] = (f32x4){0.f, 0.f, 0.f, 0.f};
    bf16x8 At[4][2], B0[2][2], B1[2][2];
    constexpr bool GA = Sched::GATHER; constexpr int H1 = GA ? 1 : 0;
    unsigned vA[2][2], vB[2];
    { int gi0[4] = {0, 0, 0, 0}; if (GA) load_gidx(cur, tid, gi0); calc_voff<Epi::PERM, GA>(cur, tid, vA, vB, gi0); }
    unsigned hA = GA ? 0u : (unsigned)(HALF * cur.pitchA), hB = (unsigned)(HALF * cur.pitchB);
    const char* cA = cur.A; const char* cB = cur.B + (size_t)cur.eidx * cur.bstride; int nt = cur.nt;
    constexpr unsigned kstep = BK * 2;
    G8_STAGE(G8_SB(0, 0), cB, 0u, vB); G8_STAGE(G8_SB(0, 1), cB, hB, vB); G8_STAGE(G8_SA(0, 0), cA, 0u, vA[0]); G8_STAGE(G8_SA(0, 1), cA, hA, vA[H1]);
    if (wr == 1) G8_BAR;
    G8_WAIT_V(2); G8_BAR;
    G8_STAGE(G8_SB(1, 0), cB, kstep, vB); G8_STAGE(G8_SA(1, 0), cA, kstep, vA[0]); G8_STAGE(G8_SB(1, 1), cB, kstep + hB, vB);
    G8_WAIT_V(6); G8_BAR;
    for (;;) {
        const bool has_next = S.next(ui + 1, nxt);
        int gi[4] = {0, 0, 0, 0};
        if (GA && has_next) load_gidx(nxt, tid, gi);
        const char* nA = has_next ? nxt.A : cA; const char* nB = cB;
        const bool hm0 = (cur.hmask & 1) != 0, hm1 = (cur.hmask & 2) != 0;
        for (int t = 0; t < nt; t += 2) {
            const bool last = (t == nt - 2);
            const unsigned k1 = (unsigned)(t + 1) * kstep, k2 = last ? 0u : (unsigned)(t + 2) * kstep, k3 = k2 + kstep;
            if (last && has_next) { int e = nxt.eidx; asm volatile("" : "+v"(e)); nB = nxt.B + (size_t)__builtin_amdgcn_readfirstlane(e) * nxt.bstride; }
            const char* a2 = last ? nA : cA; const char* b2 = last ? nB : cB;
            G8_LDB(B0, 0, 0); G8_LDB(B1, 0, 1); G8_SCHED; G8_LDA(At, 0, 0); G8_STAGE(G8_SA(1, 1), cA, k1 + hA, vA[H1]);
            if (last && has_next) { calc_voff<Epi::PERM, GA>(nxt, tid, vA, vB, gi); hA = GA ? 0u : (unsigned)(HALF * nxt.pitchA); hB = (unsigned)(HALF * nxt.pitchB); }
            G8_WAIT_V(8); G8_WAIT_L(0); G8_BAR; if (hm0) { G8_MMA(0, 0, At, B0); G8_MMA(0, 1, At, B1); } G8_BAR; G8_SCHED;
            G8_LDA(At, 0, 1); G8_STAGE(G8_SB(0, 0), b2, k2, vB); G8_STAGE(G8_SB(0, 1), b2, k2 + hB, vB); G8_STAGE(G8_SA(0, 0), a2, k2, vA[0]);
            G8_WAIT_V(8); G8_WAIT_L(0); G8_BAR; if (hm1) { G8_MMA(1, 0, At, B0); G8_MMA(1, 1, At, B1); } G8_BAR; G8_SCHED;
            G8_LDB(B0, 1, 0); G8_LDB(B1, 1, 1); G8_SCHED; G8_LDA(At, 1, 0); G8_STAGE(G8_SA(0, 1), a2, k2 + hA, vA[H1]);
            G8_WAIT_V(8); G8_WAIT_L(0); G8_BAR; if (hm0) { G8_MMA(0, 0, At, B0); G8_MMA(0, 1, At, B1); } G8_BAR; G8_SCHED;
            G8_LDA(At, 1, 1); G8_STAGE(G8_SB(1, 0), b2, k3, vB); G8_STAGE(G8_SB(1, 1), b2, k3 + hB, vB); G8_STAGE(G8_SA(1, 0), a2, k3, vA[0]);
            G8_WAIT_V(8); G8_WAIT_L(0); G8_BAR; if (hm1) { G8_MMA(1, 0, At, B0); G8_MMA(1, 1, At, B1); } G8_BAR; G8_SCHED;
        }
        if (wr == 0) G8_BAR;
        G8_SCHED; E(acc, cur, wr, wc, fr, fq); G8_SCHED;
        if (!has_next) break;
        if (!Epi::keeps(cur)) {
#pragma unroll
        for (int a = 0; a < 2; ++a)
#pragma unroll
            for (int b = 0; b < 2; ++b)
#pragma unroll
                for (int m = 0; m < 4; ++m)
#pragma unroll
                    for (int n = 0; n < 2; ++n) acc[a][b][m][n] = (f32x4){0.f, 0.f, 0.f, 0.f};
        }
        cur = nxt; cA = nA; cB = nB; nt = cur.nt; ++ui;
        if (wr == 1) G8_BAR;
    }
    G8_WAIT_V(0);
    G8_BAR;
#undef G8_SA
#undef G8_SB
#undef G8_STAGE
#undef G8_LDA
#undef G8_LDB
#undef G8_MMA
#undef G8_WAIT_V
#undef G8_WAIT_L
#undef G8_BAR
#undef G8_SCHED
}
typedef f32x4 Acc[2][2][4][2];
}
using g8::Unit;

struct SchedDense {
    static constexpr bool GATHER = false;
    const char* A; const char* B; int K, nM, nN, G, c; bool skip;
    __device__ __forceinline__ bool next(int i, Unit& u) const {
        int pm, pn, hm; if (!g8::static_tile(i, G, c, skip ? (nM / 17) * 16 : nM, nN, pm, pn, hm)) return false;
        if (skip) pm = (pm >> 4) * 17 + 1 + (pm & 15);
        u.hmask = hm; u.pitchA = K * 2; u.pitchB = K * 2; u.nt = K / 64; u.pm = pm; u.pn = pn; u.aux = 0; u.gidx = nullptr; u.eidx = 0; u.bstride = 0;
        u.A = A + (size_t)pm * 256 * K * 2; u.B = B + (size_t)pn * 256 * K * 2; return true;
    }
};
struct SchedGate {
    static constexpr bool GATHER = false;
    const char* A; const char* B; int nM, G, c;
    __device__ __forceinline__ bool next(int i, Unit& u) const {
        int pm, pn, hm; if (!g8::static_tile(i, G, c, nM, 8, pm, pn, hm)) return false;
        u.hmask = hm;
        int two = 2; asm volatile("" : "+s"(two));
        u.pitchA = 1024; u.pitchB = 256; u.nt = two; u.pm = pm; u.pn = pn; u.aux = 0; u.gidx = nullptr; u.eidx = 0; u.bstride = 0;
        u.A = A + (size_t)pm * 256 * 1024 + (size_t)(pn >> 1) * 256; u.B = B + (size_t)pn * 256 * 256; return true;
    }
};
struct SchedMerge {
    static constexpr bool GATHER = false;
    const char* wsb; const char* WBR; int nM, G, c; bool skip;
    __device__ __forceinline__ bool next(int i, Unit& u) const {
        const int ti = i / 3, k = i - ti * 3;
        int pm, pn, hm; if (!g8::static_tile(ti, G, c, skip ? (nM / 17) * 16 : nM, 4, pm, pn, hm)) return false;
        u.hmask = hm;
        if (skip) pm = (pm >> 4) * 17 + 1 + (pm & 15);
        u.pm = pm; u.pn = pn; u.aux = k; u.gidx = nullptr; u.eidx = 0; u.bstride = 0;
        u.pitchA = 1024; u.pitchB = 1024; u.nt = 8; { const size_t yo = k == 0 ? WS_C : (k == 1 ? WS_B + B_YM : WS_B + B_YG); u.A = wsb + yo + (size_t)pm * 256 * 1024; } u.B = WBR + ((size_t)k * 1024 + pn * 256) * 1024;
        return true;
    }
};
template <bool GA_> struct SchedMoe {
    static constexpr bool GATHER = GA_;
    const char* A; const char* Bw; const int* list; const LAS int* toffs; int ntiles, nN, K, G, c; size_t strideB;
    __device__ __forceinline__ bool next(int i, Unit& u) const {
        int uid, hm; if (!g8::deal_unit(i, G, c, ntiles * nN, uid, hm)) return false;
        const int tile = uid / nN, pn = uid - tile * nN; u.hmask = hm;
        int e = 0;
#pragma unroll
        for (int st = 16; st >= 1; st >>= 1) if (toffs[e + st] <= tile) e += st;
        u.pm = tile; u.pn = pn; u.aux = 0; u.pitchA = K * 2; u.pitchB = K * 2; u.nt = K / 64; u.eidx = 0; u.bstride = 0;
        u.gidx = GA_ ? list + (size_t)tile * 256 : nullptr; u.A = GA_ ? A : A + (size_t)tile * 256 * K * 2;
        u.B = Bw + (size_t)e * strideB + (size_t)pn * 256 * K * 2; return true;
    }
};

struct EpiBf16Plain {
    static __device__ __forceinline__ bool keeps(const Unit&) { return false; }
    static constexpr bool PERM = true;
    bf16_t* O; int ldc;
    __device__ __forceinline__ void operator()(const g8::Acc& acc, const Unit& u, int wr, int wc, int fr, int fq) const {
        const int row0 = u.pm * 256 + wr * 64 + fr, col0 = u.pn * 256 + wc * 32 + 8 * fq;
#pragma unroll
        for (int ai = 0; ai < 2; ++ai) if ((u.hmask >> ai) & 1)
#pragma unroll
            for (int m = 0; m < 4; ++m) { bf16_t* rowp = O + (size_t)(row0 + ai * 128 + m * 16) * ldc + col0;
#pragma unroll
                for (int bj = 0; bj < 2; ++bj) { const f32x4 v0 = acc[ai][bj][m][0], v1 = acc[ai][bj][m][1];
                    u32x4 w; w.x = cvt_pk_bf16(v0[0], v0[1]); w.y = cvt_pk_bf16(v0[2], v0[3]); w.z = cvt_pk_bf16(v1[0], v1[1]); w.w = cvt_pk_bf16(v1[2], v1[3]);
                    *(u32x4*)(rowp + bj * 128) = w; } }
    }
};
struct EpiBf16I8 {
    static __device__ __forceinline__ bool keeps(const Unit&) { return false; }
    static constexpr bool PERM = true;
    static constexpr bool I8 = true;
    bf16_t* O; int ldc; const float* rs_; const float* cm_;
    __device__ __forceinline__ void operator()(const g8::Acc& acc, const Unit& u, int wr, int wc, int fr, int fq) const {
        asm volatile("" : "+v"(fr), "+v"(fq));
        const int row0 = u.pm * 256 + wr * 64 + fr, col0 = u.pn * 256 + wc * 32 + 8 * fq;
        f32x4 cs[2][2];
#pragma unroll
        for (int bj = 0; bj < 2; ++bj)
#pragma unroll
            for (int h = 0; h < 2; ++h) cs[bj][h] = *(const f32x4*)(cm_ + col0 + bj * 128 + 4 * h) * (1.0f / 127.0f);
        float rsv[2][4];
#pragma unroll
        for (int ai = 0; ai < 2; ++ai)
#pragma unroll
            for (int m = 0; m < 4; ++m) rsv[ai][m] = rs_[row0 + ai * 128 + m * 16];
#pragma unroll
        for (int ai = 0; ai < 2; ++ai) if ((u.hmask >> ai) & 1)
#pragma unroll
            for (int m = 0; m < 4; ++m) { bf16_t* rowp = O + (size_t)(row0 + ai * 128 + m * 16) * ldc + col0; const float rs = rsv[ai][m];
#pragma unroll
                for (int bj = 0; bj < 2; ++bj) { const g8::i32x4 i0 = __builtin_bit_cast(g8::i32x4, acc[ai][bj][m][0]), i1 = __builtin_bit_cast(g8::i32x4, acc[ai][bj][m][1]);
                    const f32x4 v0 = (f32x4){(float)i0[0], (float)i0[1], (float)i0[2], (float)i0[3]} * rs * cs[bj][0], v1 = (f32x4){(float)i1[0], (float)i1[1], (float)i1[2], (float)i1[3]} * rs * cs[bj][1];
                    u32x4 w; w.x = cvt_pk_bf16(v0[0], v0[1]); w.y = cvt_pk_bf16(v0[2], v0[3]); w.z = cvt_pk_bf16(v1[0], v1[1]); w.w = cvt_pk_bf16(v1[2], v1[3]);
                    *(u32x4*)(rowp + bj * 128) = w; } }
    }
};
struct EpiGate {
    static __device__ __forceinline__ bool keeps(const Unit&) { return false; }
    static constexpr bool PERM = false;
    const bf16_t* xc_; bf16_t* lab_; const float* ba; const float* bi; const float* logu;
    __device__ __forceinline__ void operator()(const g8::Acc& acc, const Unit& u, int wr, int wc, int fr_, int fq_) const {
        int fr = fr_, fq = fq_; asm volatile("" : "+v"(fr), "+v"(fq));
        const int row0 = u.pm * 256 + wr * 64 + fr; const int c = u.pn * 64 + wc * 16 + fq * 4;
        const f32x4 baf = *(const f32x4*)(ba + c), bif = *(const f32x4*)(bi + c), bab = *(const f32x4*)(ba + 512 + c), bib = *(const f32x4*)(bi + 512 + c), luf = *(const f32x4*)(logu + c), lub = *(const f32x4*)(logu + 512 + c);
        u32x2 xw[2][4];
#pragma unroll
        for (int ai = 0; ai < 2; ++ai) if ((u.hmask >> ai) & 1)
#pragma unroll
            for (int m = 0; m < 4; ++m) xw[ai][m] = *(const u32x2*)(xc_ + (size_t)(row0 + ai * 128 + m * 16) * 512 + c);
        asm volatile("" ::: "memory");
#pragma unroll
        for (int ai = 0; ai < 2; ++ai) if ((u.hmask >> ai) & 1)
#pragma unroll
            for (int m = 0; m < 4; ++m) {
                const size_t row = (size_t)(row0 + ai * 128 + m * 16);
                const float xc[4] = {__uint_as_float(xw[ai][m].x << 16), __uint_as_float(xw[ai][m].x & 0xffff0000u), __uint_as_float(xw[ai][m].y << 16), __uint_as_float(xw[ai][m].y & 0xffff0000u)};
                unsigned w[8];
#pragma unroll
                for (int i = 0; i < 4; ++i) {
                    const float rf = sigmoidf_(acc[ai][0][m][0][i] + baf[i]), i_f = sigmoidf_(acc[ai][0][m][1][i] + bif[i]), rb = sigmoidf_(acc[ai][1][m][0][i] + bab[i]), ib = sigmoidf_(acc[ai][1][m][1][i] + bib[i]);
                    const float laf = rf * luf[i], lab = rb * lub[i];
                    const float bf_ = __builtin_amdgcn_sqrtf(nexpm1_small(2.0f * laf)) * i_f * xc[i], bb_ = __builtin_amdgcn_sqrtf(nexpm1_small(2.0f * lab)) * ib * xc[i];
                    w[2 * i] = cvt_pk_bf16(laf, bf_); w[2 * i + 1] = cvt_pk_bf16(lab, bb_);
                }
                u32x4* dp = (u32x4*)(lab_ + (row * 512 + c) * 4);
                dp[0] = (u32x4){w[0], w[1], w[2], w[3]}; dp[1] = (u32x4){w[4], w[5], w[6], w[7]};
            }
    }
};
struct EpiUkv {
    static __device__ __forceinline__ bool keeps(const Unit&) { return false; }
    static constexpr bool PERM = false;
    bf16_t* km_; bf16_t* vmt_;
    __device__ __forceinline__ void operator()(const g8::Acc& acc, const Unit& u, int wr, int wc, int fr, int fq) const {
        const int b = u.pm / 17, nb = (u.pm - b * 17) * 256 + wr * 64 + fr;
#pragma unroll
        for (int bj = 0; bj < 2; ++bj) { const int h = u.pn * 2 + bj; const size_t bh = (size_t)b * 8 + h;
#pragma unroll
            for (int n = 0; n < 2; ++n) { const int j = wc * 32 + n * 16 + fq * 4;
#pragma unroll
                for (int ai = 0; ai < 2; ++ai) if ((u.hmask >> ai) & 1)
#pragma unroll
                    for (int m = 0; m < 4; ++m) { const int nn = nb + ai * 128 + m * 16; const f32x4 v = acc[ai][bj][m][n];
                        if (wc < 2) { u32x2 w; w.x = cvt_pk_bf16(v[0], v[1]); w.y = cvt_pk_bf16(v[2], v[3]); *(u32x2*)(km_ + (bh * TPB + nn) * 64 + j) = w; }
                        else {
                            float a0 = v[0], a1 = v[1], a2 = v[2], a3 = v[3];
                            { const bool bq = (fr & 2) != 0; const float s0 = bq ? a0 : a2, s1 = bq ? a1 : a3; const float r0 = dpp_f<0x4E>(s0), r1 = dpp_f<0x4E>(s1); if (bq) { a0 = r0; a1 = r1; } else { a2 = r0; a3 = r1; } }
                            { const bool cq = (fr & 1) != 0; const float s0 = cq ? a0 : a1, s1 = cq ? a2 : a3; const float r0 = dpp_f<0xB1>(s0), r1 = dpp_f<0xB1>(s1); if (cq) { a0 = r0; a2 = r1; } else { a1 = r0; a3 = r1; } }
                            u32x2 w; w.x = cvt_pk_bf16(a0, a1); w.y = cvt_pk_bf16(a2, a3);
                            *(u32x2*)(vmt_ + (bh * 64 + (j - 64) + (fr & 3)) * TPB + (nn & ~3)) = w; } } } }
    }
};
struct EpiUq {
    static __device__ __forceinline__ bool keeps(const Unit&) { return false; }
    static constexpr bool PERM = false;
    bf16_t* qm_; const float* cm_; const float* sm_;
    __device__ __forceinline__ void operator()(const g8::Acc& acc, const Unit& u, int wr, int wc, int fr, int fq) const {
        const int b = u.pm / 17, nb = (u.pm - b * 17) * 256 + wr * 64 + fr; const bool lat = (u.pm - b * 17) != 0;
#pragma unroll
        for (int bj = 0; bj < 2; ++bj) { const int G = (u.pn * 256 + bj * 128 + wc * 32) >> 5, h = G / 3, gg = G - h * 3; const size_t bh = (size_t)b * 8 + h;
#pragma unroll
            for (int ai = 0; ai < 2; ++ai) if ((u.hmask >> ai) & 1)
#pragma unroll
                for (int m = 0; m < 4; ++m) { const int nn = nb + ai * 128 + m * 16; f32x4 v0 = acc[ai][bj][m][0] * QSCALE_M, v1 = acc[ai][bj][m][1] * QSCALE_M;
                    bf16_t* qp = qm_ + (bh * TPB + nn) * 96 + gg * 32 + fq * 4;
                    if (ABL != 5 && gg == 2 && lat) { const f32x4 cs = *(const f32x4*)(cm_ + (size_t)(nn - NCTX) * 16 + fq * 4), sn = *(const f32x4*)(sm_ + (size_t)(nn - NCTX) * 16 + fq * 4);
                        const f32x4 o0 = v0 * cs - v1 * sn, o1 = v0 * sn + v1 * cs; v0 = o0; v1 = o1; }
                    u32x2 w0, w1; w0.x = cvt_pk_bf16(v0[0], v0[1]); w0.y = cvt_pk_bf16(v0[2], v0[3]); w1.x = cvt_pk_bf16(v1[0], v1[1]); w1.y = cvt_pk_bf16(v1[2], v1[3]);
                    *(u32x2*)qp = w0; *(u32x2*)(qp + 16) = w1; } }
    }
};
struct EpiGateU8 {
    static __device__ __forceinline__ bool keeps(const Unit&) { return false; }
    static constexpr bool PERM = true;
    unsigned char* g8_;
    __device__ __forceinline__ void operator()(const g8::Acc& acc, const Unit& u, int wr, int wc, int fr, int fq) const {
        const int row0 = u.pm * 256 + wr * 64 + fr, col0 = u.pn * 256 + wc * 32 + 8 * fq;
#pragma unroll
        for (int ai = 0; ai < 2; ++ai) if ((u.hmask >> ai) & 1)
#pragma unroll
            for (int m = 0; m < 4; ++m)
#pragma unroll
                for (int bj = 0; bj < 2; ++bj) { const f32x4 v0 = acc[ai][bj][m][0], v1 = acc[ai][bj][m][1]; const float f[8] = {v0[0], v0[1], v0[2], v0[3], v1[0], v1[1], v1[2], v1[3]};
                    u32x2 w = {0u, 0u};
#pragma unroll
                    for (int j = 0; j < 4; ++j) { w.x = __builtin_amdgcn_cvt_pk_u8_f32(fmaxf(sigmoidf_(f[j]) * 255.0f, 1.0f), j, w.x); w.y = __builtin_amdgcn_cvt_pk_u8_f32(fmaxf(sigmoidf_(f[4 + j]) * 255.0f, 1.0f), j, w.y); }
                    *(u32x2*)(g8_ + (size_t)(row0 + ai * 128 + m * 16) * 3072 + col0 + bj * 128) = w; }
    }
};
struct EpiGateI8 {
    static __device__ __forceinline__ bool keeps(const Unit&) { return false; }
    static constexpr bool PERM = true;
    static constexpr bool I8 = true;
    unsigned char* g8_; const float* rs_; const float* cm_;
    __device__ __forceinline__ void operator()(const g8::Acc& acc, const Unit& u, int wr, int wc, int fr, int fq) const {
        asm volatile("" : "+v"(fr), "+v"(fq));
        const int row0 = u.pm * 256 + wr * 64 + fr, col0 = u.pn * 256 + wc * 32 + 8 * fq;
        f32x4 cs[2][2];
#pragma unroll
        for (int bj = 0; bj < 2; ++bj)
#pragma unroll
            for (int h = 0; h < 2; ++h) cs[bj][h] = *(const f32x4*)(cm_ + col0 + bj * 128 + 4 * h) * (-LOG2E_ / 127.0f);
        float rsv[2][4];
#pragma unroll
        for (int ai = 0; ai < 2; ++ai)
#pragma unroll
            for (int m = 0; m < 4; ++m) rsv[ai][m] = rs_[row0 + ai * 128 + m * 16];
#pragma unroll
        for (int ai = 0; ai < 2; ++ai) if ((u.hmask >> ai) & 1)
#pragma unroll
            for (int m = 0; m < 4; ++m)
#pragma unroll
                for (int bj = 0; bj < 2; ++bj) { const g8::i32x4 v0 = __builtin_bit_cast(g8::i32x4, acc[ai][bj][m][0]), v1 = __builtin_bit_cast(g8::i32x4, acc[ai][bj][m][1]); const float rs = rsv[ai][m];
                    u32x2 w = {0u, 0u};
#pragma unroll
                    for (int j = 0; j < 4; ++j) {
                        const float s0 = __builtin_amdgcn_rcpf(1.0f + __builtin_amdgcn_exp2f((float)v0[j] * rs * cs[bj][0][j])), s1 = __builtin_amdgcn_rcpf(1.0f + __builtin_amdgcn_exp2f((float)v1[j] * rs * cs[bj][1][j]));
                        w.x = __builtin_amdgcn_cvt_pk_u8_f32(fmaxf(s0 * 255.0f, 1.0f), j, w.x); w.y = __builtin_amdgcn_cvt_pk_u8_f32(fmaxf(s1 * 255.0f, 1.0f), j, w.y); }
                    *(u32x2*)(g8_ + (size_t)(row0 + ai * 128 + m * 16) * 3072 + col0 + bj * 128) = w; }
    }
};
struct EpiMerge {
    static constexpr bool PERM = true;
    static __device__ __forceinline__ bool keeps(const Unit& u) { return u.aux < 2; }
    bf16_t* mb_; const unsigned char* g8_;
    __device__ __forceinline__ void operator()(g8::Acc& acc, const Unit& u, int wr, int wc, int fr_, int fq_) const {
        int fr = fr_, fq = fq_; asm volatile("" : "+v"(fr), "+v"(fq));
        const int row0 = u.pm * 256 + wr * 64 + fr, col0 = u.pn * 256 + wc * 32 + 8 * fq; const int k = u.aux;
        const unsigned char* ga = g8_ + k * 1024 + col0; const unsigned char* gb = g8_ + (k < 2 ? k + 1 : k) * 1024 + col0;
#pragma unroll
        for (int am = 0; am < 4; ++am) {
            const int ai = am >> 1, m0 = (am & 1) * 2;
            if (!((u.hmask >> ai) & 1)) continue;
            u32x2 wa[2][2], wb2[2][2];
#pragma unroll
            for (int mm = 0; mm < 2; ++mm)
#pragma unroll
                for (int bj = 0; bj < 2; ++bj) { const size_t o = (size_t)(row0 + ai * 128 + (m0 + mm) * 16) * 3072 + bj * 128; wa[mm][bj] = *(const u32x2*)(ga + o); wb2[mm][bj] = *(const u32x2*)(gb + o); }
            asm volatile("" ::: "memory");
#pragma unroll
            for (int mm = 0; mm < 2; ++mm)
#pragma unroll
                for (int bj = 0; bj < 2; ++bj) { const int m = m0 + mm;
                    float sc[8];
#pragma unroll
                    for (int j = 0; j < 8; ++j) { const float a = (float)(((j < 4 ? wa[mm][bj].x : wa[mm][bj].y) >> (8 * (j & 3))) & 255u), bq = (float)(((j < 4 ? wb2[mm][bj].x : wb2[mm][bj].y) >> (8 * (j & 3))) & 255u);
                        sc[j] = k == 2 ? a * (1.0f / 255.0f) : a * __builtin_amdgcn_rcpf(bq); }
                    const f32x4 v0 = acc[ai][bj][m][0] * (f32x4){sc[0], sc[1], sc[2], sc[3]}, v1 = acc[ai][bj][m][1] * (f32x4){sc[4], sc[5], sc[6], sc[7]};
                    acc[ai][bj][m][0] = v0; acc[ai][bj][m][1] = v1;
                    if (k == 2) { u32x4 w; w.x = cvt_pk_bf16(v0[0], v0[1]); w.y = cvt_pk_bf16(v0[2], v0[3]); w.z = cvt_pk_bf16(v1[0], v1[1]); w.w = cvt_pk_bf16(v1[2], v1[3]);
                        *(u32x4*)(mb_ + (size_t)(row0 + ai * 128 + m * 16) * 1024 + col0 + bj * 128) = w; }
                }
            asm volatile("" ::: "memory");
        }
    }
};
struct EpiOut {
    static __device__ __forceinline__ bool keeps(const Unit&) { return false; }
    static constexpr bool PERM = false;
    bf16_t* xb_; const float* in_; const float* inc_; const float* mod_;
    __device__ __forceinline__ void operator()(const g8::Acc& acc, const Unit& u, int wr, int wc, int fr, int fq) const {
        const int b = u.pm / 17, pt = u.pm - b * 17; const bool isctx = pt == 0;
        if (ABL == 7 && isctx) return;
        const float* ga = mod_ + (size_t)(isctx ? 8 : b) * 6144 + 2048;
        const int r0 = wr * 64 + fr, col0 = u.pn * 256 + wc * 32 + 4 * fq;
        bf16_t* xrow = xb_ + (size_t)(u.pm * 256 + r0) * DM + col0;
        f32x4 g[2][2];
#pragma unroll
        for (int bj = 0; bj < 2; ++bj)
#pragma unroll
            for (int n = 0; n < 2; ++n) g[bj][n] = *(const f32x4*)(ga + col0 + bj * 128 + n * 16);
#pragma unroll
        for (int ai = 0; ai < 2; ++ai) { if (!((u.hmask >> ai) & 1)) continue;
            f32x4 r[4][2][2];
            if (in_) { const float* rbase = (isctx ? inc_ + (size_t)b * NCTX * DM : in_ + ((size_t)b * SEQ + (size_t)(pt - 1) * 256) * DM) + (size_t)r0 * DM + col0;
#pragma unroll
                for (int m = 0; m < 4; ++m)
#pragma unroll
                    for (int bj = 0; bj < 2; ++bj)
#pragma unroll
                        for (int n = 0; n < 2; ++n) r[m][bj][n] = *(const f32x4*)(rbase + (size_t)(ai * 128 + m * 16) * DM + bj * 128 + n * 16);
            } else { u32x2 q[4][2][2];
#pragma unroll
                for (int m = 0; m < 4; ++m)
#pragma unroll
                    for (int bj = 0; bj < 2; ++bj)
#pragma unroll
                        for (int n = 0; n < 2; ++n) q[m][bj][n] = *(const u32x2*)(xrow + (size_t)(ai * 128 + m * 16) * DM + bj * 128 + n * 16);
                asm volatile("" ::: "memory");
#pragma unroll
                for (int m = 0; m < 4; ++m)
#pragma unroll
                    for (int bj = 0; bj < 2; ++bj)
#pragma unroll
                        for (int n = 0; n < 2; ++n) r[m][bj][n] = unpack4(q[m][bj][n]);
            }
            asm volatile("" ::: "memory");
#pragma unroll
            for (int m = 0; m < 4; ++m)
#pragma unroll
                for (int bj = 0; bj < 2; ++bj)
#pragma unroll
                    for (int n = 0; n < 2; ++n) *(u32x2*)(xrow + (size_t)(ai * 128 + m * 16) * DM + bj * 128 + n * 16) = pack4(r[m][bj][n] + g[bj][n] * acc[ai][bj][m][n]);
            asm volatile("" ::: "memory");
        }
    }
};
struct EpiMoe1 {
    static __device__ __forceinline__ bool keeps(const Unit&) { return false; }
    static constexpr bool PERM = false;
    bf16_t* he_;
    __device__ __forceinline__ void operator()(const g8::Acc& acc, const Unit& u, int wr, int wc, int fr, int fq) const {
        const int row0 = u.pm * 256 + wr * 64 + fr;
#pragma unroll
        for (int bj = 0; bj < 2; ++bj) { const int j0 = u.pn * 128 + bj * 64 + wc * 16 + fq * 4;
#pragma unroll
            for (int ai = 0; ai < 2; ++ai) if ((u.hmask >> ai) & 1)
#pragma unroll
                for (int m = 0; m < 4; ++m) { const f32x4 a = acc[ai][bj][m][0], bb = acc[ai][bj][m][1]; float o[4];
#pragma unroll
                    for (int j = 0; j < 4; ++j) o[j] = a[j] * sigmoidf_(a[j]) * bb[j];
                    u32x2 w; w.x = cvt_pk_bf16(o[0], o[1]); w.y = cvt_pk_bf16(o[2], o[3]);
                    *(u32x2*)(he_ + (size_t)(row0 + ai * 128 + m * 16) * 256 + j0) = w; } }
    }
};
struct EpiMoe2 {
    static __device__ __forceinline__ bool keeps(const Unit&) { return false; }
    static constexpr bool PERM = true;
    bf16_t* y2_; const int* ltok_; const float* lp_;
    __device__ __forceinline__ void operator()(const g8::Acc& acc, const Unit& u, int wr, int wc, int fr_, int fq_) const {
        int fr = fr_, fq = fq_; asm volatile("" : "+v"(fr), "+v"(fq));
        const int row0 = u.pm * 256 + wr * 64 + fr, col0 = u.pn * 256 + wc * 32 + 8 * fq;
        int tk[2][4]; float pw[2][4];
#pragma unroll
        for (int ai = 0; ai < 2; ++ai) if ((u.hmask >> ai) & 1)
#pragma unroll
            for (int m = 0; m < 4; ++m) { const int slot = row0 + ai * 128 + m * 16; tk[ai][m] = ltok_[slot]; pw[ai][m] = lp_[slot]; }
#pragma unroll
        for (int ai = 0; ai < 2; ++ai) if ((u.hmask >> ai) & 1)
#pragma unroll
            for (int m = 0; m < 4; ++m) {
                if (tk[ai][m] >= 0) { bf16_t* rowp = y2_ + (size_t)tk[ai][m] * 1024 + col0;
                    const float pq = ABL == 3 ? 0.f : pw[ai][m];
#pragma unroll
                    for (int bj = 0; bj < 2; ++bj) { const f32x4 v0 = acc[ai][bj][m][0] * pq, v1 = acc[ai][bj][m][1] * pq;
                        u32x4 w; w.x = cvt_pk_bf16(v0[0], v0[1]); w.y = cvt_pk_bf16(v0[2], v0[3]); w.z = cvt_pk_bf16(v1[0], v1[1]); w.w = cvt_pk_bf16(v1[2], v1[3]);
                        *(u32x4*)(rowp + bj * 128) = w; } } }
    }
};

__device__ __forceinline__ float half_max(float m) { auto rr = __builtin_amdgcn_permlane32_swap(__float_as_uint(m), __float_as_uint(m), false, false); return __builtin_fmaxf(__uint_as_float(rr[0]), __uint_as_float(rr[1])); }
__device__ __forceinline__ float half_sum(float m) { auto rr = __builtin_amdgcn_permlane32_swap(__float_as_uint(m), __float_as_uint(m), false, false); return __uint_as_float(rr[0]) + __uint_as_float(rr[1]); }
__device__ __forceinline__ float max3f(float a, float b, float c) { return __builtin_fmaxf(__builtin_fmaxf(a, b), c); }
__device__ __forceinline__ float max2f(float a, float b) { return __builtin_fmaxf(a, b); }
template <int DQK, int NQ, int NS, bool SAFE>
__device__ __forceinline__ bool attn_unit(
    LAS unsigned char* lds, const bf16_t* Q, const bf16_t* Kn, const bf16_t* Kr, const bf16_t* Vt, int nkeys, bf16_t* O  ) {
    constexpr int KB = 8192, RB_ = (DQK == 96) ? 4096 : 0, VB = 8192, SUB = KB + RB_ + VB, BUF = NS * SUB;
    constexpr int ND = DQK / 16;
    constexpr float THR = 8.0f;
    int tid_l = threadIdx.x; asm volatile("" : "+v"(tid_l));
    const int tid = tid_l, lane = tid & 63, r32 = lane & 31, hi = lane >> 5; const int wid = __builtin_amdgcn_readfirstlane(tid >> 6);
    LAS float* scr = (LAS float*)(lds + 2 * BUF) + wid * 32;
    bf16x8 qf[NQ][ND];
#pragma unroll
    for (int q = 0; q < NQ; ++q) { const bf16_t* qrow = Q + (size_t)((wid * NQ + q) * 32 + r32) * DQK + hi * 8;
#pragma unroll
      for (int d0 = 0; d0 < ND; ++d0) qf[q][d0] = *(const bf16x8*)(qrow + d0 * 16); }
    const int drow = wid * 8 + (lane >> 3), dch = (lane & 7) ^ ((drow >> 1) & 7);
    const unsigned ksrc = (unsigned)(drow * 128 + dch * 16);
    const unsigned vsrc = (unsigned)(drow * (TPB * 2) + dch * 16);
    const int rrow = (wid & 3) * 16 + (lane >> 2), rch = (lane & 3) ^ ((rrow >> 2) & 3);
    const unsigned rsrc = (unsigned)(rrow * 64 + rch * 16);
    const int NT = nkeys / (64 * NS);
    auto dma = [&](int t, int boff) {
#pragma unroll
        for (int u = 0; u < NS; ++u) { const int k0 = (t * NS + u) * 64; LAS unsigned char* sb = lds + boff + u * SUB;
            __builtin_amdgcn_global_load_lds((const unsigned*)((const char*)Kn + (unsigned)(ksrc + (unsigned)k0 * 128u)), (LAS unsigned*)(sb + wid * 1024), 16, 0, 0);
            if (DQK == 96) { if (wid < 4) __builtin_amdgcn_global_load_lds((const unsigned*)((const char*)Kr + (unsigned)(rsrc + (unsigned)k0 * 64u)), (LAS unsigned*)(sb + KB + wid * 1024), 16, 0, 0); }
            __builtin_amdgcn_global_load_lds((const unsigned*)((const char*)Vt + (unsigned)(vsrc + (unsigned)k0 * 2u)), (LAS unsigned*)(sb + KB + RB_ + wid * 1024), 16, 0, 0); }
    };
    dma(0, 0);
    asm volatile("s_waitcnt vmcnt(0)" ::: "memory");
    __syncthreads();
    f32x16 o0[NQ], o1[NQ]; float m_run[NQ], l_run[NQ]; bool zref[NQ];
#pragma unroll
    for (int q = 0; q < NQ; ++q) { o0[q] = f32x16{}; o1[q] = f32x16{}; m_run[q] = 0.f; l_run[q] = 0.f; zref[q] = true; }
    const int ksw = (r32 & 19) | ((r32 & 4) << 1) | ((r32 & 8) >> 1);
    const int kro = ksw * 128, ksx = (ksw >> 1) & 7, rro = ksw * 64, rsx = (ksw >> 2) & 3, vro = r32 * 128, vsx = (r32 >> 1) & 7;
    for (int t = 0; t < NT; ++t) {
        if (t + 1 < NT) dma(t + 1, ((t + 1) & 1) * BUF);
        const LAS unsigned char* bb = lds + (t & 1) * BUF;
#pragma unroll
        for (int u = 0; u < NS; ++u) {
            const LAS unsigned char* kb = bb + u * SUB; const LAS unsigned char* rb = kb + KB; const LAS unsigned char* vb = rb + RB_;
            f32x16 p0[NQ], p1[NQ];
#pragma unroll
            for (int q = 0; q < NQ; ++q) { p0[q] = f32x16{}; p1[q] = f32x16{}; }
            __builtin_amdgcn_s_setprio(1);
#pragma unroll
            for (int d0 = 0; d0 < ND; ++d0) {
                bf16x8 a0, a1;
                if (d0 < 4) { const int off = kro + (((2 * d0 + hi) ^ ksx) << 4); a0 = *(const LAS bf16x8*)(kb + off); a1 = *(const LAS bf16x8*)(kb + 4096 + off); }
                else { const int off = rro + (((2 * (d0 - 4) + hi) ^ rsx) << 4); a0 = *(const LAS bf16x8*)(rb + off); a1 = *(const LAS bf16x8*)(rb + 2048 + off); }
#pragma unroll
                for (int q = 0; q < NQ; ++q) { p0[q] = __builtin_amdgcn_mfma_f32_32x32x16_bf16(a0, qf[q][d0], p0[q], 0, 0, 0); p1[q] = __builtin_amdgcn_mfma_f32_32x32x16_bf16(a1, qf[q][d0], p1[q], 0, 0, 0); }
            }
            __builtin_amdgcn_s_setprio(0);
            bf16x8 pa[NQ][4];
#pragma unroll
            for (int q = 0; q < NQ; ++q) {
                if (ABL == 4) { p0[q] = f32x16{}; p1[q] = f32x16{}; }
                if (SAFE) {
                    float mx = max2f(p0[q][0], p1[q][0]);
#pragma unroll
                    for (int r = 1; r < 16; ++r) mx = max3f(mx, p0[q][r], p1[q][r]);
                    mx = half_max(mx);
                    const bool first = (t == 0 && u == 0);
                    if (first ? __any(__builtin_fabsf(mx) > THR) : __any(mx - m_run[q] > THR)) {
                        const float m_new = first ? mx : max2f(m_run[q], mx); const float alpha = first ? 1.0f : __builtin_amdgcn_exp2f(m_run[q] - m_new);
                        m_run[q] = m_new; l_run[q] *= alpha; zref[q] = false;
                        if (hi == 0) scr[r32] = alpha;
#pragma unroll
                        for (int r = 0; r < 16; ++r) { const float al = scr[(r & 3) + 8 * (r >> 2) + 4 * hi]; o0[q][r] *= al; o1[q][r] *= al; }
                    }
                }
                float ps = 0.f;
                if (!SAFE || zref[q]) {
#pragma unroll
                    for (int r = 0; r < 16; ++r) { p0[q][r] = __builtin_amdgcn_exp2f(p0[q][r]); ps += p0[q][r]; }
#pragma unroll
                    for (int r = 0; r < 16; ++r) { p1[q][r] = __builtin_amdgcn_exp2f(p1[q][r]); ps += p1[q][r]; }
                } else {
                    const float mr = m_run[q];
#pragma unroll
                    for (int r = 0; r < 16; ++r) { p0[q][r] = __builtin_amdgcn_exp2f(p0[q][r] - mr); ps += p0[q][r]; }
#pragma unroll
                    for (int r = 0; r < 16; ++r) { p1[q][r] = __builtin_amdgcn_exp2f(p1[q][r] - mr); ps += p1[q][r]; }
                }
                l_run[q] += ps;
                u32x4 w; const f32x16& a = p0[q]; const f32x16& c = p1[q];
                w.x = cvt_pk_bf16(a[0], a[1]); w.y = cvt_pk_bf16(a[2], a[3]); w.z = cvt_pk_bf16(a[4], a[5]); w.w = cvt_pk_bf16(a[6], a[7]); pa[q][0] = __builtin_bit_cast(bf16x8, w);
                w.x = cvt_pk_bf16(a[8], a[9]); w.y = cvt_pk_bf16(a[10], a[11]); w.z = cvt_pk_bf16(a[12], a[13]); w.w = cvt_pk_bf16(a[14], a[15]); pa[q][1] = __builtin_bit_cast(bf16x8, w);
                w.x = cvt_pk_bf16(c[0], c[1]); w.y = cvt_pk_bf16(c[2], c[3]); w.z = cvt_pk_bf16(c[4], c[5]); w.w = cvt_pk_bf16(c[6], c[7]); pa[q][2] = __builtin_bit_cast(bf16x8, w);
                w.x = cvt_pk_bf16(c[8], c[9]); w.y = cvt_pk_bf16(c[10], c[11]); w.z = cvt_pk_bf16(c[12], c[13]); w.w = cvt_pk_bf16(c[14], c[15]); pa[q][3] = __builtin_bit_cast(bf16x8, w);
            }
#pragma unroll
            for (int s = 0; s < 4; ++s) {
                const int off = vro + (((2 * s + hi) ^ vsx) << 4);
                const bf16x8 v0 = *(const LAS bf16x8*)(vb + off);
                const bf16x8 v1 = *(const LAS bf16x8*)(vb + 4096 + off);
#pragma unroll
                for (int q = 0; q < NQ; ++q) { o0[q] = __builtin_amdgcn_mfma_f32_32x32x16_bf16(pa[q][s], v0, o0[q], 0, 0, 0); o1[q] = __builtin_amdgcn_mfma_f32_32x32x16_bf16(pa[q][s], v1, o1[q], 0, 0, 0); }
            }
            if (NQ > 1) __builtin_amdgcn_sched_barrier(0);
        }
        asm volatile("s_waitcnt vmcnt(0)" ::: "memory");
        __syncthreads();
    }
    bool bad = false;
#pragma unroll
    for (int q = 0; q < NQ; ++q) {
        const float lt = half_sum(l_run[q]);
        bad = bad || !(lt > 7.9e-31f && lt < 1.2e30f);
        if (hi == 0) scr[r32] = 1.0f / lt;
        bf16_t* orow = O + (size_t)((wid * NQ + q) * 32) * 512;
#pragma unroll
        for (int r = 0; r < 16; ++r) { const int qq = (r & 3) + 8 * (r >> 2) + 4 * hi; const float il = scr[qq];
            orow[(size_t)qq * 512 + r32] = f2bf(ABL == 1 ? 0.f : o0[q][r] * il); orow[(size_t)qq * 512 + 32 + r32] = f2bf(ABL == 1 ? 0.f : o1[q][r] * il); }
    }
    __syncthreads();
    return !SAFE && (__any(bad) || ABL == 6);
}
#ifndef ATTN_PRIO
#define ATTN_PRIO 4
#endif
template <int DQK, int NS>
__device__ __forceinline__ bool attn16_unit(LAS unsigned char* lds, const bf16_t* Q, const bf16_t* Kn, const bf16_t* Kr, const bf16_t* Vt, int nkeys, bf16_t* O) {
    constexpr int KB = 8192, RB_ = (DQK == 96) ? 4096 : 0, VB = 8192, SUB = KB + RB_ + VB, BUF = NS * SUB;
    constexpr int KS = DQK / 32;
    int tid_l = threadIdx.x; asm volatile("" : "+v"(tid_l));
    const int tid = tid_l, lane = tid & 63, li = lane & 15, g = lane >> 4; const int wid = __builtin_amdgcn_readfirstlane(tid >> 6);
    LAS float* scr = (LAS float*)(lds + 2 * BUF) + wid * 64;
    bf16x8 qf[4][KS];
#pragma unroll
    for (int qt = 0; qt < 4; ++qt) { const bf16_t* qrow = Q + (size_t)(wid * 64 + qt * 16 + li) * DQK + g * 8;
#pragma unroll
        for (int ks = 0; ks < KS; ++ks) qf[qt][ks] = *(const bf16x8*)(qrow + ks * 32); }
    const int drow = wid * 8 + (lane >> 3), dch = (lane & 7) ^ (2 * ((drow >> 1) & 1) + 4 * ((drow >> 3) & 1));
    const unsigned ksrc = (unsigned)(drow * 128 + dch * 16), vsrc = (unsigned)(drow * (TPB * 2) + dch * 16);
    const int rrow = (wid & 3) * 16 + (lane >> 2), rch = (lane & 3) ^ (2 * ((rrow >> 3) & 1));
    const unsigned rsrc = (unsigned)(rrow * 64 + rch * 16);
    const int NT = nkeys / (64 * NS);
    auto dma = [&](int t, int boff) {
#pragma unroll
        for (int u = 0; u < NS; ++u) { const int k0 = (t * NS + u) * 64; LAS unsigned char* sb = lds + boff + u * SUB;
            __builtin_amdgcn_global_load_lds((const unsigned*)((const char*)Kn + (unsigned)(ksrc + (unsigned)k0 * 128u)), (LAS unsigned*)(sb + wid * 1024), 16, 0, 0);
            if (DQK == 96) { if (wid < 4) __builtin_amdgcn_global_load_lds((const unsigned*)((const char*)Kr + (unsigned)(rsrc + (unsigned)k0 * 64u)), (LAS unsigned*)(sb + KB + wid * 1024), 16, 0, 0); }
            __builtin_amdgcn_global_load_lds((const unsigned*)((const char*)Vt + (unsigned)(vsrc + (unsigned)k0 * 2u)), (LAS unsigned*)(sb + KB + RB_ + wid * 1024), 16, 0, 0); }
    };
    dma(0, 0);
    asm volatile("s_waitcnt vmcnt(0)" ::: "memory");
    __syncthreads();
    f32x4 o[4][4], ol[4];
#pragma unroll
    for (int qt = 0; qt < 4; ++qt) { ol[qt] = (f32x4){0.f, 0.f, 0.f, 0.f};
#pragma unroll
        for (int dt = 0; dt < 4; ++dt) o[qt][dt] = (f32x4){0.f, 0.f, 0.f, 0.f}; }
    const bf16x8 ones = {(short)0x3F80, (short)0x3F80, (short)0x3F80, (short)0x3F80, (short)0x3F80, (short)0x3F80, (short)0x3F80, (short)0x3F80};
    const int krow = 8 * (li >> 2) + (li & 3), fk = 2 * ((li >> 1) & 1) + 4 * ((li >> 2) & 1), fr = 2 * ((li >> 2) & 1);
    const int fv = 2 * ((li >> 1) & 1) + 4 * ((li >> 3) & 1);
    for (int t = 0; t < NT; ++t) {
        if (t + 1 < NT) dma(t + 1, ((t + 1) & 1) * BUF);
        const LAS unsigned char* bb = lds + (t & 1) * BUF;
#pragma unroll
        for (int u = 0; u < NS; ++u) {
            const LAS unsigned char* kb = bb + u * SUB; const LAS unsigned char* rb = kb + KB; const LAS unsigned char* vb = rb + RB_;
#pragma unroll
            for (int b32 = 0; b32 < 2; ++b32) {
                f32x4 sT[2][4];
#pragma unroll
                for (int T2 = 0; T2 < 2; ++T2)
#pragma unroll
                    for (int qt = 0; qt < 4; ++qt) sT[T2][qt] = (f32x4){0.f, 0.f, 0.f, 0.f};
                if (ATTN_PRIO) __builtin_amdgcn_s_setprio(ATTN_PRIO == 4 ? 2 : 1);
#pragma unroll
                for (int ks = 0; ks < KS; ++ks) {
                    bf16x8 kf[2];
#pragma unroll
                    for (int T2 = 0; T2 < 2; ++T2) { const int row = 32 * b32 + 4 * T2 + krow;
                        kf[T2] = ks < 2 ? *(const LAS bf16x8*)(kb + row * 128 + (((4 * ks + g) ^ fk) << 4)) : *(const LAS bf16x8*)(rb + row * 64 + ((g ^ fr) << 4)); }
#pragma unroll
                    for (int T2 = 0; T2 < 2; ++T2)
#pragma unroll
                        for (int qt = 0; qt < 4; ++qt) sT[T2][qt] = __builtin_amdgcn_mfma_f32_16x16x32_bf16(kf[T2], qf[qt][ks], sT[T2][qt], 0, 0, 0);
                }
                if (ATTN_PRIO && ATTN_PRIO != 3) __builtin_amdgcn_s_setprio(ATTN_PRIO == 4 ? 1 : 0);
                bf16x8 pf[4];
#pragma unroll
                for (int qt = 0; qt < 4; ++qt) {
                    float e[8];
#pragma unroll
                    for (int j = 0; j < 4; ++j) { e[j] = __builtin_amdgcn_exp2f(ABL == 4 ? 0.f : sT[0][qt][j]); e[4 + j] = __builtin_amdgcn_exp2f(ABL == 4 ? 0.f : sT[1][qt][j]); }
                    u32x4 w; w.x = cvt_pk_bf16(e[0], e[1]); w.y = cvt_pk_bf16(e[2], e[3]); w.z = cvt_pk_bf16(e[4], e[5]); w.w = cvt_pk_bf16(e[6], e[7]); pf[qt] = __builtin_bit_cast(bf16x8, w);
                }
                bf16x8 vf[4];
#pragma unroll
                for (int dt = 0; dt < 4; ++dt) vf[dt] = *(const LAS bf16x8*)(vb + (16 * dt + li) * 128 + (((4 * b32 + g) ^ fv) << 4));
                if (ATTN_PRIO == 3 || ATTN_PRIO == 4) __builtin_amdgcn_s_setprio(0);
                if (ATTN_PRIO == 2) __builtin_amdgcn_s_setprio(1);
#pragma unroll
                for (int qt = 0; qt < 4; ++qt) {
#pragma unroll
                    for (int dt = 0; dt < 4; ++dt) o[qt][dt] = __builtin_amdgcn_mfma_f32_16x16x32_bf16(pf[qt], vf[dt], o[qt][dt], 0, 0, 0);
                    ol[qt] = __builtin_amdgcn_mfma_f32_16x16x32_bf16(pf[qt], ones, ol[qt], 0, 0, 0); }
                if (ATTN_PRIO == 2) __builtin_amdgcn_s_setprio(0);
                __builtin_amdgcn_sched_barrier(0);
            }
        }
        asm volatile("s_waitcnt vmcnt(0)" ::: "memory");
        __syncthreads();
    }
    bool bad = false;
#pragma unroll
    for (int qt = 0; qt < 4; ++qt)
#pragma unroll
        for (int r = 0; r < 4; ++r) { const float lt = ol[qt][r]; bad = bad || !(lt > 7.9e-31f && lt < 1.2e30f); }
#pragma unroll
    for (int qt = 0; qt < 4; ++qt)
#pragma unroll
        for (int r = 0; r < 4; ++r) { const float il = 1.0f / ol[qt][r]; bf16_t* orow = O + (size_t)(wid * 64 + qt * 16 + 4 * g + r) * 512 + li;
#pragma unroll
            for (int dt = 0; dt < 4; ++dt) orow[dt * 16] = f2bf(ABL == 1 ? 0.f : o[qt][dt][r] * il); }
    __syncthreads();
    return __any(bad) || ABL == 6;
}

template <int DQK, int NQ, int NS>
__device__ __forceinline__ void attn_run(LAS unsigned char* lds, const bf16_t* Q, const bf16_t* Kn, const bf16_t* Kr, const bf16_t* Vt, int nkeys, bf16_t* O) {
    const bool bad = NQ == 2 ? attn16_unit<DQK, NS>(lds, Q, Kn, Kr, Vt, nkeys, O) : attn_unit<DQK, NQ, NS, false>(lds, Q, Kn, Kr, Vt, nkeys, O);
    LAS unsigned* flag = (LAS unsigned*)(lds + 160 * 1024 - 64);
    int t_ = threadIdx.x; asm volatile("" : "+v"(t_));
    if (t_ == 0) *flag = 0u;
    __syncthreads();
    if (bad && (t_ & 63) == 0) *flag = 1u;
    __syncthreads();
    const unsigned any_bad = *flag;
    __syncthreads();
    if (any_bad) {
#pragma unroll
        for (int h = 0; h < NQ; ++h) attn_unit<DQK, 1, NS, true>(lds, Q + (size_t)h * 256 * DQK, Kn, Kr, Vt, nkeys, O + (size_t)h * 256 * 512);
    }
}

template <class F>
__device__ __forceinline__ void cvt_tile(LAS unsigned char* buf, bf16_t* dst, int dst_ld, int tid, F srcp) {
    const int w = tid >> 6, lane = tid & 63;
    f32x4 v[8];
#pragma unroll
    for (int i = 0; i < 8; ++i) { const float* sp = srcp(8 * w + i, lane); v[i] = sp ? *(const f32x4*)sp : (f32x4){0.f, 0.f, 0.f, 0.f}; }
#pragma unroll
    for (int j = 0; j < 4; ++j) { u32x4 o; o.x = cvt_pk_bf16(v[0][j], v[1][j]); o.y = cvt_pk_bf16(v[2][j], v[3][j]); o.z = cvt_pk_bf16(v[4][j], v[5][j]); o.w = cvt_pk_bf16(v[6][j], v[7][j]);
        const int n = 4 * lane + j; *(LAS u32x4*)(buf + n * 128 + ((w ^ (lane & 7)) << 4)) = o; }
    __syncthreads();
#pragma unroll
    for (int i = 0; i < 4; ++i) { const int e = tid + i * 512, n = e >> 3, c = e & 7; const u32x4 o = *(const LAS u32x4*)(buf + n * 128 + ((c ^ ((n >> 2) & 7)) << 4));
        *(u32x4*)(dst + (size_t)n * dst_ld + c * 8) = o; }
}

template <class F>
__device__ __forceinline__ void cvt_tile_i8(LAS unsigned char* buf, unsigned char* dst, int dst_ld, int tid, const float* cmax, F srcp) {
    const int w = tid >> 6, lane = tid & 63;
    f32x4 v[8];
#pragma unroll
    for (int i = 0; i < 8; ++i) { const float* sp = srcp(8 * w + i, lane); v[i] = sp ? *(const f32x4*)sp : (f32x4){0.f, 0.f, 0.f, 0.f}; }
    const f32x4 cm = *(const f32x4*)(cmax + 4 * lane);
#pragma unroll
    for (int j = 0; j < 4; ++j) { const float sc = 127.0f / fmaxf(cm[j], 1e-30f); u32x2 o; o.x = pack_i8x4(v[0][j], v[1][j], v[2][j], v[3][j], sc); o.y = pack_i8x4(v[4][j], v[5][j], v[6][j], v[7][j], sc);
        *(LAS u32x2*)(buf + (4 * lane + j) * 64 + w * 8) = o; }
    __syncthreads();
#pragma unroll
    for (int i = 0; i < 2; ++i) { const int e = tid + i * 512, n = e >> 2, c = e & 3; *(u32x4*)(dst + (size_t)n * dst_ld + c * 16) = *(const LAS u32x4*)(buf + n * 64 + c * 16); }
}

constexpr int LDS_BYTES = 163840;
constexpr int NPH_PRO = 1;
constexpr int NPH_LAYER = 15;
constexpr int PH_FINAL = NPH_PRO + NLAYER * NPH_LAYER;
constexpr int NPHASE = PH_FINAL + 1;

__global__ void __launch_bounds__(512, 2) mega(Params kp) {
    extern __shared__ __attribute__((aligned(16))) unsigned char lds_raw[];
    LAS unsigned char* lds = (LAS unsigned char*)lds_raw;
    const int ph_lo = kp.lo, ph_hi = kp.hi;
    typedef const __attribute__((address_space(4))) Params* KPtr;
#define PHK() int koff_ = 0, Gl_ = gridDim.x, bidl_ = blockIdx.x; asm volatile("" : "+s"(koff_), "+s"(Gl_), "+s"(bidl_)); const int G = Gl_, bid = bidl_; (void)G; (void)bid; const KPtr KP = (KPtr)((const __attribute__((address_space(4))) char*)__builtin_amdgcn_kernarg_segment_ptr() + koff_)
#define LTID() PHK(); int tid_l = threadIdx.x; asm volatile("" : "+v"(tid_l)); const int tid = tid_l, lane = tid & 63; const int wid = __builtin_amdgcn_readfirstlane(tid >> 6); (void)lane; (void)wid
    unsigned* ctl = (unsigned*)(kp.ws + WS_CTL);
    volatile LAS unsigned* xbw = (volatile LAS unsigned*)(lds + LDS_BYTES - 16);
    if (threadIdx.x == 0) { xbw[0] = 0u; xbw[1] = 0u; xbw[2] = 0u; xbw[3] = 0u; }
    __syncthreads();
    XcdBarrier bar = xcd_barrier_post(ctl + CW_BAR, xbw);
#define RUN(id) (ph_lo <= (id) && (id) < ph_hi)
#define SEAM(id) do { if (ph_lo <= (id) && (id) + 1 < ph_hi) { xcd_barrier(bar); if (DUP == 15) xcd_barrier(bar); } } while (0)

#define modv ((float*)(KP->ws + WS_MOD))
#define cosG ((float*)(KP->ws + WS_ROPE))
#define sinG (cosG + 4096 * 32)
#define cosM (cosG + 2 * 4096 * 32)
#define sinM (cosG + 2 * 4096 * 32 + 4096 * 16)
#define lrut ((float*)(KP->ws + WS_LRUT))
#define wrt ((float*)(KP->ws + WS_WRT))
#define carry ((f32x2*)(KP->ws + WS_CARRY))
#define sel ((int*)(KP->ws + WS_SEL))
#define list_tok ((int*)(KP->ws + WS_LIST))
#define list_p ((float*)(KP->ws + WS_LIST + (size_t)MAXSLOT * 4))
#define tile_exp ((int*)(KP->ws + WS_LIST + (size_t)MAXSLOT * 8))
#define xsc ((float*)(KP->ws + WS_XSC))
#define wb (KP->ws + WS_W)
#define Hb ((bf16_t*)KP->out)
#define H8 ((unsigned char*)KP->out + (size_t)T * 1024 * 2)
#define RS8 ((float*)((char*)KP->out + (size_t)T * 1024 * 3))
#define CMAX(l_) ((const float*)(KP->ws + WS_CTL) + CW_CMAX + (l_) * 3072)
#define CMAX2(l_) ((const float*)(KP->ws + WS_CTL) + CW_CMAX2 + (l_) * 2304)
#define XB ((bf16_t*)(KP->ws + WS_H))
#define RA (KP->ws + WS_A)
#define RB (KP->ws + WS_B)
#define Ub ((bf16_t*)(RA + A_U))
#define LAB ((bf16_t*)(RA + A_LAB))
#define KM ((bf16_t*)(RA + A_KM))
#define QM ((bf16_t*)(RA + A_QM))
#define VMt ((bf16_t*)(RA + A_VMT))
#define Mb ((bf16_t*)(RB + B_CKVN))
#define GT ((bf16_t*)(RA + A_GT))
#define Y2 ((bf16_t*)(RA + A_Y2))
#define XC ((bf16_t*)(RB + B_XC))
#define GR ((bf16_t*)(RB + B_GR))
#define CKVN ((bf16_t*)(RB + B_CKVN))
#define CQN ((bf16_t*)(RB + B_CQN))
#define QG ((bf16_t*)(RB + B_QG))
#define KG ((bf16_t*)(RB + B_KG))
#define VGt ((bf16_t*)(RB + B_VGT))
#define KR ((bf16_t*)(RB + B_KR))
#define YM ((bf16_t*)(RB + B_YM))
#define YG ((bf16_t*)(RB + B_YG))
#define HE ((bf16_t*)(RB + B_HE))
#define YR ((bf16_t*)(KP->ws + WS_C))

    for (int rep_ = 0; rep_ < (DUP == 0 ? 1 + DUPN : 1); ++rep_)
    if (ON(0) && RUN(0)) { LTID();
        LAS float* sc_ = (LAS float*)lds;
        LAS float* red = sc_ + 9 * 1024;
        for (int e = tid; e < 9 * 1024; e += 512) { const int r = e >> 10, k = e & 1023; const float v = r < 8 ? KP->c[r * 1024 + k] : KP->c_ctx[k]; sc_[e] = v / (1.0f + __expf(-v)); }
        __syncthreads();
        for (int cb = bid; cb < 256; cb += G) {
            const int colg = cb * 48, l = colg / 6144, n0 = colg - l * 6144;
            const int cs = tid % 48, kg = tid / 48;
            float a[9] = {0.f, 0.f, 0.f, 0.f, 0.f, 0.f, 0.f, 0.f, 0.f};
            if (kg < 10) { const int k0 = kg * 103, k1 = (k0 + 103) < 1024 ? (k0 + 103) : 1024; const float* wp = KP->w_mod + (size_t)l * 1024 * 6144 + n0 + cs;
                for (int k = k0; k < k1; k += 8) { float w[8];
#pragma unroll
                    for (int u = 0; u < 8; ++u) w[u] = (k + u < k1) ? wp[(size_t)(k + u) * 6144] : 0.f;
#pragma unroll
                    for (int u = 0; u < 8; ++u) { const int kk = (k + u < k1) ? k + u : k;
#pragma unroll
                        for (int r = 0; r < 9; ++r) a[r] += sc_[r * 1024 + kk] * w[u]; } }
#pragma unroll
                for (int r = 0; r < 9; ++r) red[(kg * 48 + cs) * 9 + r] = a[r]; }
            __syncthreads();
            if (tid < 48 * 9) { const int c2 = tid / 9, r = tid - c2 * 9; float s = KP->b_mod[l * 6144 + n0 + c2];
                for (int g = 0; g < 10; ++g) s += red[(g * 48 + c2) * 9 + r];
                modv[((size_t)l * 9 + r) * 6144 + n0 + c2] = s; }
            __syncthreads();
        }
        { LAS float* cmx = (LAS float*)lds;
          for (int ti = bid; ti < 2 * 21 * 16; ti += G) { const int l2 = ti / 336, q = ti - l2 * 336, ns = q % 21, ks = q / 21;
              const int n = ns * 256 + 4 * lane, col = n < U_MG ? n : (n < NU ? -1 : n - (NU - U_MG));
              const float* src = KP->w_in + (size_t)l2 * 1024 * DIN + (size_t)(ks * 64 + 8 * wid) * DIN + (col < 0 ? 0 : col);
              f32x4 mx = {0.f, 0.f, 0.f, 0.f};
#pragma unroll
              for (int i = 0; i < 8; ++i) { const f32x4 v = col < 0 ? (f32x4){0.f, 0.f, 0.f, 0.f} : *(const f32x4*)(src + (size_t)i * DIN); mx[0] = fmaxf(mx[0], __builtin_fabsf(v[0])); mx[1] = fmaxf(mx[1], __builtin_fabsf(v[1])); mx[2] = fmaxf(mx[2], __builtin_fabsf(v[2])); mx[3] = fmaxf(mx[3], __builtin_fabsf(v[3])); }
              *(LAS f32x4*)(cmx + wid * 256 + 4 * lane) = mx;
              __syncthreads();
              if (tid < 256) { float m = cmx[tid];
#pragma unroll
                  for (int w = 1; w < 8; ++w) m = fmaxf(m, cmx[w * 256 + tid]);
                  atomicMax((unsigned*)(KP->ws + WS_CTL) + (ns < 9 ? CW_CMAX2 + l2 * 2304 + ns * 256 : CW_CMAX + l2 * 3072 + (ns - 9) * 256) + tid, __float_as_uint(m)); }
              __syncthreads(); } }
        for (int e = bid * 512 + tid; e < 4096 * 48; e += G * 512) {
            const int pos = e / 48, j = e - pos * 48; const float row = (float)(pos >> 6), col = (float)(pos & 63);
            if (j < 32) { const int q = j & 15; const float f = powf(10000.0f, -(float)q / 16.0f); const float ang = (j < 16 ? row : col) * f; float s, c; sincosf(ang, &s, &c); cosG[pos * 32 + j] = c; sinG[pos * 32 + j] = s; }
            else { const int jj = j - 32, q = jj & 7; const float f = powf(10000.0f, -(float)q / 8.0f); const float ang = (jj < 8 ? row : col) * f; float s, c; sincosf(ang, &s, &c); cosM[pos * 16 + jj] = c; sinM[pos * 16 + jj] = s; }
        }
        for (int e = bid * 512 + tid; e < 2 * 2 * 512; e += G * 512) { const float lam = KP->lru_lambda[e]; const float sp = (-lam > 20.f) ? -lam : log1pf(__expf(-lam)); lrut[e] = -8.0f * sp; }
        for (int e = bid * 512 + tid; e < 2 * 36 * 1024; e += G * 512) { const int l = e / (36 * 1024), r = (e / 1024) % 36, k = e & 1023;
            wrt[e] = r < 4 ? KP->moe_wg[((size_t)l * 1024 + k) * 4 + r] : KP->moe_we[((size_t)l * 1024 + k) * 32 + (r - 4)]; }
    }
    SEAM(0);

    for (int l = 0; l < NLAYER; ++l) {
        const int P0 = NPH_PRO + l * NPH_LAYER;
#define modl (modv + (size_t)l * 9 * 6144)
        unsigned* cnt = ctl + CW_CNT + l * 32 * 64;
        if (ON(1) && RUN(P0 + 0)) { LTID();
            for (int rep_ = 0; rep_ < (DUP == 1 ? 1 + DUPN : 1); ++rep_) {
            int par = 0;
            for (int ti = bid; ti < 2060; ti += G, par ^= 1) {
                LAS unsigned char* buf = lds + par * 32768;
                if (ti < 336 && ti % 21 >= 9) { const int ns = ti % 21 - 9, ks = ti / 21; const float* src = KP->w_in + (size_t)l * 1024 * DIN + (size_t)ks * 64 * DIN + U_MG + ns * 256;
                    cvt_tile_i8(buf, (unsigned char*)(wb + W_MG) + (size_t)ns * 256 * 1024 + ks * 64, 1024, tid, CMAX(l) + ns * 256, [=](int kk, int ln) -> const float* { return src + (size_t)kk * DIN + 4 * ln; });
                } else if (ti < 336) { const int ns = ti % 21, ks = ti / 21; const float* src = KP->w_in + (size_t)l * 1024 * DIN + (size_t)ks * 64 * DIN;
                    cvt_tile_i8(buf, (unsigned char*)(wb + W_IN) + (size_t)ns * 256 * 1024 + ks * 64, 1024, tid, CMAX2(l) + ns * 256, [=](int kk, int ln) -> const float* { const int n = ns * 256 + 4 * ln; return n < U_MG ? src + (size_t)kk * DIN + n : nullptr; });
                } else if (ti < 352) { const int q = ti - 336, ns = q & 3, ks = q >> 2; const float* src = KP->mla_wukv + (size_t)l * 128 * 1024 + (size_t)ks * 64 * 1024 + ns * 256;
                    cvt_tile(buf, (bf16_t*)(wb + W_UKV) + (size_t)ns * 256 * 256 + ks * 64, 256, tid, [=](int kk, int ln) -> const float* { return ks < 2 ? src + (size_t)kk * 1024 + 4 * ln : nullptr; });
                } else if (ti < 364) { const int q = ti - 352, ns = q % 3, ks = q / 3; const float* src = KP->mla_wuq + (size_t)l * 256 * 768 + (size_t)ks * 64 * 768 + ns * 256;
                    cvt_tile(buf, (bf16_t*)(wb + W_UQ) + (size_t)ns * 256 * 256 + ks * 64, 256, tid, [=](int kk, int ln) -> const float* { return src + (size_t)kk * 768 + 4 * ln; });
                } else if (ti < 460) { const int q = ti - 364, br = q >> 5, r = q & 31, ns = r & 3, ks = r >> 2; const float* src = KP->w_branch + ((size_t)l * 3 + br) * 512 * 1024 + (size_t)ks * 64 * 1024 + ns * 256;
                    cvt_tile(buf, (bf16_t*)(wb + W_BR) + (size_t)br * 1024 * 512 + (size_t)ns * 256 * 512 + ks * 64, 512, tid, [=](int kk, int ln) -> const float* { return src + (size_t)kk * 1024 + 4 * ln; });
                } else if (ti < 524) { const int q = ti - 460, ns = q & 3, ks = q >> 2; const float* src = KP->w_out + (size_t)l * 1024 * 1024 + (size_t)ks * 64 * 1024 + ns * 256;
                    cvt_tile(buf, (bf16_t*)(wb + W_OUT) + (size_t)ns * 256 * 1024 + ks * 64, 1024, tid, [=](int kk, int ln) -> const float* { return src + (size_t)kk * 1024 + 4 * ln; });
                } else if (ti < 1548) { const int q = ti - 524, e = q >> 5, r = q & 31, ns = r & 1, ks = r >> 1;
                    const float* s1 = KP->moe_w1 + ((size_t)l * NEXP + e) * 1024 * 256 + (size_t)ks * 64 * 256; const float* s3 = KP->moe_w3 + ((size_t)l * NEXP + e) * 1024 * 256 + (size_t)ks * 64 * 256;
                    cvt_tile(buf, (bf16_t*)(wb + W_13) + (size_t)e * 512 * 1024 + (size_t)ns * 256 * 1024 + ks * 64, 1024, tid, [=](int kk, int ln) -> const float* { const int n = ns * 256 + 4 * ln, g = n >> 5, i = n & 31; return (i < 16 ? s1 : s3) + (size_t)kk * 256 + 16 * g + (i & 15); });
                } else { const int q = ti - 1548, e = q >> 4, r = q & 15, ns = r & 3, ks = r >> 2; const float* src = KP->moe_w2 + ((size_t)l * NEXP + e) * 256 * 1024 + (size_t)ks * 64 * 1024 + ns * 256;
                    cvt_tile(buf, (bf16_t*)(wb + W_2T) + (size_t)e * 1024 * 256 + (size_t)ns * 256 * 256 + ks * 64, 256, tid, [=](int kk, int ln) -> const float* { return src + (size_t)kk * 1024 + 4 * ln; });
                }
            }
            __syncthreads();
            for (int e = bid * 512 + tid; e < 8 * 256 * 128; e += G * 512) {
                const int pn = e >> 15, r = (e >> 7) & 255, k = e & 127; const int g = 2 * (r >> 7) + ((r >> 4) & 1), cl = 16 * ((r >> 5) & 3) + (r & 15), dir = g >> 1; float v = 0.f;
                if ((k >> 6) == (pn & 1)) { const float* w = (g & 1) ? KP->lru_wi : KP->lru_wa; v = w[((((size_t)l * 2 + dir) * 8 + pn) * 64 + (k & 63)) * 64 + cl]; }
                ((bf16_t*)(wb + W_G))[e] = f2bf(v);
            }
            }
            for (int rep2_ = 0; rep2_ < ((DUP == 20 && l == 0) ? 2 : 1); ++rep2_) {
            f32x4 gmx[4];
#pragma unroll
            for (int j = 0; j < 4; ++j) gmx[j] = *(const f32x4*)(KP->g_mix + (size_t)l * 1024 + (j * 64 + lane) * 4);
            for (int bb = bid; bb < T / 136; bb += G) {
                f32x4 L_v[4]; u32x2 L_xb[4], L_ya[4], L_yb[4]; f32x4 m_sc[4], m_sh[4], m_gf[4]; int cur_mr = -1;
#pragma unroll
                for (int j = 0; j < 4; ++j) { L_v[j] = (f32x4){0.f, 0.f, 0.f, 0.f}; L_xb[j] = (u32x2){0u, 0u}; L_ya[j] = (u32x2){0u, 0u}; L_yb[j] = (u32x2){0u, 0u}; m_sc[j] = m_sh[j] = m_gf[j] = (f32x4){0.f, 0.f, 0.f, 0.f}; }
#define N1_ISSUE(TT) do { const int t_ = (TT); const int b_ = t_ / TPB, n_ = t_ - b_ * TPB; \
                    if (l == 0) { const float* src_ = n_ < NCTX ? KP->ctx + ((size_t)b_ * NCTX + n_) * DM : KP->x + ((size_t)b_ * SEQ + (n_ - NCTX)) * DM; \
                        _Pragma("unroll") for (int j = 0; j < 4; ++j) L_v[j] = *(const f32x4*)(src_ + (j * 64 + lane) * 4); } \
                    else { const bf16_t* x_ = XB + (size_t)t_ * 1024; const bf16_t* y_ = Y2 + (size_t)t_ * 2048; _Pragma("unroll") for (int j = 0; j < 4; ++j) { L_xb[j] = *(const u32x2*)(x_ + (j * 64 + lane) * 4); L_ya[j] = *(const u32x2*)(y_ + (j * 64 + lane) * 4); L_yb[j] = *(const u32x2*)(y_ + 1024 + (j * 64 + lane) * 4); } } } while (0)
                N1_ISSUE(bb * 136 + wid);
                for (int it = 0; it < 17; ++it) {
                    const int t = bb * 136 + it * 8 + wid; const int b = t / TPB, n = t - b * TPB; const int mr = n < NCTX ? 8 : b;
                    f32x4 v[4]; u32x2 ya[4], yb[4];
#pragma unroll
                    for (int j = 0; j < 4; ++j) { v[j] = l == 0 ? L_v[j] : unpack4(L_xb[j]); ya[j] = L_ya[j]; yb[j] = L_yb[j]; }
                    if (it + 1 < 17) N1_ISSUE(t + 8);
                    if (mr != cur_mr) { cur_mr = mr; const float* sh = modl + (size_t)mr * 6144; const float* gf = modv + ((size_t)(l > 0 ? l - 1 : 0) * 9 + mr) * 6144 + 5120;
#pragma unroll
                        for (int j = 0; j < 4; ++j) { const int col = (j * 64 + lane) * 4; m_sh[j] = *(const f32x4*)(sh + col); m_sc[j] = *(const f32x4*)(sh + 1024 + col) + 1.0f; m_gf[j] = *(const f32x4*)(gf + col); } }
                    __builtin_amdgcn_sched_barrier(0);
                    if (l != 0 && !(ABL == 7 && n < NCTX)) {
#pragma unroll
                        for (int j = 0; j < 4; ++j) { f32x4 xv = v[j]; const f32x4 g = m_gf[j]; const u32x2 a = ya[j], bq = yb[j];
                            xv[0] += g[0] * (__uint_as_float(a.x << 16) + __uint_as_float(bq.x << 16)); xv[1] += g[1] * (__uint_as_float(a.x & 0xffff0000u) + __uint_as_float(bq.x & 0xffff0000u));
                            xv[2] += g[2] * (__uint_as_float(a.y << 16) + __uint_as_float(bq.y << 16)); xv[3] += g[3] * (__uint_as_float(a.y & 0xffff0000u) + __uint_as_float(bq.y & 0xffff0000u));
                            v[j] = xv; } }
                    if (l != 0) {
#pragma unroll
                        for (int j = 0; j < 4; ++j) *(u32x2*)(XB + (size_t)t * 1024 + (j * 64 + lane) * 4) = pack4(v[j]); }
                    float ss = 0.f;
#pragma unroll
                    for (int j = 0; j < 4; ++j) ss += v[j][0] * v[j][0] + v[j][1] * v[j][1] + v[j][2] * v[j][2] + v[j][3] * v[j][3];
                    ss = wave_sum(ss); const float rstd = rsqrtf(ss * (1.0f / 1024.0f) + 1e-6f);
#pragma unroll
                    for (int j = 0; j < 4; ++j) { const int col = (j * 64 + lane) * 4;
                        const f32x4 h = v[j] * rstd * gmx[j] * m_sc[j] + m_sh[j]; v[j] = h; (void)col; }
                    {
                        float am = 0.f;
#pragma unroll
                        for (int j = 0; j < 4; ++j) am = fmaxf(fmaxf(am, fmaxf(__builtin_fabsf(v[j][0]), __builtin_fabsf(v[j][1]))), fmaxf(__builtin_fabsf(v[j][2]), __builtin_fabsf(v[j][3])));
                        am = fmaxf(wave_max_nn(am), 1e-30f); const float sc = 127.0f / am;
#pragma unroll
                        for (int j = 0; j < 4; ++j) *(unsigned*)(H8 + (size_t)t * 1024 + (j * 64 + lane) * 4) = pack_i8x4(v[j][0], v[j][1], v[j][2], v[j][3], sc);
                        if (lane == 0) RS8[t] = am * (1.0f / 127.0f);
                    }
                }
#undef N1_ISSUE
            }
            }
        }
        SEAM(P0 + 0);
        for (int rep_ = 0; rep_ < (DUP == 2 ? 1 + DUPN : 1); ++rep_)
        if (ON(2) && RUN(P0 + 1)) { PHK();
            SchedDense S{(const char*)H8, wb + W_IN, 512, T / 256, NU / 256, G, bid, false}; EpiBf16I8 E{Ub, NU, RS8, CMAX2(l)};
            g8::gemm_phase(lds, S, E);
        }
        SEAM(P0 + 1);
        for (int rep_ = 0; rep_ < (DUP == 3 ? 1 + DUPN : 1); ++rep_)
        if (ON(3) && RUN(P0 + 2)) { LTID();
            f32x4 cwv[4][2]; f32x4 cbv[2];
            { const float* cw = KP->conv_w + (size_t)l * 4 * 512 + lane * 8; const float* cbias = KP->conv_b + (size_t)l * 512 + lane * 8;
#pragma unroll
              for (int k = 0; k < 4; ++k) { cwv[k][0] = *(const f32x4*)(cw + k * 512); cwv[k][1] = *(const f32x4*)(cw + k * 512 + 4); }
              cbv[0] = *(const f32x4*)cbias; cbv[1] = *(const f32x4*)(cbias + 4); }
            const f32x2 gkv2 = *(const f32x2*)(KP->mla_gkv + (size_t)l * 128 + lane * 2);
            const f32x4 gqm4 = *(const f32x4*)(KP->mla_gq + (size_t)l * 256 + lane * 4);
            const int qa = lane & 7, qh = lane >> 3;
            const f32x4 ggqA = *(const f32x4*)(KP->gqa_gq + (size_t)l * 64 + qa * 4), ggqB = *(const f32x4*)(KP->gqa_gq + (size_t)l * 64 + 32 + qa * 4);
            const int ki = lane & 15, kh = (lane >> 4) & 1;
            const f32x2 ggkA = *(const f32x2*)(KP->gqa_gk + (size_t)l * 64 + ki * 2), ggkB = *(const f32x2*)(KP->gqa_gk + (size_t)l * 64 + 32 + ki * 2);
            LAS bf16_t* vst = (LAS bf16_t*)lds;
            constexpr int VSTP = 138;
            for (int bb = bid; bb < T / 136; bb += G) {
            __syncthreads();
            u32x4 L_xr[4], L_rg; unsigned L_ckv, L_gka, L_gkb, L_gv; u32x2 L_cq, L_gqa, L_gqb; bf16_t L_kr1, L_kr2; f32x4 L_qc, L_qs; f32x2 L_kc, L_ks; float L_rc, L_rs;
#define P3_ISSUE(TT) do { const int t_ = (TT); const int b_ = t_ / TPB, n_ = t_ - b_ * TPB; const bool ic_ = n_ < NCTX; const int s0_ = ic_ ? 0 : NCTX, s1_ = ic_ ? NCTX : TPB; \
                const int pp_ = ic_ ? 0 : n_ - NCTX; const bf16_t* ur_ = Ub + (size_t)t_ * NU; \
                _Pragma("unroll") for (int k = 0; k < 4; ++k) { const int nn = n_ + k - 2; L_xr[k] = (nn >= s0_ && nn < s1_) ? *(const u32x4*)(ur_ + (ptrdiff_t)(k - 2) * NU + U_XR + lane * 8) : (u32x4){0u, 0u, 0u, 0u}; } \
                L_rg = *(const u32x4*)(ur_ + U_RG + lane * 8); L_ckv = *(const unsigned*)(ur_ + U_CKV + lane * 2); L_cq = *(const u32x2*)(ur_ + U_CQ + lane * 4); \
                L_kr1 = ur_[U_KR + ki]; L_kr2 = ur_[U_KR + 16 + ki]; L_gka = *(const unsigned*)(ur_ + U_GK + kh * 64 + ki * 2); L_gkb = *(const unsigned*)(ur_ + U_GK + kh * 64 + 32 + ki * 2); \
                L_gv = *(const unsigned*)(ur_ + U_GV + lane * 2); L_gqa = *(const u32x2*)(ur_ + U_GQ + qh * 64 + qa * 4); L_gqb = *(const u32x2*)(ur_ + U_GQ + qh * 64 + 32 + qa * 4); \
                L_qc = *(const f32x4*)(cosG + pp_ * 32 + qa * 4); L_qs = *(const f32x4*)(sinG + pp_ * 32 + qa * 4); L_kc = *(const f32x2*)(cosG + pp_ * 32 + ki * 2); L_ks = *(const f32x2*)(sinG + pp_ * 32 + ki * 2); \
                L_rc = cosM[pp_ * 16 + ki]; L_rs = sinM[pp_ * 16 + ki]; } while (0)
            P3_ISSUE(bb * 136 + wid);
            for (int it = 0; it < 17; ++it) {
                const int tl = it * 8 + wid; const int t = bb * 136 + tl;
                const int b = t / TPB, n = t - b * TPB; const bool isctx = n < NCTX;
                u32x4 xr4[4]; xr4[0] = L_xr[0]; xr4[1] = L_xr[1]; xr4[2] = L_xr[2]; xr4[3] = L_xr[3];
                const u32x4 rg4 = L_rg; const unsigned ckvw = L_ckv, gka = L_gka, gkb = L_gkb, gvw = L_gv; const u32x2 cqw = L_cq, gqa_ = L_gqa, gqb_ = L_gqb; const bf16_t kr1 = L_kr1, kr2 = L_kr2;
                const f32x4 qc = L_qc, qs = L_qs; const f32x2 kc = L_kc, ks = L_ks; const float rc = L_rc, rs_ = L_rs;
                if (it + 1 < 17) P3_ISSUE(t + 8);
                __builtin_amdgcn_sched_barrier(0);
                { f32x4 a0 = cbv[0], a1 = cbv[1];
#pragma unroll
                  for (int k = 0; k < 4; ++k) { float xv[8]; unpack8(xr4[k], xv); a0 += cwv[k][0] * (f32x4){xv[0], xv[1], xv[2], xv[3]}; a1 += cwv[k][1] * (f32x4){xv[4], xv[5], xv[6], xv[7]}; }
                  const float a[8] = {a0[0], a0[1], a0[2], a0[3], a1[0], a1[1], a1[2], a1[3]};
                  *(u32x4*)(XC + (size_t)t * 512 + lane * 8) = pack8(a); }
                { float xv[8]; unpack8(rg4, xv);
#pragma unroll
                  for (int j = 0; j < 8; ++j) xv[j] = gelu_tanh(xv[j]);
                  *(u32x4*)(GR + (size_t)t * 512 + lane * 8) = pack8(xv); }
                { const float x0 = __uint_as_float(ckvw << 16), x1 = __uint_as_float(ckvw & 0xffff0000u);
                  const float ss = wave_sum(x0 * x0 + x1 * x1); const float rs = rsqrtf(ss * (1.0f / 128.0f) + 1e-6f);
                  *(unsigned*)(CKVN + (size_t)t * 256 + lane * 2) = cvt_pk_bf16(x0 * rs * gkv2.x, x1 * rs * gkv2.y);
                  *(unsigned*)(CKVN + (size_t)t * 256 + 128 + lane * 2) = 0u; }
                { const float x0 = __uint_as_float(cqw.x << 16), x1 = __uint_as_float(cqw.x & 0xffff0000u), x2 = __uint_as_float(cqw.y << 16), x3 = __uint_as_float(cqw.y & 0xffff0000u);
                  const float ss = wave_sum(x0 * x0 + x1 * x1 + x2 * x2 + x3 * x3); const float rs = rsqrtf(ss * (1.0f / 256.0f) + 1e-6f);
                  u32x2 o; o.x = cvt_pk_bf16(x0 * rs * gqm4[0], x1 * rs * gqm4[1]); o.y = cvt_pk_bf16(x2 * rs * gqm4[2], x3 * rs * gqm4[3]);
                  *(u32x2*)(CQN + (size_t)t * 256 + lane * 4) = o; }
                { float x1 = bf2f(kr1), x2 = bf2f(kr2);
                  if (ABL != 5 && !isctx) { const float o1 = x1 * rc - x2 * rs_, o2 = x1 * rs_ + x2 * rc; x1 = o1; x2 = o2; }
                  if (lane < 16) { KR[(size_t)t * 32 + lane] = f2bf(x1); KR[(size_t)t * 32 + 16 + lane] = f2bf(x2); } }
                { float a0 = __uint_as_float(gka << 16), a1 = __uint_as_float(gka & 0xffff0000u), b0 = __uint_as_float(gkb << 16), b1 = __uint_as_float(gkb & 0xffff0000u);
                  const float ss = red16(a0 * a0 + a1 * a1 + b0 * b0 + b1 * b1); const float rs = rsqrtf(ss * (1.0f / 64.0f) + 1e-6f);
                  a0 *= rs * ggkA.x; a1 *= rs * ggkA.y; b0 *= rs * ggkB.x; b1 *= rs * ggkB.y;
                  if (ABL != 5 && !isctx) { const float o0 = a0 * kc.x - b0 * ks.x, o1 = a1 * kc.y - b1 * ks.y, o2 = a0 * ks.x + b0 * kc.x, o3 = a1 * ks.y + b1 * kc.y; a0 = o0; a1 = o1; b0 = o2; b1 = o3; }
                  if (lane < 32) { bf16_t* kp = KG + (((size_t)b * 2 + kh) * TPB + n) * 64; *(unsigned*)(kp + ki * 2) = cvt_pk_bf16(a0, a1); *(unsigned*)(kp + 32 + ki * 2) = cvt_pk_bf16(b0, b1); } }
                { vst[(lane * 2) * VSTP + tl] = (bf16_t)(gvw & 0xffffu); vst[(lane * 2 + 1) * VSTP + tl] = (bf16_t)(gvw >> 16); }
                { f32x4 xA = {__uint_as_float(gqa_.x << 16), __uint_as_float(gqa_.x & 0xffff0000u), __uint_as_float(gqa_.y << 16), __uint_as_float(gqa_.y & 0xffff0000u)};
                  f32x4 xB = {__uint_as_float(gqb_.x << 16), __uint_as_float(gqb_.x & 0xffff0000u), __uint_as_float(gqb_.y << 16), __uint_as_float(gqb_.y & 0xffff0000u)};
                  const f32x4 sq = xA * xA + xB * xB; const float ss = red8((sq[0] + sq[1]) + (sq[2] + sq[3])); const float rs = rsqrtf(ss * (1.0f / 64.0f) + 1e-6f);
                  xA = xA * rs * ggqA; xB = xB * rs * ggqB;
                  if (ABL != 5 && !isctx) { const f32x4 oA = xA * qc - xB * qs, oB = xA * qs + xB * qc; xA = oA; xB = oB; }
                  xA = xA * QSCALE_G; xB = xB * QSCALE_G;
                  bf16_t* qp = QG + (((size_t)b * 8 + qh) * TPB + n) * 64; u32x2 oa, ob; oa.x = cvt_pk_bf16(xA[0], xA[1]); oa.y = cvt_pk_bf16(xA[2], xA[3]); ob.x = cvt_pk_bf16(xB[0], xB[1]); ob.y = cvt_pk_bf16(xB[2], xB[3]);
                  *(u32x2*)(qp + qa * 4) = oa; *(u32x2*)(qp + 32 + qa * 4) = ob; }
            }
#undef P3_ISSUE
            __syncthreads();
            { const int b = (bb * 136) / TPB, n0 = bb * 136 - b * TPB;
#pragma unroll 4
              for (int r = 0; r < 16; ++r) { const int row = wid * 16 + r; bf16_t* gp = VGt + (((size_t)b * 2 + (row >> 6)) * 64 + (row & 63)) * TPB + n0;
                  *(unsigned*)(gp + lane * 2) = *(const LAS unsigned*)(vst + row * VSTP + lane * 2);
                  if (lane < 4) *(unsigned*)(gp + 128 + lane * 2) = *(const LAS unsigned*)(vst + row * VSTP + 128 + lane * 2); } }
            }
        }
        SEAM(P0 + 2);
        for (int rep_ = 0; rep_ < (DUP == 4 ? 1 + DUPN : 1); ++rep_)
        if (ON(4) && RUN(P0 + 3)) { PHK();
            SchedGate S{(const char*)XC, wb + W_G, T / 256, G, bid};
            EpiGate E{XC, LAB, KP->lru_ba + (size_t)l * 1024, KP->lru_bi + (size_t)l * 1024, lrut + (size_t)l * 1024};
            g8::gemm_phase(lds, S, E);
        }
        SEAM(P0 + 3);
        for (int rep_ = 0; rep_ < (DUP == 5 ? 1 + DUPN : 1); ++rep_)
        if (ON(5) && RUN(P0 + 4)) { LTID();
            for (int it = bid; it < NB_ * NCHUNK; it += G) {
                const int b = it / NCHUNK, j = it - b * NCHUNK; const int c = tid;
                const char* ub = (const char*)(LAB + ((size_t)b * TPB + (size_t)j * 64) * 2048); const unsigned lo = (unsigned)c * 8u;
                u32x2 w[64];
                { const __amdgpu_buffer_rsrc_t rs = BUF_RSRC(ub);
#pragma unroll
                  for (int s = 0; s < 64; ++s) w[s] = __builtin_amdgcn_raw_buffer_load_b64(rs, lo, s * 4096, 0); }
                __builtin_amdgcn_sched_barrier(0);
                float Pf = 1.f, Hf = 0.f, Pb = 1.f, Hb_ = 0.f;
#pragma unroll
                for (int s = 0; s < 64; ++s) { const float af = __expf(__uint_as_float(w[s].x << 16)); Hf = af * Hf + __uint_as_float(w[s].x & 0xffff0000u); Pf *= af; }
#pragma unroll
                for (int s = 63; s >= 0; --s) { const float ab = __expf(__uint_as_float(w[s].y << 16)); Hb_ = ab * Hb_ + __uint_as_float(w[s].y & 0xffff0000u); Pb *= ab; }
                __builtin_amdgcn_sched_barrier(0);
                carry[(((size_t)b * NCHUNK + j) * 2 + 0) * 512 + c] = (f32x2){Pf, Hf};
                carry[(((size_t)b * NCHUNK + j) * 2 + 1) * 512 + c] = (f32x2){Pb, Hb_};
            }
        }
        SEAM(P0 + 4);
        for (int rep_ = 0; rep_ < (DUP == 6 ? 1 + DUPN : 1); ++rep_)
        if (ON(6) && RUN(P0 + 5)) { LTID();
            for (int it = bid; it < NB_ * NCHUNK; it += G) {
                const int b = it / NCHUNK, j = it - b * NCHUNK; const int c = tid;
                if (l == NLAYER - 1 && j < 4) continue;
                const __amdgpu_buffer_rsrc_t crs = BUF_RSRC(carry + (size_t)b * NCHUNK * 2 * 512); const unsigned clo = (unsigned)c * 8u;
                float cf = 0.f, cbk = 0.f;
                const int pf = j, pb = j < 4 ? 3 - j : 71 - j;
#pragma unroll
                for (int hb = 0; hb < 2; ++hb) {
                    u32x2 vf[34], vb[34];
#pragma unroll
                    for (int q = 0; q < 34; ++q) { const int qq = hb * 34 + q; const int ib = qq < 4 ? 3 - qq : 71 - qq;
                        vf[q] = __builtin_amdgcn_raw_buffer_load_b64(crs, clo, (qq * 2 + 0) * 4096, 0); vb[q] = __builtin_amdgcn_raw_buffer_load_b64(crs, clo, (ib * 2 + 1) * 4096, 0); }
                    __builtin_amdgcn_sched_barrier(0);
#pragma unroll
                    for (int q = 0; q < 34; ++q) { const int qq = hb * 34 + q;
                        if (qq < pf) cf = __uint_as_float(vf[q].x) * cf + __uint_as_float(vf[q].y);
                        if (qq < pb) cbk = __uint_as_float(vb[q].x) * cbk + __uint_as_float(vb[q].y); }
                }
                const size_t t0 = (size_t)b * TPB + (size_t)j * 64;
                const char* ub = (const char*)(LAB + t0 * 2048); const unsigned lo = (unsigned)c * 8u, lo2 = (unsigned)c * 2u;
                const char* gb = (const char*)(GR + t0 * 512); char* yb = (char*)(YR + t0 * 512);
                __builtin_amdgcn_sched_barrier(0);
                u32x2 w[64];
                { const __amdgpu_buffer_rsrc_t rs = BUF_RSRC(ub);
#pragma unroll
                  for (int s = 0; s < 64; ++s) w[s] = __builtin_amdgcn_raw_buffer_load_b64(rs, lo, s * 4096, 0); }
                __builtin_amdgcn_sched_barrier(0);
#pragma unroll
                for (int s = 0; s < 64; ++s) { cf = __expf(__uint_as_float(w[s].x << 16)) * cf + __uint_as_float(w[s].x & 0xffff0000u); w[s].x = __float_as_uint(cf); }
                bf16_t ga[16], gn[16];
#pragma unroll
                for (int s = 0; s < 16; ++s) ga[s] = *(const bf16_t*)(gb + (size_t)(48 + s) * 1024 + lo2);
#pragma unroll
                for (int k = 3; k >= 0; --k) {
                    if (k > 0) {
#pragma unroll
                        for (int s = 0; s < 16; ++s) gn[s] = *(const bf16_t*)(gb + (size_t)((k - 1) * 16 + s) * 1024 + lo2); }
                    __builtin_amdgcn_sched_barrier(0);
#pragma unroll
                    for (int s = 15; s >= 0; --s) { const int ss = k * 16 + s; cbk = __expf(__uint_as_float(w[ss].y << 16)) * cbk + __uint_as_float(w[ss].y & 0xffff0000u);
                        *(bf16_t*)(yb + (size_t)ss * 1024 + lo2) = f2bf(ABL == 2 ? 0.f : (__uint_as_float(w[ss].x) + cbk) * bf2f(ga[s])); }
#pragma unroll
                    for (int s = 0; s < 16; ++s) ga[s] = gn[s];
                }
            }
        }
        SEAM(P0 + 5);
        for (int rep_ = 0; rep_ < (DUP == 7 ? 1 + DUPN : 1); ++rep_)
        if (ON(7) && RUN(P0 + 6)) { PHK();
            { SchedDense S{(const char*)CKVN, wb + W_UKV, 256, T / 256, 4, G, bid, false}; EpiUkv E{KM, VMt}; g8::gemm_phase(lds, S, E); }
            { SchedDense S{(const char*)CQN, wb + W_UQ, 256, T / 256, 3, G, bid, l == NLAYER - 1}; EpiUq E{QM, cosM, sinM}; g8::gemm_phase(lds, S, E); }
        }
        SEAM(P0 + 6);
        for (int rep_ = 0; rep_ < ((DUP == 8 || DUP == 23 || DUP == 24) ? 1 + DUPN : 1); ++rep_)
        if (ON(8) && RUN(P0 + 7)) { LTID();
            const int ng = NB_ * 8 * 8, nm = NB_ * 8 * 8, nall = ng + nm + (l == NLAYER - 1 ? 0 : 2 * NB_ * 8);
            for (int it = (DUP == 24 && rep_) ? ng + bid : bid; it < ((DUP == 23 && rep_) ? ng : (DUP == 24 && rep_) ? ng + nm : nall); it += G) {
                if (it < ng) {
                    int u = it; const int qb = u >> 6; u &= 63; const int h = u & 7, b = u >> 3; const size_t bh = (size_t)b * 8 + h, bk = (size_t)b * 2 + (h >> 2); const size_t n0 = NCTX + (size_t)qb * 512;
                    attn_run<64, 2, 4>(lds, QG + (bh * TPB + n0) * 64, KG + bk * TPB * 64, nullptr, VGt + bk * 64 * TPB, TPB, YG + ((size_t)b * TPB + n0) * 512 + h * 64);
                } else if (it < ng + nm) {
                    int u = it - ng; const int qb = u >> 6; u &= 63; const int h = u & 7, b = u >> 3; const size_t bh = (size_t)b * 8 + h; const size_t n0 = NCTX + (size_t)qb * 512;
                    attn_run<96, 2, 2>(lds, QM + (bh * TPB + n0) * 96, KM + bh * TPB * 64, KR + (size_t)b * TPB * 32, VMt + bh * 64 * TPB, TPB, YM + ((size_t)b * TPB + n0) * 512 + h * 64);
                } else {
                    int u = it - ng - nm; const int kind = u & 1; u >>= 1; const int h = u & 7, b = u >> 3; const size_t bh = (size_t)b * 8 + h;
                    if (kind == 0) attn_run<96, 1, 2>(lds, QM + (bh * TPB) * 96, KM + bh * TPB * 64, KR + (size_t)b * TPB * 32, VMt + bh * 64 * TPB, NCTX, YM + ((size_t)b * TPB) * 512 + h * 64);
                    else { const size_t bk = (size_t)b * 2 + (h >> 2); attn_run<64, 1, 2>(lds, QG + (bh * TPB) * 64, KG + bk * TPB * 64, nullptr, VGt + bk * 64 * TPB, NCTX, YG + ((size_t)b * TPB) * 512 + h * 64); }
                }
            }
        }
        SEAM(P0 + 7);
        for (int rep_ = 0; rep_ < (DUP == 12 ? 1 + DUPN : 1); ++rep_)
        if (ON(15) && RUN(P0 + 8)) { PHK();
            SchedDense S{(const char*)H8, wb + W_MG, 512, T / 256, 12, G, bid, l == NLAYER - 1}; EpiGateI8 E{(unsigned char*)RA, RS8, CMAX(l)};
            g8::gemm_phase(lds, S, E);
        }
        SEAM(P0 + 8);
        for (int rep_ = 0; rep_ < (DUP == 9 ? 1 + DUPN : 1); ++rep_)
        if (ON(9) && RUN(P0 + 9)) { PHK();
            SchedMerge S{(const char*)KP->ws, wb + W_BR, T / 256, G, bid, l == NLAYER - 1};
            EpiMerge E{Mb, (const unsigned char*)RA};
            g8::gemm_phase(lds, S, E);
        }
        SEAM(P0 + 9);
        for (int rep_ = 0; rep_ < (DUP == 10 ? 1 + DUPN : 1); ++rep_)
        if (ON(10) && RUN(P0 + 10)) { PHK();
            SchedDense S{(const char*)Mb, wb + W_OUT, 1024, T / 256, 4, G, bid, l == NLAYER - 1}; EpiOut E{rep_ ? (bf16_t*)RA : XB, l == 0 ? KP->x : (const float*)nullptr, l == 0 ? KP->ctx : (const float*)nullptr, modl};
            g8::gemm_phase(lds, S, E);
        }
        SEAM(P0 + 10);
        for (int rep_ = 0; rep_ < (DUP == 11 ? 1 + DUPN : 1); ++rep_)
        if (ON(11) && RUN(P0 + 11)) { LTID();
            LAS float* wl = (LAS float*)lds;
            { const float* src = wrt + (size_t)l * 36 * 1024; for (int e = tid; e < 36 * 1024 / 4; e += 512) *(LAS f32x4*)(wl + e * 4) = *(const f32x4*)(src + e * 4); }
            __syncthreads();
            const float* bg = KP->moe_bg + l * 4; const float* be = KP->moe_be + l * 32;
            f32x4 gfx_[4];
#pragma unroll
            for (int j = 0; j < 4; ++j) gfx_[j] = *(const f32x4*)(KP->g_ffn + (size_t)l * 1024 + (j * 64 + lane) * 4);
            for (int bb = bid; bb < T / 136; bb += G) {
            u32x2 L_v[4]; f32x4 m_sc[4], m_sh[4]; int cur_mr = -1;
#pragma unroll
            for (int j = 0; j < 4; ++j) m_sc[j] = m_sh[j] = (f32x4){0.f, 0.f, 0.f, 0.f};
#define R_ISSUE(TT) do { const bf16_t* xr_ = XB + (size_t)(TT) * 1024; _Pragma("unroll") for (int j = 0; j < 4; ++j) L_v[j] = *(const u32x2*)(xr_ + (j * 64 + lane) * 4); } while (0)
            R_ISSUE(bb * 136 + wid);
            for (int it = 0; it < 17; ++it) {
                const int t = bb * 136 + it * 8 + wid;
                const int b = t / TPB, n = t - b * TPB; const int mr = n < NCTX ? 8 : b;
                f32x4 v[4];
#pragma unroll
                for (int j = 0; j < 4; ++j) v[j] = unpack4(L_v[j]);
                if (it + 1 < 17) R_ISSUE(t + 8);
                if (mr != cur_mr) { cur_mr = mr; const float* sh = modl + (size_t)mr * 6144 + 3072;
#pragma unroll
                    for (int j = 0; j < 4; ++j) { const int col = (j * 64 + lane) * 4; m_sh[j] = *(const f32x4*)(sh + col); m_sc[j] = *(const f32x4*)(sh + 1024 + col) + 1.0f; } }
                __builtin_amdgcn_sched_barrier(0);
                if (l == NLAYER - 1 && n < NCTX) continue;
                float ss = 0.f;
#pragma unroll
                for (int j = 0; j < 4; ++j) ss += v[j][0] * v[j][0] + v[j][1] * v[j][1] + v[j][2] * v[j][2] + v[j][3] * v[j][3];
                ss = wave_sum(ss); const float rstd = rsqrtf(ss * (1.0f / 1024.0f) + 1e-6f);
#pragma unroll
                for (int j = 0; j < 4; ++j) { const int col = (j * 64 + lane) * 4;
                    v[j] = v[j] * rstd * gfx_[j] * m_sc[j] + m_sh[j]; u32x2 w; w.x = cvt_pk_bf16(v[j][0], v[j][1]); w.y = cvt_pk_bf16(v[j][2], v[j][3]);
                    *(u32x2*)(Hb + (size_t)t * 1024 + col) = w; }
                float gl[4];
#pragma unroll
                for (int g = 0; g < 4; ++g) { float a = 0.f;
#pragma unroll
                    for (int j = 0; j < 4; ++j) { const f32x4 w = *(const LAS f32x4*)(wl + g * 1024 + (j * 64 + lane) * 4); a += v[j][0] * w[0] + v[j][1] * w[1] + v[j][2] * w[2] + v[j][3] * w[3]; }
                    gl[g] = wave_sum(a) + bg[g]; }
                int gs = 0; float gm = gl[0];
#pragma unroll
                for (int g = 1; g < 4; ++g) if (gl[g] > gm) { gm = gl[g]; gs = g; }
                float den = 0.f;
#pragma unroll
                for (int g = 0; g < 4; ++g) den += __expf(gl[g] - gm);
                const float pg = 1.0f / den;
                float el[8];
#pragma unroll
                for (int e = 0; e < 8; ++e) { float a = 0.f; const LAS float* wrow = wl + (4 + gs * 8 + e) * 1024;
#pragma unroll
                    for (int j = 0; j < 4; ++j) { const f32x4 w = *(const LAS f32x4*)(wrow + (j * 64 + lane) * 4); a += v[j][0] * w[0] + v[j][1] * w[1] + v[j][2] * w[2] + v[j][3] * w[3]; }
                    el[e] = wave_sum(a) + be[gs * 8 + e]; }
                int i0 = 0; float v0 = el[0];
#pragma unroll
                for (int e = 1; e < 8; ++e) if (el[e] > v0) { v0 = el[e]; i0 = e; }
                int i1 = -1; float v1 = -INFINITY;
#pragma unroll
                for (int e = 0; e < 8; ++e) if (e != i0 && el[e] > v1) { v1 = el[e]; i1 = e; }
                const float p0 = 1.0f / (1.0f + __expf(v1 - v0)), p1 = 1.0f - p0;
                if (lane == 0 && rep_ == 0) { const int e0 = gs * 8 + i0, e1 = gs * 8 + i1;
                    const unsigned s0 = atomicAdd(cnt + e0 * 64, 1u), s1 = atomicAdd(cnt + e1 * 64, 1u);
                    int* sp = sel + (size_t)t * 8; sp[0] = e0; sp[1] = e1; sp[2] = (int)s0; sp[3] = (int)s1; ((float*)sp)[4] = p0 * pg; ((float*)sp)[5] = p1 * pg; }
            }
#undef R_ISSUE
            }
        }
        SEAM(P0 + 11);
        if (ON(12) && RUN(P0 + 12)) { LTID();
            LAS int* offs = (LAS int*)lds;
            if (tid == 0) { int o = 0; for (int e = 0; e < NEXP; ++e) { offs[e] = o; o += ((int)__hip_atomic_load(cnt + e * 64, __ATOMIC_RELAXED, __HIP_MEMORY_SCOPE_AGENT) + 255) & ~255; } offs[NEXP] = o; }
            __syncthreads();
            for (int t = bid * 512 + tid; t < T; t += G * 512) { const int* sp = sel + (size_t)t * 8;
                if (l == NLAYER - 1 && (t % TPB) < NCTX) continue;
                const int q0 = offs[sp[0]] + sp[2], q1 = offs[sp[1]] + sp[3];
                list_tok[q0] = t * 2; list_p[q0] = ((const float*)sp)[4]; list_tok[q1] = t * 2 + 1; list_p[q1] = ((const float*)sp)[5]; }
            for (int e = bid; e < NEXP; e += G) { const int c0 = offs[e] + (int)__hip_atomic_load(cnt + e * 64, __ATOMIC_RELAXED, __HIP_MEMORY_SCOPE_AGENT), c1 = offs[e + 1];
                for (int q = c0 + tid; q < c1; q += 512) { list_tok[q] = -1; list_p[q] = 0.f; }
                if (tid == 0) tile_exp[e] = offs[e] / 256; }
            if (bid == 0 && tid == 0) { ctl[CW_NT + l * 64] = (unsigned)(offs[NEXP] / 256); tile_exp[NEXP] = offs[NEXP] / 256; }
        }
        SEAM(P0 + 12);
        for (int rep_ = 0; rep_ < (DUP == 13 ? 1 + DUPN : 1); ++rep_)
        if (ON(13) && RUN(P0 + 13)) { PHK();
            const int ntl = (int)__hip_atomic_load(ctl + CW_NT + l * 64, __ATOMIC_RELAXED, __HIP_MEMORY_SCOPE_AGENT);
            LAS int* tofl = (LAS int*)(lds + g8::STAGE_BYTES);
            { int t_ = threadIdx.x; asm volatile("" : "+v"(t_)); if (t_ < 33) tofl[t_] = tile_exp[t_]; }
            __syncthreads();
            SchedMoe<true> S{(const char*)Hb, wb + W_13, list_tok, tofl, ntl, 2, 1024, G, bid, (size_t)512 * 1024 * 2}; EpiMoe1 E{HE};
            g8::gemm_phase(lds, S, E);
        }
        SEAM(P0 + 13);
        for (int rep_ = 0; rep_ < (DUP == 14 ? 1 + DUPN : 1); ++rep_)
        if (ON(14) && RUN(P0 + 14)) { PHK();
            const int ntl = (int)__hip_atomic_load(ctl + CW_NT + l * 64, __ATOMIC_RELAXED, __HIP_MEMORY_SCOPE_AGENT);
            LAS int* tofl = (LAS int*)(lds + g8::STAGE_BYTES);
            { int t_ = threadIdx.x; asm volatile("" : "+v"(t_)); if (t_ < 33) tofl[t_] = tile_exp[t_]; }
            __syncthreads();
            SchedMoe<false> S{(const char*)HE, wb + W_2T, list_tok, tofl, ntl, 4, 256, G, bid, (size_t)1024 * 256 * 2}; EpiMoe2 E{Y2, list_tok, list_p};
            g8::gemm_phase(lds, S, E);
        }
        SEAM(P0 + 14);
    }
    if (ON(16) && RUN(PH_FINAL)) { LTID();
        f32x4 gfin[4];
#pragma unroll
        for (int j = 0; j < 4; ++j) gfin[j] = *(const f32x4*)(KP->g_final + (j * 64 + lane) * 4);
        for (int bb = bid; bb < NB_ * SEQ / 128; bb += G) {
            const int b = (bb * 128) / SEQ; f32x4 gf4[4];
            { const float* gf = modv + ((size_t)(NLAYER - 1) * 9 + b) * 6144 + 5120;
#pragma unroll
              for (int j = 0; j < 4; ++j) gf4[j] = *(const f32x4*)(gf + (j * 64 + lane) * 4); }
            u32x2 L_v[4], L_ya[4], L_yb[4];
#define F_ISSUE(RR) do { const int r_ = (RR); const int n_ = r_ - b * SEQ; const bf16_t* xr_ = XB + (size_t)(b * TPB + NCTX + n_) * 1024; const bf16_t* y_ = Y2 + (size_t)(b * TPB + NCTX + n_) * 2048; \
                _Pragma("unroll") for (int j = 0; j < 4; ++j) { const int col = (j * 64 + lane) * 4; L_v[j] = *(const u32x2*)(xr_ + col); L_ya[j] = *(const u32x2*)(y_ + col); L_yb[j] = *(const u32x2*)(y_ + 1024 + col); } } while (0)
            F_ISSUE(bb * 128 + wid);
            for (int it = 0; it < 16; ++it) {
                const int r = bb * 128 + it * 8 + wid; float* xr = KP->out + (size_t)r * DM;
                f32x4 v[4]; u32x2 ya[4], yb[4];
#pragma unroll
                for (int j = 0; j < 4; ++j) { v[j] = unpack4(L_v[j]); ya[j] = L_ya[j]; yb[j] = L_yb[j]; }
                if (it + 1 < 16) F_ISSUE(r + 8);
                __builtin_amdgcn_sched_barrier(0);
                float ss = 0.f;
#pragma unroll
                for (int j = 0; j < 4; ++j) { f32x4 xv = v[j]; const f32x4 g = gf4[j]; const u32x2 a = ya[j], bq = yb[j];
                    xv[0] += g[0] * (__uint_as_float(a.x << 16) + __uint_as_float(bq.x << 16)); xv[1] += g[1] * (__uint_as_float(a.x & 0xffff0000u) + __uint_as_float(bq.x & 0xffff0000u));
                    xv[2] += g[2] * (__uint_as_float(a.y << 16) + __uint_as_float(bq.y << 16)); xv[3] += g[3] * (__uint_as_float(a.y & 0xffff0000u) + __uint_as_float(bq.y & 0xffff0000u));
                    v[j] = xv; ss += xv[0] * xv[0] + xv[1] * xv[1] + xv[2] * xv[2] + xv[3] * xv[3]; }
                ss = wave_sum(ss); const float rstd = rsqrtf(ss * (1.0f / 1024.0f) + 1e-6f);
#pragma unroll
                for (int j = 0; j < 4; ++j) *(f32x4*)(xr + (j * 64 + lane) * 4) = v[j] * rstd * gfin[j];
            }
#undef F_ISSUE
        }
    }
}

extern "C" void kernel_launch(void* const* d_in, const int* in_sizes, int n_in, void* d_out, int out_size, void* d_ws, size_t ws_size, hipStream_t stream) {
    static int grid = 0;
    if (!grid) {
        if (n_in != 32 || ws_size < WS_END) { fprintf(stderr, "kernel_launch: unexpected inputs (n_in %d, ws %zu, need %zu)\n", n_in, ws_size, (size_t)WS_END); grid = -1; return; }
        int dev = 0, cus = 0, per_cu = 0;
        hipGetDevice(&dev); hipDeviceGetAttribute(&cus, hipDeviceAttributeMultiprocessorCount, dev);
        hipFuncSetAttribute((const void*)mega, hipFuncAttributeMaxDynamicSharedMemorySize, LDS_BYTES);
        hipOccupancyMaxActiveBlocksPerMultiprocessor(&per_cu, (const void*)mega, 512, LDS_BYTES);
        if (per_cu < 1) fprintf(stderr, "kernel_launch: occupancy query says %d\n", per_cu);
        grid = cus > 0 ? cus : 256;
    }
    if (grid < 0) return;
    hipMemsetAsync((char*)d_ws + WS_CTL, 0, CTL_BYTES, stream);
    Params p{};
    const float** fp = (const float**)&p;
    for (int i = 0; i < 32; ++i) fp[i] = (const float*)d_in[i];
    p.out = (float*)d_out; p.ws = (char*)d_ws;
#if N_LAUNCH_MODE == 1
    p.lo = 0; p.hi = NPHASE;
    hipLaunchKernelGGL(mega, dim3(grid), dim3(512), LDS_BYTES, stream, p);
#else
    for (int ph = 0; ph < NPHASE; ++ph) {
        p.lo = ph; p.hi = ph + 1;
        hipLaunchKernelGGL(mega, dim3(grid), dim3(512), LDS_BYTES, stream, p);
    }
#endif
}
```

```cpp
#include <hip/hip_runtime.h>
#include <cstdio>
#include <cstdint>

#define LAS __attribute__((address_space(3)))
typedef unsigned short bf16_t;
typedef short bf16x8 __attribute__((ext_vector_type(8)));
typedef float f32x4 __attribute__((ext_vector_type(4)));
typedef float f32x2 __attribute__((ext_vector_type(2)));
typedef float f32x16 __attribute__((ext_vector_type(16)));
typedef unsigned u32x4 __attribute__((ext_vector_type(4)));
typedef unsigned u32x2 __attribute__((ext_vector_type(2)));

#ifndef PHMASK
#define PHMASK 0xFFFFFFFFu
#endif
#define ON(k) ((((unsigned)(PHMASK)) >> (k)) & 1u)
#ifndef ABL
#define ABL 0
#endif
#ifndef DUP
#define DUP -1
#endif
#ifndef DUPN
#define DUPN 3
#endif
#ifndef N_LAUNCH_MODE
#define N_LAUNCH_MODE 1
#endif

constexpr int NB_ = 8, SEQ = 4096, NCTX = 256, DM = 1024, TPB = NCTX + SEQ  , T = NB_ * TPB  , NLAYER = 2;
constexpr int DIN = 5280, NU = 2304;
constexpr int U_XR = 0, U_CKV = 512, U_KR = 640, U_GK = 672, U_GV = 800, U_RG = 928, U_CQ = 1440, U_GQ = 1696, U_MG = 2208;
constexpr int NEXP = 32, DEXP = 256;
constexpr int MAXSLOT = 2 * T + NEXP * 256;
constexpr int NCHUNK = TPB / 64;
constexpr float LOG2E = 1.4426950408889634f;
#define LOG2E_ 1.4426950408889634f
constexpr float QSCALE_G = 0.125f * LOG2E;
constexpr float QSCALE_M = 0.10206207261596575f * LOG2E;

constexpr size_t al256(size_t x) { return (x + 255) & ~(size_t)255; }
constexpr size_t WS_CTL = 0;
constexpr size_t CTL_BYTES = 212992;
constexpr size_t WS_MOD = WS_CTL + CTL_BYTES;
constexpr size_t WS_ROPE = WS_MOD + al256((size_t)2 * 9 * 6144 * 4);
constexpr size_t WS_LRUT = WS_ROPE + (size_t)4096 * 96 * 4;
constexpr size_t WS_WRT = WS_LRUT + 2 * 2 * 512 * 4;
constexpr size_t WS_CARRY = WS_WRT + (size_t)2 * 36 * 1024 * 4;
constexpr size_t WS_SEL = WS_CARRY + (size_t)NB_ * NCHUNK * 2 * 512 * 8;
constexpr size_t WS_LIST = WS_SEL;
constexpr size_t WS_XSC = WS_LIST + 4096;
constexpr size_t WS_W = WS_XSC;
constexpr size_t W_IN = 0, W_MG = W_IN + (size_t)NU * 1024  , W_G = W_MG + (size_t)3072 * 1024, W_UKV = W_G + (size_t)2048 * 512 * 2,
                 W_UQ = W_UKV + (size_t)1024 * 256 * 2, W_BR = W_UQ + (size_t)768 * 256 * 2, W_OUT = W_BR + (size_t)3 * 1024 * 512 * 2,
                 W_13 = W_OUT + (size_t)1024 * 1024 * 2, W_2T = W_13 + (size_t)32 * 512 * 1024  , W_BYTES = W_2T + (size_t)32 * 1024 * 256 * 2;
constexpr size_t WS_H = WS_W + W_BYTES;
constexpr size_t WS_A = WS_H + (size_t)T * 1024 * 2;
constexpr size_t A_BYTES = (size_t)T * NU * 2;
constexpr size_t A_U = 0, A_LAB = 0, A_KM = 0, A_QM = A_KM + (size_t)T * 8 * 64 * 2, A_VMT = A_QM + (size_t)T * 8 * 96 * 2,
                 A_M = 0, A_GT = (size_t)T * 1024 * 2, A_Y2 = 0;
constexpr size_t WS_B = WS_A + A_BYTES;
constexpr size_t B_XC = 0, B_GR = B_XC + (size_t)T * 512 * 2, B_CKVN = B_GR + (size_t)T * 512 * 2, B_CQN = B_CKVN + (size_t)T * 256 * 2,
                 B_QG = B_CQN + (size_t)T * 256 * 2, B_KG = B_QG + (size_t)T * 512 * 2, B_VGT = B_KG + (size_t)T * 128 * 2, B_KR = B_VGT + (size_t)T * 128 * 2,
                 B_BYTES = B_KR + (size_t)T * 32 * 2, B_YM = B_XC, B_YG = B_GR, B_HE = 0;
constexpr size_t WS_C = WS_B + B_BYTES;
constexpr size_t WS_END = WS_C + (size_t)T * 512 * 2;
static_assert(A_VMT + (size_t)T * 8 * 64 * 2 <= A_BYTES, "A overlay");
static_assert(A_GT + (size_t)T * 1024 * 2 <= A_BYTES, "A overlay 2");
static_assert((size_t)T * 2 * 1024 * 2 <= A_BYTES, "A overlay 3");
static_assert((size_t)MAXSLOT * 256 * 2 <= B_BYTES, "B overlay");
static_assert(B_CKVN + (size_t)T * 1024 * 2 <= B_BYTES, "B overlay (M)");
static_assert((size_t)T * 3072 <= A_BYTES, "A overlay (gates)");
constexpr int LCAP = T;
constexpr size_t WS_L2 = WS_END;
constexpr size_t L2_N = (size_t)NEXP * LCAP + 1024;
constexpr size_t WS_G2 = al256(WS_L2 + L2_N * 12);
constexpr size_t WS_END2 = WS_G2 + (size_t)T * 1024;
static_assert(WS_END2 <= (size_t)536870912, "workspace");
constexpr int CW_BAR = 0;
constexpr int CW_CNT = 4096;
constexpr int CW_NT = 4096 + 2 * 32 * 64;
constexpr int CW_CMAX = 8448;
constexpr int CW_CMAX2 = CW_CMAX + 2 * 3072;
constexpr int CW_CMAX3 = CW_CMAX2 + 2 * 2304;
static_assert((CW_CMAX3 + 2 * 32 * 512) * 4 <= 212992, "control words");

struct Params {
    const float *x, *c, *ctx, *c_ctx, *w_mod, *b_mod, *g_mix, *g_ffn, *w_in, *conv_w, *conv_b, *lru_wa, *lru_ba, *lru_wi, *lru_bi, *lru_lambda,
        *mla_gq, *mla_wuq, *mla_gkv, *mla_wukv, *gqa_gq, *gqa_gk, *w_branch, *w_out, *moe_wg, *moe_bg, *moe_we, *moe_be, *moe_w1, *moe_w3, *moe_w2, *g_final;
    float* out; char* ws; int lo, hi;
};

__device__ __forceinline__ float bf2f(bf16_t b) { return __uint_as_float(((unsigned)b) << 16); }
typedef __bf16 bf16x2_t __attribute__((ext_vector_type(2)));
__device__ __forceinline__ unsigned cvt_pk_bf16(float lo, float hi) { const f32x2 v = {lo, hi}; const bf16x2_t b = __builtin_convertvector(v, bf16x2_t); return __builtin_bit_cast(unsigned, b); }
__device__ __forceinline__ bf16_t f2bf(float f) { return (bf16_t)(cvt_pk_bf16(f, 0.f) & 0xffffu); }
__device__ __forceinline__ float sigm2_(float y) { return __builtin_amdgcn_rcpf(1.0f + __builtin_amdgcn_exp2f(y)); }
__device__ __forceinline__ float sigmoidf_(float x) { return __builtin_amdgcn_rcpf(1.0f + __builtin_amdgcn_exp2f(-LOG2E_ * x)); }
__device__ __forceinline__ float nexpm1_small(float x) { float q = 1.0f / 24.0f; q = q * x + 1.0f / 6.0f; q = q * x + 0.5f; q = q * x + 1.0f;
    const float big = 1.0f - __builtin_amdgcn_exp2f(x * LOG2E_); return x < -0.25f ? big : -x * q; }
__device__ __forceinline__ float gelu_tanh(float x) { const float u = 0.7978845608028654f * (x + 0.044715f * x * x * x); const float e = __expf(2.0f * u); const float th = 1.0f - 2.0f / (e + 1.0f); return 0.5f * x * (1.0f + th); }
template <int CTRL> __device__ __forceinline__ float dpp_f(float v) { return __builtin_bit_cast(float, __builtin_amdgcn_update_dpp(0, __builtin_bit_cast(int, v), CTRL, 0xF, 0xF, true)); }
__device__ __forceinline__ float red4(float v) { v += dpp_f<0xB1>(v); v += dpp_f<0x4E>(v); return v; }
__device__ __forceinline__ float red8(float v) { v = red4(v); v += dpp_f<0x141>(v); return v; }
__device__ __forceinline__ float red16(float v) { v = red8(v); v += dpp_f<0x140>(v); return v; }
__device__ __forceinline__ float rdl(float v, int l) { return __builtin_bit_cast(float, __builtin_amdgcn_readlane(__builtin_bit_cast(int, v), l)); }
__device__ __forceinline__ float wave_sum(float v) { v = red16(v);
    v += __builtin_bit_cast(float, __builtin_amdgcn_update_dpp(0, __builtin_bit_cast(int, v), 0x142, 0xA, 0xF, false));
    v += __builtin_bit_cast(float, __builtin_amdgcn_update_dpp(0, __builtin_bit_cast(int, v), 0x143, 0xC, 0xF, false));
    return rdl(v, 63); }
__device__ __forceinline__ f32x4 unpack4(const u32x2 w) { return (f32x4){__uint_as_float(w.x << 16), __uint_as_float(w.x & 0xffff0000u), __uint_as_float(w.y << 16), __uint_as_float(w.y & 0xffff0000u)}; }
__device__ __forceinline__ u32x2 pack4(const f32x4 v) { u32x2 w; w.x = cvt_pk_bf16(v[0], v[1]); w.y = cvt_pk_bf16(v[2], v[3]); return w; }
template <int N> __device__ __forceinline__ void wave_sumN(float (&a)[N]) {
#pragma unroll
    for (int i = 0; i < N; ++i) a[i] += dpp_f<0xB1>(a[i]);
#pragma unroll
    for (int i = 0; i < N; ++i) a[i] += dpp_f<0x4E>(a[i]);
#pragma unroll
    for (int i = 0; i < N; ++i) a[i] += dpp_f<0x141>(a[i]);
#pragma unroll
    for (int i = 0; i < N; ++i) a[i] += dpp_f<0x140>(a[i]);
#pragma unroll
    for (int i = 0; i < N; ++i) a[i] += __builtin_bit_cast(float, __builtin_amdgcn_update_dpp(0, __builtin_bit_cast(int, a[i]), 0x142, 0xA, 0xF, false));
#pragma unroll
    for (int i = 0; i < N; ++i) a[i] += __builtin_bit_cast(float, __builtin_amdgcn_update_dpp(0, __builtin_bit_cast(int, a[i]), 0x143, 0xC, 0xF, false));
#pragma unroll
    for (int i = 0; i < N; ++i) a[i] = rdl(a[i], 63);
}
__device__ __forceinline__ float wave_max_nn(float v) {
    v = fmaxf(v, dpp_f<0xB1>(v)); v = fmaxf(v, dpp_f<0x4E>(v)); v = fmaxf(v, dpp_f<0x141>(v)); v = fmaxf(v, dpp_f<0x140>(v));
    v = fmaxf(v, __builtin_bit_cast(float, __builtin_amdgcn_update_dpp(0, __builtin_bit_cast(int, v), 0x142, 0xA, 0xF, false)));
    v = fmaxf(v, __builtin_bit_cast(float, __builtin_amdgcn_update_dpp(0, __builtin_bit_cast(int, v), 0x143, 0xC, 0xF, false)));
    return rdl(v, 63); }
__device__ __forceinline__ unsigned pack_i8x4(float a, float b, float c, float d, float sc) {
    const unsigned t0 = __float_as_uint(__builtin_fmaf(a, sc, 12582912.0f)), t1 = __float_as_uint(__builtin_fmaf(b, sc, 12582912.0f)), t2 = __float_as_uint(__builtin_fmaf(c, sc, 12582912.0f)), t3 = __float_as_uint(__builtin_fmaf(d, sc, 12582912.0f));
    return __builtin_amdgcn_perm(t1, t0, 0x0c0c0400u) | __builtin_amdgcn_perm(t3, t2, 0x04000c0cu); }
__device__ __forceinline__ void unpack8(const u32x4 w, float (&f)[8]) {
    f[0] = __uint_as_float(w.x << 16); f[1] = __uint_as_float(w.x & 0xffff0000u); f[2] = __uint_as_float(w.y << 16); f[3] = __uint_as_float(w.y & 0xffff0000u);
    f[4] = __uint_as_float(w.z << 16); f[5] = __uint_as_float(w.z & 0xffff0000u); f[6] = __uint_as_float(w.w << 16); f[7] = __uint_as_float(w.w & 0xffff0000u);
}
__device__ __forceinline__ u32x4 pack8(const float (&f)[8]) { u32x4 w; w.x = cvt_pk_bf16(f[0], f[1]); w.y = cvt_pk_bf16(f[2], f[3]); w.z = cvt_pk_bf16(f[4], f[5]); w.w = cvt_pk_bf16(f[6], f[7]); return w; }
#define BUF_RSRC(p) __builtin_amdgcn_make_buffer_rsrc((void*)(p), 0, 0x7fffffff, 0x00020000)
__device__ __forceinline__ float* resid_row(float* out, char* ws, int t) {
    const int b = t / TPB, n = t - b * TPB;
    return n < NCTX ? (float*)(ws + WS_XSC) + ((size_t)b * NCTX + n) * DM : out + ((size_t)b * SEQ + (n - NCTX)) * DM;
}

#define XB_TMO      128
#define XB_XCNT(j)  (256  + 64 * (j))
#define XB_XSUB(j)  (1280 + 64 * (j))
#define XB_XGEN(j)  (2304 + 64 * (j))
#define XB_TOP      3328
#define XB_TOPGEN   3392
#define XCD_BAR_WORDS 3456
#define XB_SPIN_CAP (1u << 18)
__device__ __forceinline__ unsigned xb_ld(unsigned* p)              { return __hip_atomic_load(p, __ATOMIC_RELAXED, __HIP_MEMORY_SCOPE_AGENT); }
__device__ __forceinline__ unsigned xb_add(unsigned* p, unsigned v) { return __hip_atomic_fetch_add(p, v, __ATOMIC_RELAXED, __HIP_MEMORY_SCOPE_AGENT); }
__device__ __forceinline__ unsigned xb_xcc_id() { return (unsigned)__builtin_amdgcn_s_getreg((3 << 11) | 20) & 0xFu; }
#define XB_SPIN(cond, bar) do { unsigned _sp = 0; while (cond) { __builtin_amdgcn_s_sleep(1); \
    if ((++_sp & 255u) == 0u) { if (xb_ld(&(bar)[XB_TMO])) break; if (_sp > XB_SPIN_CAP) { atomicAdd(&(bar)[XB_TMO], 1u); break; } } } } while (0)
struct XcdBarrier { unsigned* bar; unsigned x; volatile LAS unsigned* st; };
__device__ __forceinline__ XcdBarrier xcd_barrier_post(unsigned* bar, volatile LAS unsigned* st) {
    XcdBarrier b; b.bar = bar; b.x = xb_xcc_id(); b.st = st;
    if (threadIdx.x == 0) (void)xb_add(&bar[XB_XCNT(b.x)], 1u);
    return b;
}
__device__ __forceinline__ void xcd_barrier_complete(unsigned* bar, unsigned x, unsigned& nloc, unsigned& nx) {
    const unsigned G = gridDim.x * gridDim.y * gridDim.z;
    unsigned sum, cnt, mine, sp = 0u;
    for (;;) {
        sum = 0u; cnt = 0u; mine = 0u;
#pragma unroll
        for (unsigned j = 0; j < 16; ++j) { const unsigned c = xb_ld(&bar[XB_XCNT(j)]); sum += c; cnt += (c > 0u) ? 1u : 0u; mine = (j == x) ? c : mine; }
        if (sum == G) break;
        __builtin_amdgcn_s_sleep(1);
        if ((++sp & 255u) == 0u) { if (xb_ld(&bar[XB_TMO])) break; if (sp > XB_SPIN_CAP) { atomicAdd(&bar[XB_TMO], 1u); break; } }
    }
    nloc = mine > 0u ? mine : 1u; nx = cnt > 0u ? cnt : 1u;
}
__device__ __forceinline__ void xcd_barrier(const XcdBarrier& b) {
    asm volatile("s_waitcnt vmcnt(0)" ::: "memory");
    __syncthreads();
    if (threadIdx.x == 0) {
        unsigned* bar = b.bar;
        __builtin_amdgcn_s_waitcnt(0);
        unsigned nloc = b.st[0], nx = b.st[1];
        if (nloc == 0u) { xcd_barrier_complete(bar, b.x, nloc, nx); b.st[0] = nloc; b.st[1] = nx; }
        const unsigned old = xb_add(&bar[XB_XSUB(b.x)], 1u);
        const unsigned gen = old / nloc;
        if (old + 1u == (gen + 1u) * nloc) {
            __builtin_amdgcn_fence(__ATOMIC_RELEASE, "agent");
            asm volatile("s_waitcnt vmcnt(0)" ::: "memory");
            const unsigned og = xb_add(&bar[XB_TOP], 1u);
            const unsigned tg = og / nx;
            if (og + 1u == (tg + 1u) * nx) xb_add(&bar[XB_TOPGEN], 1u);
            else XB_SPIN(xb_ld(&bar[XB_TOPGEN]) == tg, bar);
            __builtin_amdgcn_fence(__ATOMIC_ACQUIRE, "agent");
            xb_add(&bar[XB_XGEN(b.x)], 1u);
            asm volatile("s_waitcnt vmcnt(0)" ::: "memory");
        } else {
            XB_SPIN(xb_ld(&bar[XB_XGEN(b.x)]) == gen, bar);
            __builtin_amdgcn_fence(__ATOMIC_ACQUIRE, "agent");
            asm volatile("s_waitcnt vmcnt(0)" ::: "memory");
        }
    }
    __syncthreads();
}

namespace g8 {
constexpr int BM = 256, BK = 64, HALF = 128, HTB = HALF * BK * 2, STAGE_BYTES = 8 * HTB, NXCD = 8, WGM = 8;
__device__ __forceinline__ int lds_byte(int r, int c) { const int st = (r >> 4) * 2 + (c >> 5), rr = r & 15, cc = c & 31, ob = rr * 64 + cc * 2; return st * 1024 + (ob ^ (((ob >> 9) & 1) << 5)); }
__device__ __forceinline__ void stage_rc(int b, int& R, int& C) { const int st = b / 1024, sb = b % 1024, swz = sb ^ (((sb >> 9) & 1) << 5); R = (st >> 1) * 16 + swz / 64; C = (st & 1) * 32 + (swz % 64) / 2; }
__device__ __forceinline__ int perm32(int rho) { const int n = rho >> 4, i = rho & 15; return 8 * (i >> 2) + 4 * n + (i & 3); }

struct Unit { const char* A; const char* B; const int* gidx; int pitchA, pitchB, nt; int pm, pn, aux; int eidx; size_t bstride; int hmask; int lrow, nvalid; };

__device__ __forceinline__ bool deal_unit(int i, int G, int c, int nwg, int& uid, int& hmask) {
    const long L = (long)i * G + c; const int full = (nwg / G) * G, rem = nwg - full;
    if (L < full) { uid = (int)L; hmask = 3; return true; }
    const int j = (int)(L - full);
    if (2 * rem <= G) { if (j >= 2 * rem) return false; uid = full + (j >> 1); hmask = 1 << (j & 1); return true; }
    if (j >= rem) return false; uid = full + j; hmask = 3; return true;
}
__device__ __forceinline__ void tile_of(int wgid, int nM, int nN, int& pm, int& pn) {
    const int nwg = nM * nN;
    { const int q = nwg / NXCD, r = nwg % NXCD, xcd = wgid % NXCD, off = wgid / NXCD; wgid = (xcd < r ? xcd * (q + 1) : r * (q + 1) + (xcd - r) * q) + off; }
    const int nig = WGM * nN, gid = wgid / nig, fm = gid * WGM, gsz = (nM - fm) < WGM ? (nM - fm) : WGM;
    pm = fm + ((wgid % nig) % gsz); pn = (wgid % nig) / gsz;
}
__device__ __forceinline__ bool static_tile(int i, int G, int c, int nM, int nN, int& pm, int& pn, int& hmask) {
    int uid; if (!deal_unit(i, G, c, nM * nN, uid, hmask)) return false;
    tile_of(uid, nM, nN, pm, pn); return true;
}

__device__ __forceinline__ void load_gidx(const Unit& u, int tid, int (&gi)[4]) {
#pragma unroll
    for (int i = 0; i < 2; ++i) { int R, C; stage_rc(tid * 16 + i * 8192, R, C);
#pragma unroll
        for (int h = 0; h < 2; ++h) gi[h * 2 + i] = (h * HALF + R < u.nvalid) ? u.gidx[h * HALF + R] : -1; }
}
template <bool PERM, bool GATHER>
__device__ __forceinline__ void calc_voff(const Unit& u, int tid, unsigned (&vA)[2][2], unsigned (&vB)[2], const int (&gi)[4]) {
#pragma unroll
    for (int i = 0; i < 2; ++i) {
        int R, C; stage_rc(tid * 16 + i * 8192, R, C); const int Rb = PERM ? ((R & ~31) + perm32(R & 31)) : R;
        vB[i] = (unsigned)Rb * (unsigned)u.pitchB + (unsigned)C * 2u;
        if (GATHER) {
#pragma unroll
            for (int h = 0; h < 2; ++h) { int g = gi[h * 2 + i]; asm volatile("" : "+v"(g));        const int rowA = g < 0 ? 0 : (g >> 1); vA[h][i] = (unsigned)rowA * (unsigned)u.pitchA + (unsigned)C * 2u; }
        } else { vA[0][i] = (unsigned)R * (unsigned)u.pitchA + (unsigned)C * 2u; vA[1][i] = vA[0][i]; }
    }
}

template <class E, class = void> struct epi_i8 { static constexpr bool value = false; };
template <class E> struct epi_i8<E, decltype((void)E::I8)> { static constexpr bool value = E::I8; };
typedef int i32x4 __attribute__((ext_vector_type(4)));
template <bool I8> __device__ __forceinline__ f32x4 mma16(const bf16x8 a, const bf16x8 b, const f32x4 c) {
    if constexpr (I8) return __builtin_bit_cast(f32x4, __builtin_amdgcn_mfma_i32_16x16x64_i8(__builtin_bit_cast(i32x4, a), __builtin_bit_cast(i32x4, b), __builtin_bit_cast(i32x4, c), 0, 0, 0));
    else return __builtin_amdgcn_mfma_f32_16x16x32_bf16(a, b, c, 0, 0, 0);
}
template <class Epi, class Sched>
__device__ __forceinline__ void gemm_phase(LAS unsigned char* lds, const Sched& S, const Epi& E) {
    int tid_l = threadIdx.x; asm volatile("" : "+v"(tid_l));
    const int tid = tid_l, wid = __builtin_amdgcn_readfirstlane(tid >> 6), lane = tid & 63, wr = wid >> 2, wc = wid & 3, fr = lane & 15, fq = lane >> 4;
    const unsigned ldsw = (unsigned)wid * 1024u;
    const int aoff = lds_byte(wr * 64 + fr, fq * 8), boff = lds_byte(wc * 32 + fr, fq * 8);
#define G8_SA(b, h) (((b) * 2 + (h)) * HTB)
#define G8_SB(b, h) ((4 + (b) * 2 + (h)) * HTB)
#define G8_STAGE(bufoff, gbase, koff, voff) do { _Pragma("unroll") for (int _i = 0; _i < 2; ++_i) \
        __builtin_amdgcn_global_load_lds((const unsigned*)((const char*)(gbase) + (unsigned)((voff)[_i] + (unsigned)(koff))), (LAS unsigned*)(lds + (bufoff) + ldsw + _i * 8192), 16, 0, 0); } while (0)
#define G8_LDA(dst, b, h) do { _Pragma("unroll") for (int m = 0; m < 4; ++m) _Pragma("unroll") for (int k = 0; k < 2; ++k) dst[m][k] = *(const LAS bf16x8*)(lds + G8_SA(b, h) + aoff + m * 2048 + k * 1024); } while (0)
#define G8_LDB(dst, b, h) do { _Pragma("unroll") for (int n = 0; n < 2; ++n) _Pragma("unroll") for (int k = 0; k < 2; ++k) dst[n][k] = *(const LAS bf16x8*)(lds + G8_SB(b, h) + boff + n * 2048 + k * 1024); } while (0)
#define G8_MMA(ai, bj, At, Bt) do { __builtin_amdgcn_s_setprio(1); _Pragma("unroll") for (int m = 0; m < 4; ++m) _Pragma("unroll") for (int n = 0; n < 2; ++n) _Pragma("unroll") for (int k = 0; k < 2; ++k) \
        acc[ai][bj][m][n] = mma16<epi_i8<Epi>::value>(Bt[n][k], At[m][k], acc[ai][bj][m][n]); __builtin_amdgcn_s_setprio(0); } while (0)
#define G8_WAIT_V(n) asm volatile("s_waitcnt vmcnt(" #n ")" ::: "memory")
#define G8_WAIT_L(n) asm volatile("s_waitcnt lgkmcnt(" #n ")" ::: "memory")
#define G8_BAR __builtin_amdgcn_s_barrier()
#define G8_SCHED __builtin_amdgcn_sched_barrier(0)
    Unit cur, nxt; int ui = 0;
    if (!S.next(0, cur)) return;
    f32x4 acc[2][2][4][2];
#pragma unroll
    for (int a = 0; a < 2; ++a)
#pragma unroll
        for (int b = 0; b < 2; ++b)
#pragma unroll
            for (int m = 0; m < 4; ++m)
#pragma unroll
                for (int n = 0; n < 2; ++n) acc[a][b][m][n] = (f32x4){0.f, 0.f, 0.f, 0.f};
    bf16x8 At[4][2], B0[2][2], B1[2][2];
    constexpr bool GA = Sched::GATHER; constexpr int H1 = GA ? 1 : 0;
    unsigned vA[2][2], vB[2];
    { int gi0[4] = {0, 0, 0, 0}; if (GA) load_gidx(cur, tid, gi0); calc_voff<Epi::PERM, GA>(cur, tid, vA, vB, gi0); }
    unsigned hA = GA ? 0u : (unsigned)(HALF * cur.pitchA), hB = (unsigned)(HALF * cur.pitchB);
    const char* cA = cur.A; const char* cB = cur.B + (size_t)cur.eidx * cur.bstride; int nt = cur.nt;
    constexpr unsigned kstep = BK * 2;
    G8_STAGE(G8_SB(0, 0), cB, 0u, vB); G8_STAGE(G8_SB(0, 1), cB, hB, vB); G8_STAGE(G8_SA(0, 0), cA, 0u, vA[0]); G8_STAGE(G8_SA(0, 1), cA, hA, vA[H1]);
    if (wr == 1) G8_BAR;
    G8_WAIT_V(2); G8_BAR;
    G8_STAGE(G8_SB(1, 0), cB, kstep, vB); G8_STAGE(G8_SA(1, 0), cA, kstep, vA[0]); G8_STAGE(G8_SB(1, 1), cB, kstep + hB, vB);
    G8_WAIT_V(6); G8_BAR;
    for (;;) {
        const bool has_next = S.next(ui + 1, nxt);
        int gi[4] = {0, 0, 0, 0};
        if (GA && has_next) load_gidx(nxt, tid, gi);
        const char* nA = has_next ? nxt.A : cA; const char* nB = cB;
        const bool hm0 = (cur.hmask & 1) != 0, hm1 = (cur.hmask & 2) != 0;
        for (int t = 0; t < nt; t += 2) {
            const bool last = (t == nt - 2);
            const unsigned k1 = (unsigned)(t + 1) * kstep, k2 = last ? 0u : (unsigned)(t + 2) * kstep, k3 = k2 + kstep;
            if (last && has_next) { int e = nxt.eidx; asm volatile("" : "+v"(e)); nB = nxt.B + (size_t)__builtin_amdgcn_readfirstlane(e) * nxt.bstride; }
            const char* a2 = last ? nA : cA; const char* b2 = last ? nB : cB;
            G8_LDB(B0, 0, 0); G8_LDB(B1, 0, 1); G8_SCHED; G8_LDA(At, 0, 0); G8_STAGE(G8_SA(1, 1), cA, k1 + hA, vA[H1]);
            if (last && has_next) { calc_voff<Epi::PERM, GA>(nxt, tid, vA, vB, gi); hA = GA ? 0u : (unsigned)(HALF * nxt.pitchA); hB = (unsigned)(HALF * nxt.pitchB); }
            G8_WAIT_V(8); G8_WAIT_L(0); G8_BAR; if (hm0) { G8_MMA(0, 0, At, B0); G8_MMA(0, 1, At, B1); } G8_BAR; G8_SCHED;
            G8_LDA(At, 0, 1); G8_STAGE(G8_SB(0, 0), b2, k2, vB); G8_STAGE(G8_SB(0, 1), b2, k2 + hB, vB); G8_STAGE(G8_SA(0, 0), a2, k2, vA[0]);
            G8_WAIT_V(8); G8_WAIT_L(0); G8_BAR; if (hm1) { G8_MMA(1, 0, At, B0); G8_MMA(1, 1, At, B1); } G8_BAR; G8_SCHED;
            G8_LDB(B0, 1, 0); G8_LDB(B1, 1, 1); G8_SCHED; G8_LDA(At, 1, 0); G8_STAGE(G8_SA(0, 1), a2, k2 + hA, vA[H1]);
            G8_WAIT_V(8); G8_WAIT_L(0); G8_BAR; if (hm0) { G8_MMA(0, 0, At, B0); G8_MMA(0, 1, At, B1); } G8_BAR; G8_SCHED;
            G8_LDA(At, 1, 1); G8_STAGE(G8_SB(1, 0), b2, k3, vB); G8_STAGE(G8_SB(1, 1), b2, k3 + hB, vB); G8_STAGE(G8_SA(1, 0), a2, k3, vA[0]);
            G8_WAIT_V(8); G8_WAIT_L(0); G8_BAR; if (hm1) { G8_MMA(1, 0, At, B0); G8_MMA(1, 1, At, B1); } G8_BAR; G8_SCHED;
        }
        if (wr == 0) G8_BAR;
        G8_SCHED; E(acc, cur, wr, wc, fr, fq); G8_SCHED;
        if (!has_next) break;
        if (!Epi::keeps(cur)) {
#pragma unroll
        for (int a = 0; a < 2; ++a)
#pragma unroll
            for (int b = 0; b < 2; ++b)
#pragma unroll
                for (int m = 0; m < 4; ++m)
#pragma unroll
                    for (int n = 0; n < 2; ++n) acc[a][b][m][n] = (f32x4){0.f, 0.f, 0.f, 0.f};
        }
        cur = nxt; cA = nA; cB = nB; nt = cur.nt; ++ui;
        if (wr == 1) G8_BAR;
    }
    G8_WAIT_V(0);
    G8_BAR;
#undef G8_SA
#undef G8_SB
#undef G8_STAGE
#undef G8_LDA
#undef G8_LDB
#undef G8_MMA
#undef G8_WAIT_V
#undef G8_WAIT_L
#undef G8_BAR
#undef G8_SCHED
}
typedef f32x4 Acc[2][2][4][2];
}
using g8::Unit;

struct SchedDense {
    static constexpr bool GATHER = false;
    const char* A; const char* B; int K, nM, nN, G, c; bool skip;
    __device__ __forceinline__ bool next(int i, Unit& u) const {
        int pm, pn, hm; if (!g8::static_tile(i, G, c, skip ? (nM / 17) * 16 : nM, nN, pm, pn, hm)) return false;
        if (skip) pm = (pm >> 4) * 17 + 1 + (pm & 15);
        u.hmask = hm; u.pitchA = K * 2; u.pitchB = K * 2; u.nt = K / 64; u.pm = pm; u.pn = pn; u.aux = 0; u.gidx = nullptr; u.eidx = 0; u.bstride = 0;
        u.A = A + (size_t)pm * 256 * K * 2; u.B = B + (size_t)pn * 256 * K * 2; return true;
    }
};
struct SchedUp {
    static constexpr bool GATHER = false;
    const char* Akv; const char* Bkv; const char* Aq; const char* Bq; int nM, G, c; bool skip;
    __device__ __forceinline__ bool next(int i, Unit& u) const {
        const int nkv = nM * 4, nMq = skip ? (nM / 17) * 16 : nM, nq = nMq * 3;
        int uid, hm; if (!g8::deal_unit(i, G, c, nkv + nq, uid, hm)) return false;
        int pm, pn; const bool isq = uid >= nkv;
        if (!isq) g8::tile_of(uid, nM, 4, pm, pn); else { g8::tile_of(uid - nkv, nMq, 3, pm, pn); if (skip) pm = (pm >> 4) * 17 + 1 + (pm & 15); }
        const int kb = isq ? 512 : 256;
        u.hmask = hm; u.pitchA = kb; u.pitchB = kb; u.nt = kb / 128; u.pm = pm; u.pn = pn; u.aux = isq ? 1 : 0; u.gidx = nullptr; u.eidx = 0; u.bstride = 0;
        u.A = (isq ? Aq : Akv) + (size_t)pm * 256 * kb; u.B = (isq ? Bq : Bkv) + (size_t)pn * 256 * kb; return true;
    }
};
struct SchedHG {
    static constexpr bool GATHER = false;
    const char* A; const char* B; int nM, G, c; bool last;
    __device__ __forceinline__ bool next(int i, Unit& u) const {
        const int n1 = last ? 6 : 21, nMl = (nM / 17) * 16, np1 = nM * n1, np2 = last ? nMl * (21 - n1) : 0;
        int uid, hm; if (!g8::deal_unit(i, G, c, np1 + np2, uid, hm)) return false;
        int pm, pn;
        if (uid < np1) g8::tile_of(uid, nM, n1, pm, pn);
        else { g8::tile_of(uid - np1, nMl, 21 - n1, pm, pn); pm = (pm >> 4) * 17 + 1 + (pm & 15); pn += n1; }
        u.hmask = hm; u.pitchA = 1024; u.pitchB = 1024; u.nt = 8; u.pm = pm; u.pn = pn; u.aux = 0; u.gidx = nullptr; u.eidx = 0; u.bstride = 0;
        u.A = A + (size_t)pm * 256 * 1024; u.B = B + (size_t)pn * 256 * 1024; return true;
    }
};
struct SchedGate {
    static constexpr bool GATHER = false;
    const char* A; const char* B; int nM, G, c;
    __device__ __forceinline__ bool next(int i, Unit& u) const {
        int pm, pn, hm; if (!g8::static_tile(i, G, c, nM, 8, pm, pn, hm)) return false;
        u.hmask = hm;
        int two = 2; asm volatile("" : "+s"(two));
        u.pitchA = 1024; u.pitchB = 256; u.nt = two; u.pm = pm; u.pn = pn; u.aux = 0; u.gidx = nullptr; u.eidx = 0; u.bstride = 0;
        u.A = A + (size_t)pm * 256 * 1024 + (size_t)(pn >> 1) * 256; u.B = B + (size_t)pn * 256 * 256; return true;
    }
};
struct SchedMerge {
    static constexpr bool GATHER = false;
    const char* wsb; const char* WBR; int nM, G, c; bool skip;
    __device__ __forceinline__ bool next(int i, Unit& u) const {
        const int ti = i / 3, k = i - ti * 3;
        int pm, pn, hm; if (!g8::static_tile(ti, G, c, skip ? (nM / 17) * 16 : nM, 4, pm, pn, hm)) return false;
        u.hmask = hm;
        if (skip) pm = (pm >> 4) * 17 + 1 + (pm & 15);
        u.pm = pm; u.pn = pn; u.aux = k; u.gidx = nullptr; u.eidx = 0; u.bstride = 0;
        u.pitchA = 1024; u.pitchB = 1024; u.nt = 8; { const size_t yo = k == 0 ? WS_C : (k == 1 ? WS_B + B_YM : WS_B + B_YG); u.A = wsb + yo + (size_t)pm * 256 * 1024; } u.B = WBR + ((size_t)k * 1024 + pn * 256) * 1024;
        return true;
    }
};
template <bool GA_> struct SchedMoe {
    static constexpr bool GATHER = GA_;
    const char* A; const char* Bw; const int* list; const LAS int* toffs; int ntiles, nN, K, G, c; size_t strideB;
    __device__ __forceinline__ bool next(int i, Unit& u) const {
        int uid, hm; if (!g8::deal_unit(i, G, c, ntiles * nN, uid, hm)) return false;
        const int tile = uid / nN, pn = uid - tile * nN; u.hmask = hm;
        int e = 0;
#pragma unroll
        for (int st = 16; st >= 1; st >>= 1) if (toffs[e + st] <= tile) e += st;
        const int ti = tile - toffs[e]; u.nvalid = toffs[64 + e] - ti * 256; u.lrow = e * LCAP + ti * 256;
        if (u.nvalid <= 128) u.hmask = hm & 1;
        u.pm = tile; u.pn = pn; u.aux = e; u.pitchA = K * 2; u.pitchB = K * 2; u.nt = K / 64; u.eidx = 0; u.bstride = 0;
        u.gidx = GA_ ? list + u.lrow : nullptr; u.A = GA_ ? A : A + (size_t)tile * 256 * K * 2;
        u.B = Bw + (size_t)e * strideB + (size_t)pn * 256 * K * 2; return true;
    }
};

struct EpiBf16Plain {
    static __device__ __forceinline__ bool keeps(const Unit&) { return false; }
    static constexpr bool PERM = true;
    bf16_t* O; int ldc;
    __device__ __forceinline__ void operator()(const g8::Acc& acc, const Unit& u, int wr, int wc, int fr, int fq) const {
        const int row0 = u.pm * 256 + wr * 64 + fr, col0 = u.pn * 256 + wc * 32 + 8 * fq;
#pragma unroll
        for (int ai = 0; ai < 2; ++ai) if ((u.hmask >> ai) & 1)
#pragma unroll
            for (int m = 0; m < 4; ++m) { bf16_t* rowp = O + (size_t)(row0 + ai * 128 + m * 16) * ldc + col0;
#pragma unroll
                for (int bj = 0; bj < 2; ++bj) { const f32x4 v0 = acc[ai][bj][m][0], v1 = acc[ai][bj][m][1];
                    u32x4 w; w.x = cvt_pk_bf16(v0[0], v0[1]); w.y = cvt_pk_bf16(v0[2], v0[3]); w.z = cvt_pk_bf16(v1[0], v1[1]); w.w = cvt_pk_bf16(v1[2], v1[3]);
                    *(u32x4*)(rowp + bj * 128) = w; } }
    }
};
struct EpiBf16I8 {
    static __device__ __forceinline__ bool keeps(const Unit&) { return false; }
    static constexpr bool PERM = true;
    static constexpr bool I8 = true;
    bf16_t* O; int ldc; const float* rs_; const float* cm_;
    __device__ __forceinline__ void operator()(const g8::Acc& acc, const Unit& u, int wr, int wc, int fr, int fq) const {
        asm volatile("" : "+v"(fr), "+v"(fq));
        const int row0 = u.pm * 256 + wr * 64 + fr, col0 = u.pn * 256 + wc * 32 + 8 * fq;
        f32x4 cs[2][2];
#pragma unroll
        for (int bj = 0; bj < 2; ++bj)
#pragma unroll
            for (int h = 0; h < 2; ++h) cs[bj][h] = *(const f32x4*)(cm_ + col0 + bj * 128 + 4 * h) * (1.0f / 127.0f);
        float rsv[2][4];
#pragma unroll
        for (int ai = 0; ai < 2; ++ai)
#pragma unroll
            for (int m = 0; m < 4; ++m) rsv[ai][m] = rs_[row0 + ai * 128 + m * 16];
#pragma unroll
        for (int ai = 0; ai < 2; ++ai) if ((u.hmask >> ai) & 1)
#pragma unroll
            for (int m = 0; m < 4; ++m) { bf16_t* rowp = O + (size_t)(row0 + ai * 128 + m * 16) * ldc + col0; const float rs = rsv[ai][m];
#pragma unroll
                for (int bj = 0; bj < 2; ++bj) { const g8::i32x4 i0 = __builtin_bit_cast(g8::i32x4, acc[ai][bj][m][0]), i1 = __builtin_bit_cast(g8::i32x4, acc[ai][bj][m][1]);
                    const f32x4 v0 = (f32x4){(float)i0[0], (float)i0[1], (float)i0[2], (float)i0[3]} * (cs[bj][0] * rs), v1 = (f32x4){(float)i1[0], (float)i1[1], (float)i1[2], (float)i1[3]} * (cs[bj][1] * rs);
                    u32x4 w; w.x = cvt_pk_bf16(v0[0], v0[1]); w.y = cvt_pk_bf16(v0[2], v0[3]); w.z = cvt_pk_bf16(v1[0], v1[1]); w.w = cvt_pk_bf16(v1[2], v1[3]);
                    *(u32x4*)(rowp + bj * 128) = w; } }
    }
};
struct EpiGate {
    static __device__ __forceinline__ bool keeps(const Unit&) { return false; }
    static constexpr bool PERM = false;
    const bf16_t* xc_; bf16_t* lab_; const float* ba; const float* bi; const float* logu;
    __device__ __forceinline__ void operator()(const g8::Acc& acc, const Unit& u, int wr, int wc, int fr_, int fq_) const {
        int fr = fr_, fq = fq_; asm volatile("" : "+v"(fr), "+v"(fq));
        const int row0 = u.pm * 256 + wr * 64 + fr; const int c = u.pn * 64 + wc * 16 + fq * 4;
        const f32x4 baf = *(const f32x4*)(ba + c) * -LOG2E_, bif = *(const f32x4*)(bi + c) * -LOG2E_, bab = *(const f32x4*)(ba + 512 + c) * -LOG2E_, bib = *(const f32x4*)(bi + 512 + c) * -LOG2E_, luf = *(const f32x4*)(logu + c), lub = *(const f32x4*)(logu + 512 + c);
        const f32x4 luf2 = luf * (2.0f * LOG2E_), lub2 = lub * (2.0f * LOG2E_);
        u32x2 xw[2][4];
#pragma unroll
        for (int ai = 0; ai < 2; ++ai) if ((u.hmask >> ai) & 1)
#pragma unroll
            for (int m = 0; m < 4; ++m) xw[ai][m] = *(const u32x2*)(xc_ + (size_t)(row0 + ai * 128 + m * 16) * 512 + c);
        asm volatile("" ::: "memory");
#pragma unroll
        for (int ai = 0; ai < 2; ++ai) if ((u.hmask >> ai) & 1)
#pragma unroll
            for (int m = 0; m < 4; ++m) {
                const size_t row = (size_t)(row0 + ai * 128 + m * 16);
                const float xc[4] = {__uint_as_float(xw[ai][m].x << 16), __uint_as_float(xw[ai][m].x & 0xffff0000u), __uint_as_float(xw[ai][m].y << 16), __uint_as_float(xw[ai][m].y & 0xffff0000u)};
                unsigned w[8];
#pragma unroll
                for (int i = 0; i < 4; ++i) {
                    const float rf = sigm2_(acc[ai][0][m][0][i] + baf[i]), i_f = sigm2_(acc[ai][0][m][1][i] + bif[i]), rb = sigm2_(acc[ai][1][m][0][i] + bab[i]), ib = sigm2_(acc[ai][1][m][1][i] + bib[i]);
                    const float laf = rf * luf[i], lab = rb * lub[i];
                    const float bf_ = __builtin_amdgcn_sqrtf(fmaxf(1.0f - __builtin_amdgcn_exp2f(rf * luf2[i]), 0.0f)) * i_f * xc[i], bb_ = __builtin_amdgcn_sqrtf(fmaxf(1.0f - __builtin_amdgcn_exp2f(rb * lub2[i]), 0.0f)) * ib * xc[i];
                    w[2 * i] = cvt_pk_bf16(laf, bf_); w[2 * i + 1] = cvt_pk_bf16(lab, bb_);
                }
                u32x4* dp = (u32x4*)(lab_ + (row * 512 + c) * 4);
                dp[0] = (u32x4){w[0], w[1], w[2], w[3]}; dp[1] = (u32x4){w[4], w[5], w[6], w[7]};
            }
    }
};
struct EpiUkv {
    static __device__ __forceinline__ bool keeps(const Unit&) { return false; }
    static constexpr bool PERM = false;
    bf16_t* km_; bf16_t* vmt_;
    __device__ __forceinline__ void operator()(const g8::Acc& acc, const Unit& u, int wr, int wc, int fr, int fq) const {
        const int b = u.pm / 17, nb = (u.pm - b * 17) * 256 + wr * 64 + fr;
#pragma unroll
        for (int bj = 0; bj < 2; ++bj) { const int h = u.pn * 2 + bj; const size_t bh = (size_t)b * 8 + h;
#pragma unroll
            for (int n = 0; n < 2; ++n) { const int j = wc * 32 + n * 16 + fq * 4;
#pragma unroll
                for (int ai = 0; ai < 2; ++ai) if ((u.hmask >> ai) & 1)
#pragma unroll
                    for (int m = 0; m < 4; ++m) { const int nn = nb + ai * 128 + m * 16; const f32x4 v = acc[ai][bj][m][n];
                        if (wc < 2) { u32x2 w; w.x = cvt_pk_bf16(v[0], v[1]); w.y = cvt_pk_bf16(v[2], v[3]); *(u32x2*)(km_ + (bh * TPB + nn) * 64 + j) = w; }
                        else {
                            float a0 = v[0], a1 = v[1], a2 = v[2], a3 = v[3];
                            { const bool bq = (fr & 2) != 0; const float s0 = bq ? a0 : a2, s1 = bq ? a1 : a3; const float r0 = dpp_f<0x4E>(s0), r1 = dpp_f<0x4E>(s1); if (bq) { a0 = r0; a1 = r1; } else { a2 = r0; a3 = r1; } }
                            { const bool cq = (fr & 1) != 0; const float s0 = cq ? a0 : a1, s1 = cq ? a2 : a3; const float r0 = dpp_f<0xB1>(s0), r1 = dpp_f<0xB1>(s1); if (cq) { a0 = r0; a2 = r1; } else { a1 = r0; a3 = r1; } }
                            u32x2 w; w.x = cvt_pk_bf16(a0, a1); w.y = cvt_pk_bf16(a2, a3);
                            *(u32x2*)(vmt_ + (bh * 64 + (j - 64) + (fr & 3)) * TPB + (nn & ~3)) = w; } } } }
    }
};
struct EpiUq {
    static __device__ __forceinline__ bool keeps(const Unit&) { return false; }
    static constexpr bool PERM = false;
    bf16_t* qm_; const float* cm_; const float* sm_;
    __device__ __forceinline__ void operator()(const g8::Acc& acc, const Unit& u, int wr, int wc, int fr, int fq) const {
        const int b = u.pm / 17, nb = (u.pm - b * 17) * 256 + wr * 64 + fr; const bool lat = (u.pm - b * 17) != 0;
#pragma unroll
        for (int bj = 0; bj < 2; ++bj) { const int G = (u.pn * 256 + bj * 128 + wc * 32) >> 5, h = G / 3, gg = G - h * 3; const size_t bh = (size_t)b * 8 + h;
#pragma unroll
            for (int ai = 0; ai < 2; ++ai) if ((u.hmask >> ai) & 1)
#pragma unroll
                for (int m = 0; m < 4; ++m) { const int nn = nb + ai * 128 + m * 16; f32x4 v0 = acc[ai][bj][m][0] * QSCALE_M, v1 = acc[ai][bj][m][1] * QSCALE_M;
                    bf16_t* qp = qm_ + (bh * TPB + nn) * 96 + gg * 32 + fq * 4;
                    if (ABL != 5 && gg == 2 && lat) { const f32x4 cs = *(const f32x4*)(cm_ + (size_t)(nn - NCTX) * 16 + fq * 4), sn = *(const f32x4*)(sm_ + (size_t)(nn - NCTX) * 16 + fq * 4);
                        const f32x4 o0 = v0 * cs - v1 * sn, o1 = v0 * sn + v1 * cs; v0 = o0; v1 = o1; }
                    u32x2 w0, w1; w0.x = cvt_pk_bf16(v0[0], v0[1]); w0.y = cvt_pk_bf16(v0[2], v0[3]); w1.x = cvt_pk_bf16(v1[0], v1[1]); w1.y = cvt_pk_bf16(v1[2], v1[3]);
                    *(u32x2*)qp = w0; *(u32x2*)(qp + 16) = w1; } }
    }
};
struct EpiGateU8 {
    static __device__ __forceinline__ bool keeps(const Unit&) { return false; }
    static constexpr bool PERM = true;
    unsigned char* g8_;
    __device__ __forceinline__ void operator()(const g8::Acc& acc, const Unit& u, int wr, int wc, int fr, int fq) const {
        const int row0 = u.pm * 256 + wr * 64 + fr, col0 = u.pn * 256 + wc * 32 + 8 * fq;
#pragma unroll
        for (int ai = 0; ai < 2; ++ai) if ((u.hmask >> ai) & 1)
#pragma unroll
            for (int m = 0; m < 4; ++m)
#pragma unroll
                for (int bj = 0; bj < 2; ++bj) { const f32x4 v0 = acc[ai][bj][m][0], v1 = acc[ai][bj][m][1]; const float f[8] = {v0[0], v0[1], v0[2], v0[3], v1[0], v1[1], v1[2], v1[3]};
                    u32x2 w = {0u, 0u};
#pragma unroll
                    for (int j = 0; j < 4; ++j) { w.x = __builtin_amdgcn_cvt_pk_u8_f32(fmaxf(sigmoidf_(f[j]) * 255.0f, 1.0f), j, w.x); w.y = __builtin_amdgcn_cvt_pk_u8_f32(fmaxf(sigmoidf_(f[4 + j]) * 255.0f, 1.0f), j, w.y); }
                    *(u32x2*)(g8_ + (size_t)(row0 + ai * 128 + m * 16) * 3072 + col0 + bj * 128) = w; }
    }
};
struct EpiGateI8 {
    static __device__ __forceinline__ bool keeps(const Unit&) { return false; }
    static constexpr bool PERM = true;
    static constexpr bool I8 = true;
    unsigned char* gp0_; unsigned char* gp2_; const float* rs_; const float* cm_;
    __device__ __forceinline__ void operator()(const g8::Acc& acc, const Unit& u, int wr, int wc, int fr, int fq) const {
        asm volatile("" : "+v"(fr), "+v"(fq));
        const int row0 = u.pm * 256 + wr * 64 + fr, col0 = u.pn * 256 + wc * 32 + 8 * fq;
        unsigned char* gpl = (u.pn >> 2) == 2 ? gp2_ : gp0_ + (size_t)(u.pn >> 2) * T * 1024;
        f32x4 cs[2][2];
#pragma unroll
        for (int bj = 0; bj < 2; ++bj)
#pragma unroll
            for (int h = 0; h < 2; ++h) cs[bj][h] = *(const f32x4*)(cm_ + col0 + bj * 128 + 4 * h) * (-LOG2E_ / 127.0f);
        float rsv[2][4];
#pragma unroll
        for (int ai = 0; ai < 2; ++ai)
#pragma unroll
            for (int m = 0; m < 4; ++m) rsv[ai][m] = rs_[row0 + ai * 128 + m * 16];
#pragma unroll
        for (int ai = 0; ai < 2; ++ai) if ((u.hmask >> ai) & 1)
#pragma unroll
            for (int m = 0; m < 4; ++m)
#pragma unroll
                for (int bj = 0; bj < 2; ++bj) { const g8::i32x4 v0 = __builtin_bit_cast(g8::i32x4, acc[ai][bj][m][0]), v1 = __builtin_bit_cast(g8::i32x4, acc[ai][bj][m][1]); const f32x4 c0 = cs[bj][0] * rsv[ai][m], c1 = cs[bj][1] * rsv[ai][m];
                    u32x2 w = {0u, 0u};
#pragma unroll
                    for (int j = 0; j < 4; ++j) {
                        const float s0 = __builtin_amdgcn_rcpf(__builtin_fmaf(__builtin_amdgcn_exp2f((float)v0[j] * c0[j]), 1.0f / 255.0f, 1.0f / 255.0f)), s1 = __builtin_amdgcn_rcpf(__builtin_fmaf(__builtin_amdgcn_exp2f((float)v1[j] * c1[j]), 1.0f / 255.0f, 1.0f / 255.0f));
                        w.x = __builtin_amdgcn_cvt_pk_u8_f32(fmaxf(s0, 1.0f), j, w.x); w.y = __builtin_amdgcn_cvt_pk_u8_f32(fmaxf(s1, 1.0f), j, w.y); }
                    *(u32x2*)(gpl + (size_t)(row0 + ai * 128 + m * 16) * 1024 + (col0 & 1023) + bj * 128) = w; }
    }
};
struct EpiUp {
    static __device__ __forceinline__ bool keeps(const Unit&) { return false; }
    static constexpr bool PERM = false;
    EpiUkv kv; EpiUq q;
    __device__ __forceinline__ void operator()(const g8::Acc& acc, const Unit& u, int wr, int wc, int fr, int fq) const { asm volatile("" : "+v"(fr), "+v"(fq)); if (u.aux == 0) kv(acc, u, wr, wc, fr, fq); else q(acc, u, wr, wc, fr, fq); }
};
struct EpiHG {
    static __device__ __forceinline__ bool keeps(const Unit&) { return false; }
    static constexpr bool PERM = true;
    static constexpr bool I8 = true;
    EpiBf16I8 ip; EpiGateI8 mg;
    __device__ __forceinline__ void operator()(const g8::Acc& acc, const Unit& u, int wr, int wc, int fr, int fq) const {
        if (u.pn < 9) ip(acc, u, wr, wc, fr, fq);
        else { Unit v = u; v.pn = u.pn - 9; mg(acc, v, wr, wc, fr, fq); }
    }
};
struct EpiMerge {
    static constexpr bool PERM = true;
    static __device__ __forceinline__ bool keeps(const Unit& u) { return u.aux < 2; }
    bf16_t* mb_; const unsigned char* gp0_; const unsigned char* gp2_;
    __device__ __forceinline__ void operator()(g8::Acc& acc, const Unit& u, int wr, int wc, int fr_, int fq_) const {
        int fr = fr_, fq = fq_; asm volatile("" : "+v"(fr), "+v"(fq));
        const int row0 = u.pm * 256 + wr * 64 + fr, col0 = u.pn * 256 + wc * 32 + 8 * fq; const int k = u.aux;
        const unsigned char* ga = (k == 2 ? gp2_ : gp0_ + (size_t)k * T * 1024) + col0; const unsigned char* gb = (k >= 1 ? gp2_ : gp0_ + (size_t)T * 1024) + col0;
#pragma unroll
        for (int am = 0; am < 4; ++am) {
            const int ai = am >> 1, m0 = (am & 1) * 2;
            if (!((u.hmask >> ai) & 1)) continue;
            u32x2 wa[2][2], wb2[2][2];
#pragma unroll
            for (int mm = 0; mm < 2; ++mm)
#pragma unroll
                for (int bj = 0; bj < 2; ++bj) { const size_t o = (size_t)(row0 + ai * 128 + (m0 + mm) * 16) * 1024 + bj * 128; wa[mm][bj] = *(const u32x2*)(ga + o); wb2[mm][bj] = *(const u32x2*)(gb + o); }
            asm volatile("" ::: "memory");
#pragma unroll
            for (int mm = 0; mm < 2; ++mm)
#pragma unroll
                for (int bj = 0; bj < 2; ++bj) { const int m = m0 + mm;
                    float sc[8];
#pragma unroll
                    for (int j = 0; j < 8; ++j) { const float a = (float)(((j < 4 ? wa[mm][bj].x : wa[mm][bj].y) >> (8 * (j & 3))) & 255u), bq = (float)(((j < 4 ? wb2[mm][bj].x : wb2[mm][bj].y) >> (8 * (j & 3))) & 255u);
                        sc[j] = k == 2 ? a * (1.0f / 255.0f) : a * __builtin_amdgcn_rcpf(bq); }
                    const f32x4 v0 = acc[ai][bj][m][0] * (f32x4){sc[0], sc[1], sc[2], sc[3]}, v1 = acc[ai][bj][m][1] * (f32x4){sc[4], sc[5], sc[6], sc[7]};
                    acc[ai][bj][m][0] = v0; acc[ai][bj][m][1] = v1;
                    if (k == 2) { u32x4 w; w.x = cvt_pk_bf16(v0[0], v0[1]); w.y = cvt_pk_bf16(v0[2], v0[3]); w.z = cvt_pk_bf16(v1[0], v1[1]); w.w = cvt_pk_bf16(v1[2], v1[3]);
                        *(u32x4*)(mb_ + (size_t)(row0 + ai * 128 + m * 16) * 1024 + col0 + bj * 128) = w; }
                }
            asm volatile("" ::: "memory");
        }
    }
};
struct EpiOut {
    static __device__ __forceinline__ bool keeps(const Unit&) { return false; }
    static constexpr bool PERM = true;
    bf16_t* xb_; const float* in_; const float* inc_; const float* mod_;
    __device__ __forceinline__ void operator()(const g8::Acc& acc, const Unit& u, int wr, int wc, int fr, int fq) const {
        const int b = u.pm / 17, pt = u.pm - b * 17; const bool isctx = pt == 0;
        if (ABL == 7 && isctx) return;
        const float* ga = mod_ + (size_t)(isctx ? 8 : b) * 6144 + 2048;
        const int r0 = wr * 64 + fr, col0 = u.pn * 256 + wc * 32 + 8 * fq;
        bf16_t* xrow = xb_ + (size_t)(u.pm * 256 + r0) * DM + col0;
        f32x4 g[2][2];
#pragma unroll
        for (int bj = 0; bj < 2; ++bj)
#pragma unroll
            for (int n = 0; n < 2; ++n) g[bj][n] = *(const f32x4*)(ga + col0 + bj * 128 + n * 4);
#pragma unroll
        for (int ai = 0; ai < 2; ++ai) { if (!((u.hmask >> ai) & 1)) continue;
            f32x4 r[4][2][2];
            if (in_) { const float* rbase = (isctx ? inc_ + (size_t)b * NCTX * DM : in_ + ((size_t)b * SEQ + (size_t)(pt - 1) * 256) * DM) + (size_t)r0 * DM + col0;
#pragma unroll
                for (int m = 0; m < 4; ++m)
#pragma unroll
                    for (int bj = 0; bj < 2; ++bj)
#pragma unroll
                        for (int n = 0; n < 2; ++n) r[m][bj][n] = *(const f32x4*)(rbase + (size_t)(ai * 128 + m * 16) * DM + bj * 128 + n * 4);
            } else { u32x4 q[4][2];
#pragma unroll
                for (int m = 0; m < 4; ++m)
#pragma unroll
                    for (int bj = 0; bj < 2; ++bj) q[m][bj] = *(const u32x4*)(xrow + (size_t)(ai * 128 + m * 16) * DM + bj * 128);
                asm volatile("" ::: "memory");
#pragma unroll
                for (int m = 0; m < 4; ++m)
#pragma unroll
                    for (int bj = 0; bj < 2; ++bj) { r[m][bj][0] = unpack4((u32x2){q[m][bj].x, q[m][bj].y}); r[m][bj][1] = unpack4((u32x2){q[m][bj].z, q[m][bj].w}); }
            }
            asm volatile("" ::: "memory");
#pragma unroll
            for (int m = 0; m < 4; ++m)
#pragma unroll
                for (int bj = 0; bj < 2; ++bj) { const u32x2 lo = pack4(r[m][bj][0] + g[bj][0] * acc[ai][bj][m][0]), hi = pack4(r[m][bj][1] + g[bj][1] * acc[ai][bj][m][1]);
                    *(u32x4*)(xrow + (size_t)(ai * 128 + m * 16) * DM + bj * 128) = (u32x4){lo.x, lo.y, hi.x, hi.y}; }
            asm volatile("" ::: "memory");
        }
    }
};
struct EpiMoe1 {
    static __device__ __forceinline__ bool keeps(const Unit&) { return false; }
    static constexpr bool PERM = false;
    bf16_t* he_;
    __device__ __forceinline__ void operator()(const g8::Acc& acc, const Unit& u, int wr, int wc, int fr, int fq) const {
        const int row0 = u.pm * 256 + wr * 64 + fr;
#pragma unroll
        for (int bj = 0; bj < 2; ++bj) { const int j0 = u.pn * 128 + bj * 64 + wc * 16 + fq * 4;
#pragma unroll
            for (int ai = 0; ai < 2; ++ai) if ((u.hmask >> ai) & 1)
#pragma unroll
                for (int m = 0; m < 4; ++m) { const f32x4 a = acc[ai][bj][m][0], bb = acc[ai][bj][m][1]; float o[4];
#pragma unroll
                    for (int j = 0; j < 4; ++j) o[j] = a[j] * sigmoidf_(a[j]) * bb[j];
                    u32x2 w; w.x = cvt_pk_bf16(o[0], o[1]); w.y = cvt_pk_bf16(o[2], o[3]);
                    *(u32x2*)(he_ + (size_t)(row0 + ai * 128 + m * 16) * 256 + j0) = w; } }
    }
};
struct EpiMoe1I8 {
    static __device__ __forceinline__ bool keeps(const Unit&) { return false; }
    static constexpr bool PERM = false;
    static constexpr bool I8 = true;
    bf16_t* he_; const float* lrs_; const float* cm_;
    __device__ __forceinline__ void operator()(const g8::Acc& acc, const Unit& u, int wr, int wc, int fr_, int fq_) const {
        int fr = fr_, fq = fq_; asm volatile("" : "+v"(fr), "+v"(fq));
        const int row0 = u.pm * 256 + wr * 64 + fr;
        float rsv[2][4];
#pragma unroll
        for (int ai = 0; ai < 2; ++ai)
#pragma unroll
            for (int m = 0; m < 4; ++m) { const int r_ = wr * 64 + fr + ai * 128 + m * 16; rsv[ai][m] = r_ < u.nvalid ? lrs_[u.lrow + r_] : 0.f; }
        const float* cme = cm_ + (size_t)u.aux * 512 + u.pn * 256 + wc * 32 + fq * 4;
#pragma unroll
        for (int bj = 0; bj < 2; ++bj) { const int j0 = u.pn * 128 + bj * 64 + wc * 16 + fq * 4;
            const f32x4 ca = *(const f32x4*)(cme + bj * 128) * (1.0f / 127.0f), cb = *(const f32x4*)(cme + bj * 128 + 16) * (1.0f / 127.0f);
#pragma unroll
            for (int ai = 0; ai < 2; ++ai) if ((u.hmask >> ai) & 1)
#pragma unroll
                for (int m = 0; m < 4; ++m) { const g8::i32x4 ia = __builtin_bit_cast(g8::i32x4, acc[ai][bj][m][0]), ib = __builtin_bit_cast(g8::i32x4, acc[ai][bj][m][1]); const float rs = rsv[ai][m]; float o[4];
#pragma unroll
                    for (int j = 0; j < 4; ++j) { const float a = (float)ia[j] * rs * ca[j], bb = (float)ib[j] * rs * cb[j]; o[j] = a * sigmoidf_(a) * bb; }
                    u32x2 w; w.x = cvt_pk_bf16(o[0], o[1]); w.y = cvt_pk_bf16(o[2], o[3]);
                    *(u32x2*)(he_ + (size_t)(row0 + ai * 128 + m * 16) * 256 + j0) = w; } }
    }
};
struct EpiMoe2 {
    static __device__ __forceinline__ bool keeps(const Unit&) { return false; }
    static constexpr bool PERM = true;
    bf16_t* y2_; const int* ltok_; const float* lp_;
    __device__ __forceinline__ void operator()(const g8::Acc& acc, const Unit& u, int wr, int wc, int fr_, int fq_) const {
        int fr = fr_, fq = fq_; asm volatile("" : "+v"(fr), "+v"(fq));
        const int col0 = u.pn * 256 + wc * 32 + 8 * fq;
        int tk[2][4]; float pw[2][4];
#pragma unroll
        for (int ai = 0; ai < 2; ++ai) if ((u.hmask >> ai) & 1)
#pragma unroll
            for (int m = 0; m < 4; ++m) { const int r_ = wr * 64 + fr + ai * 128 + m * 16; const bool ok_ = r_ < u.nvalid; tk[ai][m] = ok_ ? ltok_[u.lrow + r_] : -1; pw[ai][m] = ok_ ? lp_[u.lrow + r_] : 0.f; }
#pragma unroll
        for (int ai = 0; ai < 2; ++ai) if ((u.hmask >> ai) & 1)
#pragma unroll
            for (int m = 0; m < 4; ++m) {
                if (tk[ai][m] >= 0) { bf16_t* rowp = y2_ + (size_t)tk[ai][m] * 1024 + col0;
                    const float pq = ABL == 3 ? 0.f : pw[ai][m];
#pragma unroll
                    for (int bj = 0; bj < 2; ++bj) { const f32x4 v0 = acc[ai][bj][m][0] * pq, v1 = acc[ai][bj][m][1] * pq;
                        u32x4 w; w.x = cvt_pk_bf16(v0[0], v0[1]); w.y = cvt_pk_bf16(v0[2], v0[3]); w.z = cvt_pk_bf16(v1[0], v1[1]); w.w = cvt_pk_bf16(v1[2], v1[3]);
                        *(u32x4*)(rowp + bj * 128) = w; } } }
    }
};

__device__ __forceinline__ float half_max(float m) { auto rr = __builtin_amdgcn_permlane32_swap(__float_as_uint(m), __float_as_uint(m), false, false); return __builtin_fmaxf(__uint_as_float(rr[0]), __uint_as_float(rr[1])); }
__device__ __forceinline__ float half_sum(float m) { auto rr = __builtin_amdgcn_permlane32_swap(__float_as_uint(m), __float_as_uint(m), false, false); return __uint_as_float(rr[0]) + __uint_as_float(rr[1]); }
__device__ __forceinline__ float max3f(float a, float b, float c) { return __builtin_fmaxf(__builtin_fmaxf(a, b), c); }
__device__ __forceinline__ float max2f(float a, float b) { return __builtin_fmaxf(a, b); }
template <int DQK, int NQ, int NS, bool SAFE>
__device__ __forceinline__ bool attn_unit(
    LAS unsigned char* lds, const bf16_t* Q, const bf16_t* Kn, const bf16_t* Kr, const bf16_t* Vt, int nkeys, bf16_t* O  ) {
    constexpr int KB = 8192, RB_ = (DQK == 96) ? 4096 : 0, VB = 8192, SUB = KB + RB_ + VB, BUF = NS * SUB;
    constexpr int ND = DQK / 16;
    constexpr float THR = 8.0f;
    int tid_l = threadIdx.x; asm volatile("" : "+v"(tid_l));
    const int tid = tid_l, lane = tid & 63, r32 = lane & 31, hi = lane >> 5; const int wid = __builtin_amdgcn_readfirstlane(tid >> 6);
    LAS float* scr = (LAS float*)(lds + 2 * BUF) + wid * 32;
    bf16x8 qf[NQ][ND];
#pragma unroll
    for (int q = 0; q < NQ; ++q) { const bf16_t* qrow = Q + (size_t)((wid * NQ + q) * 32 + r32) * DQK + hi * 8;
#pragma unroll
      for (int d0 = 0; d0 < ND; ++d0) qf[q][d0] = *(const bf16x8*)(qrow + d0 * 16); }
    const int drow = wid * 8 + (lane >> 3), dch = (lane & 7) ^ ((drow >> 1) & 7);
    const unsigned ksrc = (unsigned)(drow * 128 + dch * 16);
    const unsigned vsrc = (unsigned)(drow * (TPB * 2) + dch * 16);
    const int rrow = (wid & 3) * 16 + (lane >> 2), rch = (lane & 3) ^ ((rrow >> 2) & 3);
    const unsigned rsrc = (unsigned)(rrow * 64 + rch * 16);
    const int NT = nkeys / (64 * NS);
    auto dma = [&](int t, int boff) {
#pragma unroll
        for (int u = 0; u < NS; ++u) { const int k0 = (t * NS + u) * 64; LAS unsigned char* sb = lds + boff + u * SUB;
            __builtin_amdgcn_global_load_lds((const unsigned*)((const char*)Kn + (unsigned)(ksrc + (unsigned)k0 * 128u)), (LAS unsigned*)(sb + wid * 1024), 16, 0, 0);
            if (DQK == 96) { if (wid < 4) __builtin_amdgcn_global_load_lds((const unsigned*)((const char*)Kr + (unsigned)(rsrc + (unsigned)k0 * 64u)), (LAS unsigned*)(sb + KB + wid * 1024), 16, 0, 0); }
            __builtin_amdgcn_global_load_lds((const unsigned*)((const char*)Vt + (unsigned)(vsrc + (unsigned)k0 * 2u)), (LAS unsigned*)(sb + KB + RB_ + wid * 1024), 16, 0, 0); }
    };
    dma(0, 0);
    asm volatile("s_waitcnt vmcnt(0)" ::: "memory");
    __syncthreads();
    f32x16 o0[NQ], o1[NQ]; float m_run[NQ], l_run[NQ]; bool zref[NQ];
#pragma unroll
    for (int q = 0; q < NQ; ++q) { o0[q] = f32x16{}; o1[q] = f32x16{}; m_run[q] = 0.f; l_run[q] = 0.f; zref[q] = true; }
    const int ksw = (r32 & 19) | ((r32 & 4) << 1) | ((r32 & 8) >> 1);
    const int kro = ksw * 128, ksx = (ksw >> 1) & 7, rro = ksw * 64, rsx = (ksw >> 2) & 3, vro = r32 * 128, vsx = (r32 >> 1) & 7;
    for (int t = 0; t < NT; ++t) {
        if (t + 1 < NT) dma(t + 1, ((t + 1) & 1) * BUF);
        const LAS unsigned char* bb = lds + (t & 1) * BUF;
#pragma unroll
        for (int u = 0; u < NS; ++u) {
            const LAS unsigned char* kb = bb + u * SUB; const LAS unsigned char* rb = kb + KB; const LAS unsigned char* vb = rb + RB_;
            f32x16 p0[NQ], p1[NQ];
#pragma unroll
            for (int q = 0; q < NQ; ++q) { p0[q] = f32x16{}; p1[q] = f32x16{}; }
            __builtin_amdgcn_s_setprio(1);
#pragma unroll
            for (int d0 = 0; d0 < ND; ++d0) {
                bf16x8 a0, a1;
                if (d0 < 4) { const int off = kro + (((2 * d0 + hi) ^ ksx) << 4); a0 = *(const LAS bf16x8*)(kb + off); a1 = *(const LAS bf16x8*)(kb + 4096 + off); }
                else { const int off = rro + (((2 * (d0 - 4) + hi) ^ rsx) << 4); a0 = *(const LAS bf16x8*)(rb + off); a1 = *(const LAS bf16x8*)(rb + 2048 + off); }
#pragma unroll
                for (int q = 0; q < NQ; ++q) { p0[q] = __builtin_amdgcn_mfma_f32_32x32x16_bf16(a0, qf[q][d0], p0[q], 0, 0, 0); p1[q] = __builtin_amdgcn_mfma_f32_32x32x16_bf16(a1, qf[q][d0], p1[q], 0, 0, 0); }
            }
            __builtin_amdgcn_s_setprio(0);
            bf16x8 pa[NQ][4];
#pragma unroll
            for (int q = 0; q < NQ; ++q) {
                if (ABL == 4) { p0[q] = f32x16{}; p1[q] = f32x16{}; }
                if (SAFE) {
                    float mx = max2f(p0[q][0], p1[q][0]);
#pragma unroll
                    for (int r = 1; r < 16; ++r) mx = max3f(mx, p0[q][r], p1[q][r]);
                    mx = half_max(mx);
                    const bool first = (t == 0 && u == 0);
                    if (first ? __any(__builtin_fabsf(mx) > THR) : __any(mx - m_run[q] > THR)) {
                        const float m_new = first ? mx : max2f(m_run[q], mx); const float alpha = first ? 1.0f : __builtin_amdgcn_exp2f(m_run[q] - m_new);
                        m_run[q] = m_new; l_run[q] *= alpha; zref[q] = false;
                        if (hi == 0) scr[r32] = alpha;
#pragma unroll
                        for (int r = 0; r < 16; ++r) { const float al = scr[(r & 3) + 8 * (r >> 2) + 4 * hi]; o0[q][r] *= al; o1[q][r] *= al; }
                    }
                }
                float ps = 0.f;
                if (!SAFE || zref[q]) {
#pragma unroll
                    for (int r = 0; r < 16; ++r) { p0[q][r] = __builtin_amdgcn_exp2f(p0[q][r]); ps += p0[q][r]; }
#pragma unroll
                    for (int r = 0; r < 16; ++r) { p1[q][r] = __builtin_amdgcn_exp2f(p1[q][r]); ps += p1[q][r]; }
                } else {
                    const float mr = m_run[q];
#pragma unroll
                    for (int r = 0; r < 16; ++r) { p0[q][r] = __builtin_amdgcn_exp2f(p0[q][r] - mr); ps += p0[q][r]; }
#pragma unroll
                    for (int r = 0; r < 16; ++r) { p1[q][r] = __builtin_amdgcn_exp2f(p1[q][r] - mr); ps += p1[q][r]; }
                }
                l_run[q] += ps;
                u32x4 w; const f32x16& a = p0[q]; const f32x16& c = p1[q];
                w.x = cvt_pk_bf16(a[0], a[1]); w.y = cvt_pk_bf16(a[2], a[3]); w.z = cvt_pk_bf16(a[4], a[5]); w.w = cvt_pk_bf16(a[6], a[7]); pa[q][0] = __builtin_bit_cast(bf16x8, w);
                w.x = cvt_pk_bf16(a[8], a[9]); w.y = cvt_pk_bf16(a[10], a[11]); w.z = cvt_pk_bf16(a[12], a[13]); w.w = cvt_pk_bf16(a[14], a[15]); pa[q][1] = __builtin_bit_cast(bf16x8, w);
                w.x = cvt_pk_bf16(c[0], c[1]); w.y = cvt_pk_bf16(c[2], c[3]); w.z = cvt_pk_bf16(c[4], c[5]); w.w = cvt_pk_bf16(c[6], c[7]); pa[q][2] = __builtin_bit_cast(bf16x8, w);
                w.x = cvt_pk_bf16(c[8], c[9]); w.y = cvt_pk_bf16(c[10], c[11]); w.z = cvt_pk_bf16(c[12], c[13]); w.w = cvt_pk_bf16(c[14], c[15]); pa[q][3] = __builtin_bit_cast(bf16x8, w);
            }
#pragma unroll
            for (int s = 0; s < 4; ++s) {
                const int off = vro + (((2 * s + hi) ^ vsx) << 4);
                const bf16x8 v0 = *(const LAS bf16x8*)(vb + off);
                const bf16x8 v1 = *(const LAS bf16x8*)(vb + 4096 + off);
#pragma unroll
                for (int q = 0; q < NQ; ++q) { o0[q] = __builtin_amdgcn_mfma_f32_32x32x16_bf16(pa[q][s], v0, o0[q], 0, 0, 0); o1[q] = __builtin_amdgcn_mfma_f32_32x32x16_bf16(pa[q][s], v1, o1[q], 0, 0, 0); }
            }
            if (NQ > 1) __builtin_amdgcn_sched_barrier(0);
        }
        asm volatile("s_waitcnt vmcnt(0)" ::: "memory");
        __syncthreads();
    }
    bool bad = false;
#pragma unroll
    for (int q = 0; q < NQ; ++q) {
        const float lt = half_sum(l_run[q]);
        bad = bad || !(lt > 7.9e-31f && lt < 1.2e30f);
        if (hi == 0) scr[r32] = 1.0f / lt;
        bf16_t* orow = O + (size_t)((wid * NQ + q) * 32) * 512;
#pragma unroll
        for (int r = 0; r < 16; ++r) { const int qq = (r & 3) + 8 * (r >> 2) + 4 * hi; const float il = scr[qq];
            orow[(size_t)qq * 512 + r32] = f2bf(ABL == 1 ? 0.f : o0[q][r] * il); orow[(size_t)qq * 512 + 32 + r32] = f2bf(ABL == 1 ? 0.f : o1[q][r] * il); }
    }
    __syncthreads();
    return !SAFE && (__any(bad) || ABL == 6);
}
#ifndef ATTN_PRIO
#define ATTN_PRIO 4
#endif
template <int DQK, int NS>
__device__ __forceinline__ bool attn16_unit(LAS unsigned char* lds, const bf16_t* Q, const bf16_t* Kn, const bf16_t* Kr, const bf16_t* Vt, int nkeys, bf16_t* O) {
    constexpr int KB = 8192, RB_ = (DQK == 96) ? 4096 : 0, VB = 8192, SUB = KB + RB_ + VB, BUF = NS * SUB;
    constexpr int KS = DQK / 32;
    int tid_l = threadIdx.x; asm volatile("" : "+v"(tid_l));
    const int tid = tid_l, lane = tid & 63, li = lane & 15, g = lane >> 4; const int wid = __builtin_amdgcn_readfirstlane(tid >> 6);
    LAS float* scr = (LAS float*)(lds + 2 * BUF) + wid * 64;
    bf16x8 qf[4][KS];
#pragma unroll
    for (int qt = 0; qt < 4; ++qt) { const bf16_t* qrow = Q + (size_t)(wid * 64 + qt * 16 + li) * DQK + g * 8;
#pragma unroll
        for (int ks = 0; ks < KS; ++ks) qf[qt][ks] = *(const bf16x8*)(qrow + ks * 32); }
    const int drow = wid * 8 + (lane >> 3), dch = (lane & 7) ^ (2 * ((drow >> 1) & 1) + 4 * ((drow >> 3) & 1));
    const unsigned ksrc = (unsigned)(drow * 128 + dch * 16), vsrc = (unsigned)(drow * (TPB * 2) + dch * 16);
    const int rrow = (wid & 3) * 16 + (lane >> 2), rch = (lane & 3) ^ (2 * ((rrow >> 3) & 1));
    const unsigned rsrc = (unsigned)(rrow * 64 + rch * 16);
    const int NT = nkeys / (64 * NS);
    auto dma = [&](int t, int boff) {
#pragma unroll
        for (int u = 0; u < NS; ++u) { const int k0 = (t * NS + u) * 64; LAS unsigned char* sb = lds + boff + u * SUB;
            __builtin_amdgcn_global_load_lds((const unsigned*)((const char*)Kn + (unsigned)(ksrc + (unsigned)k0 * 128u)), (LAS unsigned*)(sb + wid * 1024), 16, 0, 0);
            if (DQK == 96) { if (wid < 4) __builtin_amdgcn_global_load_lds((const unsigned*)((const char*)Kr + (unsigned)(rsrc + (unsigned)k0 * 64u)), (LAS unsigned*)(sb + KB + wid * 1024), 16, 0, 0); }
            __builtin_amdgcn_global_load_lds((const unsigned*)((const char*)Vt + (unsigned)(vsrc + (unsigned)k0 * 2u)), (LAS unsigned*)(sb + KB + RB_ + wid * 1024), 16, 0, 0); }
    };
    dma(0, 0);
    asm volatile("s_waitcnt vmcnt(0)" ::: "memory");
    __syncthreads();
    f32x4 o[4][4], ol[4];
#pragma unroll
    for (int qt = 0; qt < 4; ++qt) { ol[qt] = (f32x4){0.f, 0.f, 0.f, 0.f};
#pragma unroll
        for (int dt = 0; dt < 4; ++dt) o[qt][dt] = (f32x4){0.f, 0.f, 0.f, 0.f}; }
    const bf16x8 ones = {(short)0x3F80, (short)0x3F80, (short)0x3F80, (short)0x3F80, (short)0x3F80, (short)0x3F80, (short)0x3F80, (short)0x3F80};
    const int krow = 8 * (li >> 2) + (li & 3), fk = 2 * ((li >> 1) & 1) + 4 * ((li >> 2) & 1), fr = 2 * ((li >> 2) & 1);
    const int fv = 2 * ((li >> 1) & 1) + 4 * ((li >> 3) & 1);
    for (int t = 0; t < NT; ++t) {
        if (t + 1 < NT) dma(t + 1, ((t + 1) & 1) * BUF);
        const LAS unsigned char* bb = lds + (t & 1) * BUF;
#pragma unroll
        for (int u = 0; u < NS; ++u) {
            const LAS unsigned char* kb = bb + u * SUB; const LAS unsigned char* rb = kb + KB; const LAS unsigned char* vb = rb + RB_;
#pragma unroll
            for (int b32 = 0; b32 < 2; ++b32) {
                f32x4 sT[2][4];
#pragma unroll
                for (int T2 = 0; T2 < 2; ++T2)
#pragma unroll
                    for (int qt = 0; qt < 4; ++qt) sT[T2][qt] = (f32x4){0.f, 0.f, 0.f, 0.f};
                if (ATTN_PRIO) __builtin_amdgcn_s_setprio(ATTN_PRIO == 4 ? 2 : 1);
#pragma unroll
                for (int ks = 0; ks < KS; ++ks) {
                    bf16x8 kf[2];
#pragma unroll
                    for (int T2 = 0; T2 < 2; ++T2) { const int row = 32 * b32 + 4 * T2 + krow;
                        kf[T2] = ks < 2 ? *(const LAS bf16x8*)(kb + row * 128 + (((4 * ks + g) ^ fk) << 4)) : *(const LAS bf16x8*)(rb + row * 64 + ((g ^ fr) << 4)); }
#pragma unroll
                    for (int T2 = 0; T2 < 2; ++T2)
#pragma unroll
                        for (int qt = 0; qt < 4; ++qt) sT[T2][qt] = __builtin_amdgcn_mfma_f32_16x16x32_bf16(kf[T2], qf[qt][ks], sT[T2][qt], 0, 0, 0);
                }
                if (ATTN_PRIO && ATTN_PRIO != 3) __builtin_amdgcn_s_setprio(ATTN_PRIO == 4 ? 1 : 0);
                bf16x8 vf[4];
#pragma unroll
                for (int dt = 0; dt < 4; ++dt) vf[dt] = *(const LAS bf16x8*)(vb + (16 * dt + li) * 128 + (((4 * b32 + g) ^ fv) << 4));
                bf16x8 pf[4];
#pragma unroll
                for (int qt = 0; qt < 4; ++qt) {
                    float e[8];
#pragma unroll
                    for (int j = 0; j < 4; ++j) { e[j] = __builtin_amdgcn_exp2f(ABL == 4 ? 0.f : sT[0][qt][j]); e[4 + j] = __builtin_amdgcn_exp2f(ABL == 4 ? 0.f : sT[1][qt][j]); }
                    u32x4 w; w.x = cvt_pk_bf16(e[0], e[1]); w.y = cvt_pk_bf16(e[2], e[3]); w.z = cvt_pk_bf16(e[4], e[5]); w.w = cvt_pk_bf16(e[6], e[7]); pf[qt] = __builtin_bit_cast(bf16x8, w);
                }
                if (ATTN_PRIO == 3 || ATTN_PRIO == 4) __builtin_amdgcn_s_setprio(0);
                if (ATTN_PRIO == 2) __builtin_amdgcn_s_setprio(1);
#pragma unroll
                for (int qt = 0; qt < 4; ++qt) {
#pragma unroll
                    for (int dt = 0; dt < 4; ++dt) o[qt][dt] = __builtin_amdgcn_mfma_f32_16x16x32_bf16(pf[qt], vf[dt], o[qt][dt], 0, 0, 0);
                    ol[qt] = __builtin_amdgcn_mfma_f32_16x16x32_bf16(pf[qt], ones, ol[qt], 0, 0, 0); }
                if (ATTN_PRIO == 2) __builtin_amdgcn_s_setprio(0);
                __builtin_amdgcn_sched_barrier(0);
            }
        }
        asm volatile("s_waitcnt vmcnt(0)" ::: "memory");
        __syncthreads();
    }
    bool bad = false;
#pragma unroll
    for (int qt = 0; qt < 4; ++qt)
#pragma unroll
        for (int r = 0; r < 4; ++r) { const float lt = ol[qt][r]; bad = bad || !(lt > 7.9e-31f && lt < 1.2e30f); }
#pragma unroll
    for (int qt = 0; qt < 4; ++qt)
#pragma unroll
        for (int r = 0; r < 4; ++r) { const float il = 1.0f / ol[qt][r]; bf16_t* orow = O + (size_t)(wid * 64 + qt * 16 + 4 * g + r) * 512 + li;
#pragma unroll
            for (int dt = 0; dt < 4; ++dt) orow[dt * 16] = f2bf(ABL == 1 ? 0.f : o[qt][dt][r] * il); }
    __syncthreads();
    return __any(bad) || ABL == 6;
}

template <int DQK, int NQ, int NS>
__device__ __forceinline__ void attn_run(LAS unsigned char* lds, const bf16_t* Q, const bf16_t* Kn, const bf16_t* Kr, const bf16_t* Vt, int nkeys, bf16_t* O) {
    const bool bad = NQ == 2 ? attn16_unit<DQK, NS>(lds, Q, Kn, Kr, Vt, nkeys, O) : attn_unit<DQK, NQ, NS, false>(lds, Q, Kn, Kr, Vt, nkeys, O);
    LAS unsigned* flag = (LAS unsigned*)(lds + 160 * 1024 - 64);
    int t_ = threadIdx.x; asm volatile("" : "+v"(t_));
    if (t_ == 0) *flag = 0u;
    __syncthreads();
    if (bad && (t_ & 63) == 0) *flag = 1u;
    __syncthreads();
    const unsigned any_bad = *flag;
    __syncthreads();
    if (any_bad) {
#pragma unroll
        for (int h = 0; h < NQ; ++h) attn_unit<DQK, 1, NS, true>(lds, Q + (size_t)h * 256 * DQK, Kn, Kr, Vt, nkeys, O + (size_t)h * 256 * 512);
    }
}

template <class F>
__device__ __forceinline__ void cvt_tile(LAS unsigned char* buf, bf16_t* dst, int dst_ld, int tid, F srcp) {
    const int w = tid >> 6, lane = tid & 63;
    f32x4 v[8];
#pragma unroll
    for (int i = 0; i < 8; ++i) { const float* sp = srcp(8 * w + i, lane); v[i] = sp ? *(const f32x4*)sp : (f32x4){0.f, 0.f, 0.f, 0.f}; }
#pragma unroll
    for (int j = 0; j < 4; ++j) { u32x4 o; o.x = cvt_pk_bf16(v[0][j], v[1][j]); o.y = cvt_pk_bf16(v[2][j], v[3][j]); o.z = cvt_pk_bf16(v[4][j], v[5][j]); o.w = cvt_pk_bf16(v[6][j], v[7][j]);
        const int n = 4 * lane + j; *(LAS u32x4*)(buf + n * 128 + ((w ^ (lane & 7)) << 4)) = o; }
    __syncthreads();
#pragma unroll
    for (int i = 0; i < 4; ++i) { const int e = tid + i * 512, n = e >> 3, c = e & 7; const u32x4 o = *(const LAS u32x4*)(buf + n * 128 + ((c ^ ((n >> 2) & 7)) << 4));
        *(u32x4*)(dst + (size_t)n * dst_ld + c * 8) = o; }
}

template <class F>
__device__ __forceinline__ void cvt_tile_i8(LAS unsigned char* buf, unsigned char* dst, int dst_ld, int tid, const float* cmax, F srcp) {
    const int w = tid >> 6, lane = tid & 63;
    f32x4 v[8];
#pragma unroll
    for (int i = 0; i < 8; ++i) { const float* sp = srcp(8 * w + i, lane); v[i] = sp ? *(const f32x4*)sp : (f32x4){0.f, 0.f, 0.f, 0.f}; }
    const f32x4 cm = *(const f32x4*)(cmax + 4 * lane);
#pragma unroll
    for (int j = 0; j < 4; ++j) { const float sc = 127.0f / fmaxf(cm[j], 1e-30f); u32x2 o; o.x = pack_i8x4(v[0][j], v[1][j], v[2][j], v[3][j], sc); o.y = pack_i8x4(v[4][j], v[5][j], v[6][j], v[7][j], sc);
        *(LAS u32x2*)(buf + (4 * lane + j) * 64 + w * 8) = o; }
    __syncthreads();
#pragma unroll
    for (int i = 0; i < 2; ++i) { const int e = tid + i * 512, n = e >> 2, c = e & 3; *(u32x4*)(dst + (size_t)n * dst_ld + c * 16) = *(const LAS u32x4*)(buf + n * 64 + c * 16); }
}

constexpr int LDS_BYTES = 163840;
constexpr int NPH_PRO = 1;
constexpr int NPH_LAYER = 15;
constexpr int PH_FINAL = NPH_PRO + NLAYER * NPH_LAYER;
constexpr int NPHASE = PH_FINAL + 1;

__global__ void __launch_bounds__(512, 2) mega(Params kp) {
    extern __shared__ __attribute__((aligned(16))) unsigned char lds_raw[];
    LAS unsigned char* lds = (LAS unsigned char*)lds_raw;
    const int ph_lo = kp.lo, ph_hi = kp.hi;
    typedef const __attribute__((address_space(4))) Params* KPtr;
#define PHK() int koff_ = 0, Gl_ = gridDim.x, bidl_ = blockIdx.x; asm volatile("" : "+s"(koff_), "+s"(Gl_), "+s"(bidl_)); const int G = Gl_, bid = bidl_; (void)G; (void)bid; const KPtr KP = (KPtr)((const __attribute__((address_space(4))) char*)__builtin_amdgcn_kernarg_segment_ptr() + koff_)
#define LTID() PHK(); int tid_l = threadIdx.x; asm volatile("" : "+v"(tid_l)); const int tid = tid_l, lane = tid & 63; const int wid = __builtin_amdgcn_readfirstlane(tid >> 6); (void)lane; (void)wid
    unsigned* ctl = (unsigned*)(kp.ws + WS_CTL);
    volatile LAS unsigned* xbw = (volatile LAS unsigned*)(lds + LDS_BYTES - 16);
    if (threadIdx.x == 0) { xbw[0] = 0u; xbw[1] = 0u; xbw[2] = 0u; xbw[3] = 0u; }
    __syncthreads();
    XcdBarrier bar = xcd_barrier_post(ctl + CW_BAR, xbw);
#define RUN(id) (ph_lo <= (id) && (id) < ph_hi)
#define SEAM(id) do { if (ph_lo <= (id) && (id) + 1 < ph_hi) { xcd_barrier(bar); if (DUP == 15) xcd_barrier(bar); } } while (0)

#define modv ((float*)(KP->ws + WS_MOD))
#define cosG ((float*)(KP->ws + WS_ROPE))
#define sinG (cosG + 4096 * 32)
#define cosM (cosG + 2 * 4096 * 32)
#define sinM (cosG + 2 * 4096 * 32 + 4096 * 16)
#define lrut ((float*)(KP->ws + WS_LRUT))
#define wrt ((float*)(KP->ws + WS_WRT))
#define carry ((f32x2*)(KP->ws + WS_CARRY))
#define sel ((int*)(KP->ws + WS_SEL))
#define list_tok ((int*)(KP->ws + WS_LIST))
#define list_p ((float*)(KP->ws + WS_LIST + (size_t)MAXSLOT * 4))
#define tile_exp ((int*)(KP->ws + WS_LIST + (size_t)MAXSLOT * 8))
#define ltok2 ((int*)(KP->ws + WS_L2))
#define lp2 ((float*)(KP->ws + WS_L2 + L2_N * 4))
#define lrs2 ((float*)(KP->ws + WS_L2 + L2_N * 8))
#define list_rs ((float*)(KP->ws + WS_LIST + (size_t)MAXSLOT * 8 + 2048))
#define xsc ((float*)(KP->ws + WS_XSC))
#define wb (KP->ws + WS_W)
#define Hb ((bf16_t*)KP->out)
#define H8 ((unsigned char*)KP->out + (size_t)T * 1024 * 2)
#define RS8 ((float*)((char*)KP->out + (size_t)T * 1024 * 3))
#define CMAX(l_) ((const float*)(KP->ws + WS_CTL) + CW_CMAX + (l_) * 3072)
#define CMAX2(l_) ((const float*)(KP->ws + WS_CTL) + CW_CMAX2 + (l_) * 2304)
#define CMAX3(l_) ((const float*)(KP->ws + WS_CTL) + CW_CMAX3 + (l_) * 32 * 512)
#define XB ((bf16_t*)(KP->ws + WS_H))
#define RA (KP->ws + WS_A)
#define RB (KP->ws + WS_B)
#define Ub ((bf16_t*)(RA + A_U))
#define LAB ((bf16_t*)(RA + A_LAB))
#define KM ((bf16_t*)(RA + A_KM))
#define QM ((bf16_t*)(RA + A_QM))
#define VMt ((bf16_t*)(RA + A_VMT))
#define Mb ((bf16_t*)(RB + B_CKVN))
#define GT ((bf16_t*)(RA + A_GT))
#define Y2 ((bf16_t*)(RA + A_Y2))
#define XC ((bf16_t*)(RB + B_XC))
#define GR ((bf16_t*)(RB + B_GR))
#define CKVN ((bf16_t*)(RB + B_CKVN))
#define CQN ((bf16_t*)(RB + B_CQN))
#define QG ((bf16_t*)(RB + B_QG))
#define KG ((bf16_t*)(RB + B_KG))
#define VGt ((bf16_t*)(RB + B_VGT))
#define KR ((bf16_t*)(RB + B_KR))
#define YM ((bf16_t*)(RB + B_YM))
#define YG ((bf16_t*)(RB + B_YG))
#define HE ((bf16_t*)(RB + B_HE))
#define YR ((bf16_t*)(KP->ws + WS_C))

    for (int rep_ = 0; rep_ < (DUP == 0 ? 1 + DUPN : 1); ++rep_)
    if (ON(0) && RUN(0)) { LTID();
        LAS float* sc_ = (LAS float*)lds;
        LAS float* red = sc_ + 9 * 1024;
        for (int e = tid; e < 9 * 1024; e += 512) { const int r = e >> 10, k = e & 1023; const float v = r < 8 ? KP->c[r * 1024 + k] : KP->c_ctx[k]; sc_[e] = v / (1.0f + __expf(-v)); }
        __syncthreads();
        for (int cb = bid; cb < 256; cb += G) {
            const int colg = cb * 48, l = colg / 6144, n0 = colg - l * 6144;
            const int cs = tid % 48, kg = tid / 48;
            float a[9] = {0.f, 0.f, 0.f, 0.f, 0.f, 0.f, 0.f, 0.f, 0.f};
            if (kg < 10) { const int k0 = kg * 103, k1 = (k0 + 103) < 1024 ? (k0 + 103) : 1024; const float* wp = KP->w_mod + (size_t)l * 1024 * 6144 + n0 + cs;
                for (int k = k0; k < k1; k += 8) { float w[8];
#pragma unroll
                    for (int u = 0; u < 8; ++u) w[u] = (k + u < k1) ? wp[(size_t)(k + u) * 6144] : 0.f;
#pragma unroll
                    for (int u = 0; u < 8; ++u) { const int kk = (k + u < k1) ? k + u : k;
#pragma unroll
                        for (int r = 0; r < 9; ++r) a[r] += sc_[r * 1024 + kk] * w[u]; } }
#pragma unroll
                for (int r = 0; r < 9; ++r) red[(kg * 48 + cs) * 9 + r] = a[r]; }
            __syncthreads();
            if (tid < 48 * 9) { const int c2 = tid / 9, r = tid - c2 * 9; float s = KP->b_mod[l * 6144 + n0 + c2];
                for (int g = 0; g < 10; ++g) s += red[(g * 48 + c2) * 9 + r];
                modv[((size_t)l * 9 + r) * 6144 + n0 + c2] = s; }
            __syncthreads();
        }
        { LAS float* cmx = (LAS float*)lds;
          for (int ti = bid; ti < 2 * 21 * 16; ti += G) { const int l2 = ti / 336, q = ti - l2 * 336, ns = q % 21, ks = q / 21;
              const int n = ns * 256 + 4 * lane, col = n < U_MG ? n : (n < NU ? -1 : n - (NU - U_MG));
              const float* src = KP->w_in + (size_t)l2 * 1024 * DIN + (size_t)(ks * 64 + 8 * wid) * DIN + (col < 0 ? 0 : col);
              f32x4 mx = {0.f, 0.f, 0.f, 0.f};
#pragma unroll
              for (int i = 0; i < 8; ++i) { const f32x4 v = col < 0 ? (f32x4){0.f, 0.f, 0.f, 0.f} : *(const f32x4*)(src + (size_t)i * DIN); mx[0] = fmaxf(mx[0], __builtin_fabsf(v[0])); mx[1] = fmaxf(mx[1], __builtin_fabsf(v[1])); mx[2] = fmaxf(mx[2], __builtin_fabsf(v[2])); mx[3] = fmaxf(mx[3], __builtin_fabsf(v[3])); }
              *(LAS f32x4*)(cmx + wid * 256 + 4 * lane) = mx;
              __syncthreads();
              if (tid < 256) { float m = cmx[tid];
#pragma unroll
                  for (int w = 1; w < 8; ++w) m = fmaxf(m, cmx[w * 256 + tid]);
                  atomicMax((unsigned*)(KP->ws + WS_CTL) + (ns < 9 ? CW_CMAX2 + l2 * 2304 + ns * 256 : CW_CMAX + l2 * 3072 + (ns - 9) * 256) + tid, __float_as_uint(m)); }
              __syncthreads(); }
          for (int ti = bid; ti < 2 * 32 * 2 * 16; ti += G) { const int l2 = ti >> 10, q = ti & 1023, e = q >> 5, r = q & 31, ns = r & 1, ks = r >> 1;
              const int n = ns * 256 + 4 * lane, gq = n >> 5, i = n & 31;
              const float* src = (i < 16 ? KP->moe_w1 : KP->moe_w3) + ((size_t)l2 * NEXP + e) * 1024 * 256 + (size_t)(ks * 64 + 8 * wid) * 256 + 16 * gq + (i & 15);
              f32x4 mx = {0.f, 0.f, 0.f, 0.f};
#pragma unroll
              for (int k8 = 0; k8 < 8; ++k8) { const f32x4 v = *(const f32x4*)(src + (size_t)k8 * 256); mx[0] = fmaxf(mx[0], __builtin_fabsf(v[0])); mx[1] = fmaxf(mx[1], __builtin_fabsf(v[1])); mx[2] = fmaxf(mx[2], __builtin_fabsf(v[2])); mx[3] = fmaxf(mx[3], __builtin_fabsf(v[3])); }
              *(LAS f32x4*)(cmx + wid * 256 + 4 * lane) = mx;
              __syncthreads();
              if (tid < 256) { float m = cmx[tid];
#pragma unroll
                  for (int w = 1; w < 8; ++w) m = fmaxf(m, cmx[w * 256 + tid]);
                  atomicMax((unsigned*)(KP->ws + WS_CTL) + CW_CMAX3 + (l2 * 32 + e) * 512 + ns * 256 + tid, __float_as_uint(m)); }
              __syncthreads(); } }
        for (int e = bid * 512 + tid; e < 4096 * 48; e += G * 512) {
            const int pos = e / 48, j = e - pos * 48; const float row = (float)(pos >> 6), col = (float)(pos & 63);
            if (j < 32) { const int q = j & 15; const float f = powf(10000.0f, -(float)q / 16.0f); const float ang = (j < 16 ? row : col) * f; float s, c; sincosf(ang, &s, &c); cosG[pos * 32 + j] = c; sinG[pos * 32 + j] = s; }
            else { const int jj = j - 32, q = jj & 7; const float f = powf(10000.0f, -(float)q / 8.0f); const float ang = (jj < 8 ? row : col) * f; float s, c; sincosf(ang, &s, &c); cosM[pos * 16 + jj] = c; sinM[pos * 16 + jj] = s; }
        }
        for (int e = bid * 512 + tid; e < 2 * 2 * 512; e += G * 512) { const float lam = KP->lru_lambda[e]; const float sp = (-lam > 20.f) ? -lam : log1pf(__expf(-lam)); lrut[e] = -8.0f * sp; }
        for (int e = bid * 512 + tid; e < 2 * 36 * 1024; e += G * 512) { const int l = e / (36 * 1024), r = (e / 1024) % 36, k = e & 1023;
            wrt[e] = r < 4 ? KP->moe_wg[((size_t)l * 1024 + k) * 4 + r] : KP->moe_we[((size_t)l * 1024 + k) * 32 + (r - 4)]; }
    }
    SEAM(0);

    for (int l = 0; l < NLAYER; ++l) {
        const int P0 = NPH_PRO + l * NPH_LAYER;
#define modl (modv + (size_t)l * 9 * 6144)
        unsigned* cnt = ctl + CW_CNT + l * 32 * 64;
        if (ON(1) && RUN(P0 + 0)) { LTID();
            for (int rep_ = 0; rep_ < (DUP == 1 ? 1 + DUPN : 1); ++rep_) {
            int par = 0;
            for (int ti = bid; ti < 2060; ti += G, par ^= 1) {
                LAS unsigned char* buf = lds + par * 32768;
                if (ti < 336 && ti % 21 >= 9) { const int ns = ti % 21 - 9, ks = ti / 21; const float* src = KP->w_in + (size_t)l * 1024 * DIN + (size_t)ks * 64 * DIN + U_MG + ns * 256;
                    cvt_tile_i8(buf, (unsigned char*)(wb + W_MG) + (size_t)ns * 256 * 1024 + ks * 64, 1024, tid, CMAX(l) + ns * 256, [=](int kk, int ln) -> const float* { return src + (size_t)kk * DIN + 4 * ln; });
                } else if (ti < 336) { const int ns = ti % 21, ks = ti / 21; const float* src = KP->w_in + (size_t)l * 1024 * DIN + (size_t)ks * 64 * DIN;
                    cvt_tile_i8(buf, (unsigned char*)(wb + W_IN) + (size_t)ns * 256 * 1024 + ks * 64, 1024, tid, CMAX2(l) + ns * 256, [=](int kk, int ln) -> const float* { const int n = ns * 256 + 4 * ln; return n < U_MG ? src + (size_t)kk * DIN + n : nullptr; });
                } else if (ti < 352) { const int q = ti - 336, ns = q & 3, ks = q >> 2; const float* src = KP->mla_wukv + (size_t)l * 128 * 1024 + (size_t)ks * 64 * 1024 + ns * 256;
                    if (ks < 2) cvt_tile(buf, (bf16_t*)(wb + W_UKV) + (size_t)ns * 256 * 128 + ks * 64, 128, tid, [=](int kk, int ln) -> const float* { return src + (size_t)kk * 1024 + 4 * ln; });
                } else if (ti < 364) { const int q = ti - 352, ns = q % 3, ks = q / 3; const float* src = KP->mla_wuq + (size_t)l * 256 * 768 + (size_t)ks * 64 * 768 + ns * 256;
                    cvt_tile(buf, (bf16_t*)(wb + W_UQ) + (size_t)ns * 256 * 256 + ks * 64, 256, tid, [=](int kk, int ln) -> const float* { return src + (size_t)kk * 768 + 4 * ln; });
                } else if (ti < 460) { const int q = ti - 364, br = q >> 5, r = q & 31, ns = r & 3, ks = r >> 2; const float* src = KP->w_branch + ((size_t)l * 3 + br) * 512 * 1024 + (size_t)ks * 64 * 1024 + ns * 256;
                    cvt_tile(buf, (bf16_t*)(wb + W_BR) + (size_t)br * 1024 * 512 + (size_t)ns * 256 * 512 + ks * 64, 512, tid, [=](int kk, int ln) -> const float* { return src + (size_t)kk * 1024 + 4 * ln; });
                } else if (ti < 524) { const int q = ti - 460, ns = q & 3, ks = q >> 2; const float* src = KP->w_out + (size_t)l * 1024 * 1024 + (size_t)ks * 64 * 1024 + ns * 256;
                    cvt_tile(buf, (bf16_t*)(wb + W_OUT) + (size_t)ns * 256 * 1024 + ks * 64, 1024, tid, [=](int kk, int ln) -> const float* { return src + (size_t)kk * 1024 + 4 * ln; });
                } else if (ti < 1548) { const int q = ti - 524, e = q >> 5, r = q & 31, ns = r & 1, ks = r >> 1;
                    const float* s1 = KP->moe_w1 + ((size_t)l * NEXP + e) * 1024 * 256 + (size_t)ks * 64 * 256; const float* s3 = KP->moe_w3 + ((size_t)l * NEXP + e) * 1024 * 256 + (size_t)ks * 64 * 256;
                    cvt_tile_i8(buf, (unsigned char*)(wb + W_13) + (size_t)e * 512 * 1024 + (size_t)ns * 256 * 1024 + ks * 64, 1024, tid, CMAX3(l) + e * 512 + ns * 256, [=](int kk, int ln) -> const float* { const int n = ns * 256 + 4 * ln, g = n >> 5, i = n & 31; return (i < 16 ? s1 : s3) + (size_t)kk * 256 + 16 * g + (i & 15); });
                } else { const int q = ti - 1548, e = q >> 4, r = q & 15, ns = r & 3, ks = r >> 2; const float* src = KP->moe_w2 + ((size_t)l * NEXP + e) * 256 * 1024 + (size_t)ks * 64 * 1024 + ns * 256;
                    cvt_tile(buf, (bf16_t*)(wb + W_2T) + (size_t)e * 1024 * 256 + (size_t)ns * 256 * 256 + ks * 64, 256, tid, [=](int kk, int ln) -> const float* { return src + (size_t)kk * 1024 + 4 * ln; });
                }
            }
            __syncthreads();
            for (int e = bid * 512 + tid; e < 8 * 256 * 128; e += G * 512) {
                const int pn = e >> 15, r = (e >> 7) & 255, k = e & 127; const int g = 2 * (r >> 7) + ((r >> 4) & 1), cl = 16 * ((r >> 5) & 3) + (r & 15), dir = g >> 1; float v = 0.f;
                if ((k >> 6) == (pn & 1)) { const float* w = (g & 1) ? KP->lru_wi : KP->lru_wa; v = w[((((size_t)l * 2 + dir) * 8 + pn) * 64 + (k & 63)) * 64 + cl]; }
                ((bf16_t*)(wb + W_G))[e] = f2bf(v * -LOG2E_);
            }
            }
            for (int rep2_ = 0; rep2_ < ((DUP == 20 && l == 0) ? 2 : 1); ++rep2_) {
            f32x4 gmx[4];
#pragma unroll
            for (int j = 0; j < 4; ++j) gmx[j] = *(const f32x4*)(KP->g_mix + (size_t)l * 1024 + (j * 64 + lane) * 4);
            for (int bb = bid; bb < T / 136; bb += G) {
                f32x4 L_v[4]; u32x2 L_xb[4], L_ya[4], L_yb[4]; f32x4 m_sc[4], m_sh[4], m_gf[4]; int cur_mr = -1;
#pragma unroll
                for (int j = 0; j < 4; ++j) { L_v[j] = (f32x4){0.f, 0.f, 0.f, 0.f}; L_xb[j] = (u32x2){0u, 0u}; L_ya[j] = (u32x2){0u, 0u}; L_yb[j] = (u32x2){0u, 0u}; m_sc[j] = m_sh[j] = m_gf[j] = (f32x4){0.f, 0.f, 0.f, 0.f}; }
#define N1_ISSUE(TT) do { const int t_ = (TT); const int b_ = t_ / TPB, n_ = t_ - b_ * TPB; \
                    if (l == 0) { const float* src_ = n_ < NCTX ? KP->ctx + ((size_t)b_ * NCTX + n_) * DM : KP->x + ((size_t)b_ * SEQ + (n_ - NCTX)) * DM; \
                        _Pragma("unroll") for (int j = 0; j < 4; ++j) L_v[j] = *(const f32x4*)(src_ + (j * 64 + lane) * 4); } \
                    else { const bf16_t* x_ = XB + (size_t)t_ * 1024; const bf16_t* y_ = Y2 + (size_t)t_ * 2048; _Pragma("unroll") for (int j = 0; j < 4; ++j) { L_xb[j] = *(const u32x2*)(x_ + (j * 64 + lane) * 4); L_ya[j] = *(const u32x2*)(y_ + (j * 64 + lane) * 4); L_yb[j] = *(const u32x2*)(y_ + 1024 + (j * 64 + lane) * 4); } } } while (0)
                N1_ISSUE(bb * 136 + wid);
                for (int it = 0; it < 17; ++it) {
                    const int t = bb * 136 + it * 8 + wid; const int b = t / TPB, n = t - b * TPB; const int mr = n < NCTX ? 8 : b;
                    f32x4 v[4]; u32x2 ya[4], yb[4];
#pragma unroll
                    for (int j = 0; j < 4; ++j) { v[j] = l == 0 ? L_v[j] : unpack4(L_xb[j]); ya[j] = L_ya[j]; yb[j] = L_yb[j]; }
                    if (it + 1 < 17) N1_ISSUE(t + 8);
                    if (mr != cur_mr) { cur_mr = mr; const float* sh = modl + (size_t)mr * 6144; const float* gf = modv + ((size_t)(l > 0 ? l - 1 : 0) * 9 + mr) * 6144 + 5120;
#pragma unroll
                        for (int j = 0; j < 4; ++j) { const int col = (j * 64 + lane) * 4; m_sh[j] = *(const f32x4*)(sh + col); m_sc[j] = *(const f32x4*)(sh + 1024 + col) + 1.0f; m_gf[j] = *(const f32x4*)(gf + col); } }
                    __builtin_amdgcn_sched_barrier(0);
                    if (l != 0 && !(ABL == 7 && n < NCTX)) {
#pragma unroll
                        for (int j = 0; j < 4; ++j) { f32x4 xv = v[j]; const f32x4 g = m_gf[j]; const u32x2 a = ya[j], bq = yb[j];
                            xv[0] += g[0] * (__uint_as_float(a.x << 16) + __uint_as_float(bq.x << 16)); xv[1] += g[1] * (__uint_as_float(a.x & 0xffff0000u) + __uint_as_float(bq.x & 0xffff0000u));
                            xv[2] += g[2] * (__uint_as_float(a.y << 16) + __uint_as_float(bq.y << 16)); xv[3] += g[3] * (__uint_as_float(a.y & 0xffff0000u) + __uint_as_float(bq.y & 0xffff0000u));
                            v[j] = xv; } }
                    if (l != 0) {
#pragma unroll
                        for (int j = 0; j < 4; ++j) *(u32x2*)(XB + (size_t)t * 1024 + (j * 64 + lane) * 4) = pack4(v[j]); }
                    float ss = 0.f;
#pragma unroll
                    for (int j = 0; j < 4; ++j) ss += v[j][0] * v[j][0] + v[j][1] * v[j][1] + v[j][2] * v[j][2] + v[j][3] * v[j][3];
                    ss = wave_sum(ss); const float rstd = rsqrtf(ss * (1.0f / 1024.0f) + 1e-6f);
#pragma unroll
                    for (int j = 0; j < 4; ++j) { const int col = (j * 64 + lane) * 4;
                        const f32x4 h = v[j] * rstd * gmx[j] * m_sc[j] + m_sh[j]; v[j] = h; (void)col; }
                    {
                        float am = 0.f;
#pragma unroll
                        for (int j = 0; j < 4; ++j) am = fmaxf(fmaxf(am, fmaxf(__builtin_fabsf(v[j][0]), __builtin_fabsf(v[j][1]))), fmaxf(__builtin_fabsf(v[j][2]), __builtin_fabsf(v[j][3])));
                        am = fmaxf(wave_max_nn(am), 1e-30f); const float sc = 127.0f / am;
#pragma unroll
                        for (int j = 0; j < 4; ++j) *(unsigned*)(H8 + (size_t)t * 1024 + (j * 64 + lane) * 4) = pack_i8x4(v[j][0], v[j][1], v[j][2], v[j][3], sc);
                        if (lane == 0) RS8[t] = am * (1.0f / 127.0f);
                    }
                }
#undef N1_ISSUE
            }
            }
        }
        SEAM(P0 + 0);
        for (int rep_ = 0; rep_ < (DUP == 2 ? 1 + DUPN : 1); ++rep_)
        if (ON(2) && RUN(P0 + 1)) { PHK();
            SchedHG S{(const char*)H8, wb + W_IN, T / 256, G, bid, l == NLAYER - 1};
            EpiHG E{EpiBf16I8{Ub, NU, RS8, CMAX2(l)}, EpiGateI8{(unsigned char*)KP->out, (unsigned char*)(KP->ws + WS_G2), RS8, CMAX(l)}};
            g8::gemm_phase(lds, S, E);
        }
        SEAM(P0 + 1);
        for (int rep_ = 0; rep_ < (DUP == 3 ? 1 + DUPN : 1); ++rep_)
        if (ON(3) && RUN(P0 + 2)) { LTID();
            f32x4 cwv[4][2]; f32x4 cbv[2];
            { const float* cw = KP->conv_w + (size_t)l * 4 * 512 + lane * 8; const float* cbias = KP->conv_b + (size_t)l * 512 + lane * 8;
#pragma unroll
              for (int k = 0; k < 4; ++k) { cwv[k][0] = *(const f32x4*)(cw + k * 512); cwv[k][1] = *(const f32x4*)(cw + k * 512 + 4); }
              cbv[0] = *(const f32x4*)cbias; cbv[1] = *(const f32x4*)(cbias + 4); }
            const f32x2 gkv2 = *(const f32x2*)(KP->mla_gkv + (size_t)l * 128 + lane * 2);
            const f32x4 gqm4 = *(const f32x4*)(KP->mla_gq + (size_t)l * 256 + lane * 4);
            const int qa = lane & 7, qh = lane >> 3;
            const f32x4 ggqA = *(const f32x4*)(KP->gqa_gq + (size_t)l * 64 + qa * 4), ggqB = *(const f32x4*)(KP->gqa_gq + (size_t)l * 64 + 32 + qa * 4);
            const int ki = lane & 15, kh = (lane >> 4) & 1;
            const f32x2 ggkA = *(const f32x2*)(KP->gqa_gk + (size_t)l * 64 + ki * 2), ggkB = *(const f32x2*)(KP->gqa_gk + (size_t)l * 64 + 32 + ki * 2);
            LAS bf16_t* vst = (LAS bf16_t*)lds;
            constexpr int VSTP = 138;
            for (int bb = bid; bb < T / 136; bb += G) {
            __syncthreads();
            u32x4 L_xr[4], L_rg; unsigned L_ckv, L_gka, L_gkb, L_gv; u32x2 L_cq, L_gqa, L_gqb; bf16_t L_kr1, L_kr2; f32x4 L_qc, L_qs; f32x2 L_kc, L_ks; float L_rc, L_rs;
#define P3_ISSUE(TT) do { const int t_ = (TT); const int b_ = t_ / TPB, n_ = t_ - b_ * TPB; const bool ic_ = n_ < NCTX; const int s0_ = ic_ ? 0 : NCTX, s1_ = ic_ ? NCTX : TPB; \
                const int pp_ = ic_ ? 0 : n_ - NCTX; const bf16_t* ur_ = Ub + (size_t)t_ * NU; \
                _Pragma("unroll") for (int k = 0; k < 4; ++k) { const int nn = n_ + k - 2; L_xr[k] = (nn >= s0_ && nn < s1_) ? *(const u32x4*)(ur_ + (ptrdiff_t)(k - 2) * NU + U_XR + lane * 8) : (u32x4){0u, 0u, 0u, 0u}; } \
                L_rg = *(const u32x4*)(ur_ + U_RG + lane * 8); L_ckv = *(const unsigned*)(ur_ + U_CKV + lane * 2); L_cq = *(const u32x2*)(ur_ + U_CQ + lane * 4); \
                L_kr1 = ur_[U_KR + ki]; L_kr2 = ur_[U_KR + 16 + ki]; L_gka = *(const unsigned*)(ur_ + U_GK + kh * 64 + ki * 2); L_gkb = *(const unsigned*)(ur_ + U_GK + kh * 64 + 32 + ki * 2); \
                L_gv = *(const unsigned*)(ur_ + U_GV + lane * 2); L_gqa = *(const u32x2*)(ur_ + U_GQ + qh * 64 + qa * 4); L_gqb = *(const u32x2*)(ur_ + U_GQ + qh * 64 + 32 + qa * 4); \
                L_qc = *(const f32x4*)(cosG + pp_ * 32 + qa * 4); L_qs = *(const f32x4*)(sinG + pp_ * 32 + qa * 4); L_kc = *(const f32x2*)(cosG + pp_ * 32 + ki * 2); L_ks = *(const f32x2*)(sinG + pp_ * 32 + ki * 2); \
                L_rc = cosM[pp_ * 16 + ki]; L_rs = sinM[pp_ * 16 + ki]; } while (0)
            P3_ISSUE(bb * 136 + wid);
            for (int it = 0; it < 17; ++it) {
                const int tl = it * 8 + wid; const int t = bb * 136 + tl;
                const int b = t / TPB, n = t - b * TPB; const bool isctx = n < NCTX;
                u32x4 xr4[4]; xr4[0] = L_xr[0]; xr4[1] = L_xr[1]; xr4[2] = L_xr[2]; xr4[3] = L_xr[3];
                const u32x4 rg4 = L_rg; const unsigned ckvw = L_ckv, gka = L_gka, gkb = L_gkb, gvw = L_gv; const u32x2 cqw = L_cq, gqa_ = L_gqa, gqb_ = L_gqb; const bf16_t kr1 = L_kr1, kr2 = L_kr2;
                const f32x4 qc = L_qc, qs = L_qs; const f32x2 kc = L_kc, ks = L_ks; const float rc = L_rc, rs_ = L_rs;
                if (it + 1 < 17) P3_ISSUE(t + 8);
                __builtin_amdgcn_sched_barrier(0);
                { f32x4 a0 = cbv[0], a1 = cbv[1];
#pragma unroll
                  for (int k = 0; k < 4; ++k) { float xv[8]; unpack8(xr4[k], xv); a0 += cwv[k][0] * (f32x4){xv[0], xv[1], xv[2], xv[3]}; a1 += cwv[k][1] * (f32x4){xv[4], xv[5], xv[6], xv[7]}; }
                  const float a[8] = {a0[0], a0[1], a0[2], a0[3], a1[0], a1[1], a1[2], a1[3]};
                  *(u32x4*)(XC + (size_t)t * 512 + lane * 8) = pack8(a); }
                { float xv[8]; unpack8(rg4, xv);
#pragma unroll
                  for (int j = 0; j < 8; ++j) xv[j] = gelu_tanh(xv[j]);
                  *(u32x4*)(GR + (size_t)t * 512 + lane * 8) = pack8(xv); }
                { const float x0 = __uint_as_float(ckvw << 16), x1 = __uint_as_float(ckvw & 0xffff0000u);
                  const float ss = wave_sum(x0 * x0 + x1 * x1); const float rs = rsqrtf(ss * (1.0f / 128.0f) + 1e-6f);
                  *(unsigned*)(CKVN + (size_t)t * 128 + lane * 2) = cvt_pk_bf16(x0 * rs * gkv2.x, x1 * rs * gkv2.y); }
                { const float x0 = __uint_as_float(cqw.x << 16), x1 = __uint_as_float(cqw.x & 0xffff0000u), x2 = __uint_as_float(cqw.y << 16), x3 = __uint_as_float(cqw.y & 0xffff0000u);
                  const float ss = wave_sum(x0 * x0 + x1 * x1 + x2 * x2 + x3 * x3); const float rs = rsqrtf(ss * (1.0f / 256.0f) + 1e-6f);
                  u32x2 o; o.x = cvt_pk_bf16(x0 * rs * gqm4[0], x1 * rs * gqm4[1]); o.y = cvt_pk_bf16(x2 * rs * gqm4[2], x3 * rs * gqm4[3]);
                  *(u32x2*)(CQN + (size_t)t * 256 + lane * 4) = o; }
                { float x1 = bf2f(kr1), x2 = bf2f(kr2);
                  if (ABL != 5 && !isctx) { const float o1 = x1 * rc - x2 * rs_, o2 = x1 * rs_ + x2 * rc; x1 = o1; x2 = o2; }
                  if (lane < 16) { KR[(size_t)t * 32 + lane] = f2bf(x1); KR[(size_t)t * 32 + 16 + lane] = f2bf(x2); } }
                { float a0 = __uint_as_float(gka << 16), a1 = __uint_as_float(gka & 0xffff0000u), b0 = __uint_as_float(gkb << 16), b1 = __uint_as_float(gkb & 0xffff0000u);
                  const float ss = red16(a0 * a0 + a1 * a1 + b0 * b0 + b1 * b1); const float rs = rsqrtf(ss * (1.0f / 64.0f) + 1e-6f);
                  a0 *= rs * ggkA.x; a1 *= rs * ggkA.y; b0 *= rs * ggkB.x; b1 *= rs * ggkB.y;
                  if (ABL != 5 && !isctx) { const float o0 = a0 * kc.x - b0 * ks.x, o1 = a1 * kc.y - b1 * ks.y, o2 = a0 * ks.x + b0 * kc.x, o3 = a1 * ks.y + b1 * kc.y; a0 = o0; a1 = o1; b0 = o2; b1 = o3; }
                  if (lane < 32) { bf16_t* kp = KG + (((size_t)b * 2 + kh) * TPB + n) * 64; *(unsigned*)(kp + ki * 2) = cvt_pk_bf16(a0, a1); *(unsigned*)(kp + 32 + ki * 2) = cvt_pk_bf16(b0, b1); } }
                { vst[(lane * 2) * VSTP + tl] = (bf16_t)(gvw & 0xffffu); vst[(lane * 2 + 1) * VSTP + tl] = (bf16_t)(gvw >> 16); }
                { f32x4 xA = {__uint_as_float(gqa_.x << 16), __uint_as_float(gqa_.x & 0xffff0000u), __uint_as_float(gqa_.y << 16), __uint_as_float(gqa_.y & 0xffff0000u)};
                  f32x4 xB = {__uint_as_float(gqb_.x << 16), __uint_as_float(gqb_.x & 0xffff0000u), __uint_as_float(gqb_.y << 16), __uint_as_float(gqb_.y & 0xffff0000u)};
                  const f32x4 sq = xA * xA + xB * xB; const float ss = red8((sq[0] + sq[1]) + (sq[2] + sq[3])); const float rs = rsqrtf(ss * (1.0f / 64.0f) + 1e-6f);
                  xA = xA * rs * ggqA; xB = xB * rs * ggqB;
                  if (ABL != 5 && !isctx) { const f32x4 oA = xA * qc - xB * qs, oB = xA * qs + xB * qc; xA = oA; xB = oB; }
                  xA = xA * QSCALE_G; xB = xB * QSCALE_G;
                  bf16_t* qp = QG + (((size_t)b * 8 + qh) * TPB + n) * 64; u32x2 oa, ob; oa.x = cvt_pk_bf16(xA[0], xA[1]); oa.y = cvt_pk_bf16(xA[2], xA[3]); ob.x = cvt_pk_bf16(xB[0], xB[1]); ob.y = cvt_pk_bf16(xB[2], xB[3]);
                  *(u32x2*)(qp + qa * 4) = oa; *(u32x2*)(qp + 32 + qa * 4) = ob; }
            }
#undef P3_ISSUE
            __syncthreads();
            { const int b = (bb * 136) / TPB, n0 = bb * 136 - b * TPB;
#pragma unroll 4
              for (int r = 0; r < 16; ++r) { const int row = wid * 16 + r; bf16_t* gp = VGt + (((size_t)b * 2 + (row >> 6)) * 64 + (row & 63)) * TPB + n0;
                  *(unsigned*)(gp + lane * 2) = *(const LAS unsigned*)(vst + row * VSTP + lane * 2);
                  if (lane < 4) *(unsigned*)(gp + 128 + lane * 2) = *(const LAS unsigned*)(vst + row * VSTP + 128 + lane * 2); } }
            }
        }
        SEAM(P0 + 2);
        for (int rep_ = 0; rep_ < (DUP == 4 ? 1 + DUPN : 1); ++rep_)
        if (ON(4) && RUN(P0 + 3)) { PHK();
            SchedGate S{(const char*)XC, wb + W_G, T / 256, G, bid};
            EpiGate E{XC, LAB, KP->lru_ba + (size_t)l * 1024, KP->lru_bi + (size_t)l * 1024, lrut + (size_t)l * 1024};
            g8::gemm_phase(lds, S, E);
        }
        SEAM(P0 + 3);
        for (int rep_ = 0; rep_ < (DUP == 5 ? 1 + DUPN : 1); ++rep_)
        if (ON(5) && RUN(P0 + 4)) { LTID();
            for (int it = bid; it < NB_ * NCHUNK; it += G) {
                const int b = it / NCHUNK, j = it - b * NCHUNK; const int c = tid;
                const char* ub = (const char*)(LAB + ((size_t)b * TPB + (size_t)j * 64) * 2048); const unsigned lo = (unsigned)c * 8u;
                u32x2 w[64];
                { const __amdgpu_buffer_rsrc_t rs = BUF_RSRC(ub);
#pragma unroll
                  for (int s = 0; s < 64; ++s) w[s] = __builtin_amdgcn_raw_buffer_load_b64(rs, lo, s * 4096, 0); }
                __builtin_amdgcn_sched_barrier(0);
                float Pf = 1.f, Hf = 0.f, Pb = 1.f, Hb_ = 0.f;
#pragma unroll
                for (int s = 0; s < 64; ++s) { const float af = __expf(__uint_as_float(w[s].x << 16)); Hf = af * Hf + __uint_as_float(w[s].x & 0xffff0000u); Pf *= af; }
#pragma unroll
                for (int s = 63; s >= 0; --s) { const float ab = __expf(__uint_as_float(w[s].y << 16)); Hb_ = ab * Hb_ + __uint_as_float(w[s].y & 0xffff0000u); Pb *= ab; }
                __builtin_amdgcn_sched_barrier(0);
                carry[(((size_t)b * NCHUNK + j) * 2 + 0) * 512 + c] = (f32x2){Pf, Hf};
                carry[(((size_t)b * NCHUNK + j) * 2 + 1) * 512 + c] = (f32x2){Pb, Hb_};
            }
        }
        SEAM(P0 + 4);
        for (int rep_ = 0; rep_ < (DUP == 6 ? 1 + DUPN : 1); ++rep_)
        if (ON(6) && RUN(P0 + 5)) { LTID();
            for (int it = bid; it < NB_ * NCHUNK; it += G) {
                const int b = it / NCHUNK, j = it - b * NCHUNK; const int c = tid;
                if (l == NLAYER - 1 && j < 4) continue;
                const __amdgpu_buffer_rsrc_t crs = BUF_RSRC(carry + (size_t)b * NCHUNK * 2 * 512); const unsigned clo = (unsigned)c * 8u;
                float cf = 0.f, cbk = 0.f;
                const int pf = j, pb = j < 4 ? 3 - j : 71 - j;
#pragma unroll
                for (int hb = 0; hb < 2; ++hb) {
                    u32x2 vf[34], vb[34];
#pragma unroll
                    for (int q = 0; q < 34; ++q) { const int qq = hb * 34 + q; const int ib = qq < 4 ? 3 - qq : 71 - qq;
                        vf[q] = __builtin_amdgcn_raw_buffer_load_b64(crs, clo, (qq * 2 + 0) * 4096, 0); vb[q] = __builtin_amdgcn_raw_buffer_load_b64(crs, clo, (ib * 2 + 1) * 4096, 0); }
                    __builtin_amdgcn_sched_barrier(0);
#pragma unroll
                    for (int q = 0; q < 34; ++q) { const int qq = hb * 34 + q;
                        if (qq < pf) cf = __uint_as_float(vf[q].x) * cf + __uint_as_float(vf[q].y);
                        if (qq < pb) cbk = __uint_as_float(vb[q].x) * cbk + __uint_as_float(vb[q].y); }
                }
                const size_t t0 = (size_t)b * TPB + (size_t)j * 64;
                const char* ub = (const char*)(LAB + t0 * 2048); const unsigned lo = (unsigned)c * 8u, lo2 = (unsigned)c * 2u;
                const char* gb = (const char*)(GR + t0 * 512); char* yb = (char*)(YR + t0 * 512);
                __builtin_amdgcn_sched_barrier(0);
                u32x2 w[64];
                { const __amdgpu_buffer_rsrc_t rs = BUF_RSRC(ub);
#pragma unroll
                  for (int s = 0; s < 64; ++s) w[s] = __builtin_amdgcn_raw_buffer_load_b64(rs, lo, s * 4096, 0); }
                __builtin_amdgcn_sched_barrier(0);
#pragma unroll
                for (int s = 0; s < 64; ++s) { cf = __expf(__uint_as_float(w[s].x << 16)) * cf + __uint_as_float(w[s].x & 0xffff0000u); w[s].x = __float_as_uint(cf); }
                bf16_t ga[16], gn[16];
#pragma unroll
                for (int s = 0; s < 16; ++s) ga[s] = *(const bf16_t*)(gb + (size_t)(48 + s) * 1024 + lo2);
#pragma unroll
                for (int k = 3; k >= 0; --k) {
                    if (k > 0) {
#pragma unroll
                        for (int s = 0; s < 16; ++s) gn[s] = *(const bf16_t*)(gb + (size_t)((k - 1) * 16 + s) * 1024 + lo2); }
                    __builtin_amdgcn_sched_barrier(0);
#pragma unroll
                    for (int s = 15; s >= 0; --s) { const int ss = k * 16 + s; cbk = __expf(__uint_as_float(w[ss].y << 16)) * cbk + __uint_as_float(w[ss].y & 0xffff0000u);
                        *(bf16_t*)(yb + (size_t)ss * 1024 + lo2) = f2bf(ABL == 2 ? 0.f : (__uint_as_float(w[ss].x) + cbk) * bf2f(ga[s])); }
#pragma unroll
                    for (int s = 0; s < 16; ++s) ga[s] = gn[s];
                }
            }
        }
        SEAM(P0 + 5);
        for (int rep_ = 0; rep_ < (DUP == 7 ? 1 + DUPN : 1); ++rep_)
        if (ON(7) && RUN(P0 + 6)) { PHK();
            SchedUp S{(const char*)CKVN, wb + W_UKV, (const char*)CQN, wb + W_UQ, T / 256, G, bid, l == NLAYER - 1};
            EpiUp E{EpiUkv{KM, VMt}, EpiUq{QM, cosM, sinM}};
            g8::gemm_phase(lds, S, E);
        }
        SEAM(P0 + 6);
        for (int rep_ = 0; rep_ < ((DUP == 8 || DUP == 23 || DUP == 24) ? 1 + DUPN : 1); ++rep_)
        if (ON(8) && RUN(P0 + 7)) { LTID();
            const int ng = NB_ * 8 * 8, nm = NB_ * 8 * 8, nall = ng + nm + (l == NLAYER - 1 ? 0 : 2 * NB_ * 8);
            for (int it = (DUP == 24 && rep_) ? ng + bid : bid; it < ((DUP == 23 && rep_) ? ng : (DUP == 24 && rep_) ? ng + nm : nall); it += G) {
                if (it < ng) {
                    int u = it; const int qb = u >> 6; u &= 63; const int h = u & 7, b = u >> 3; const size_t bh = (size_t)b * 8 + h, bk = (size_t)b * 2 + (h >> 2); const size_t n0 = NCTX + (size_t)qb * 512;
                    attn_run<64, 2, 4>(lds, QG + (bh * TPB + n0) * 64, KG + bk * TPB * 64, nullptr, VGt + bk * 64 * TPB, TPB, YG + ((size_t)b * TPB + n0) * 512 + h * 64);
                } else if (it < ng + nm) {
                    int u = it - ng; const int qb = u >> 6; u &= 63; const int h = u & 7, b = u >> 3; const size_t bh = (size_t)b * 8 + h; const size_t n0 = NCTX + (size_t)qb * 512;
                    attn_run<96, 2, 2>(lds, QM + (bh * TPB + n0) * 96, KM + bh * TPB * 64, KR + (size_t)b * TPB * 32, VMt + bh * 64 * TPB, TPB, YM + ((size_t)b * TPB + n0) * 512 + h * 64);
                } else {
                    int u = it - ng - nm; const int kind = u & 1; u >>= 1; const int h = u & 7, b = u >> 3; const size_t bh = (size_t)b * 8 + h;
                    if (kind == 0) attn_run<96, 1, 2>(lds, QM + (bh * TPB) * 96, KM + bh * TPB * 64, KR + (size_t)b * TPB * 32, VMt + bh * 64 * TPB, NCTX, YM + ((size_t)b * TPB) * 512 + h * 64);
                    else { const size_t bk = (size_t)b * 2 + (h >> 2); attn_run<64, 1, 2>(lds, QG + (bh * TPB) * 64, KG + bk * TPB * 64, nullptr, VGt + bk * 64 * TPB, NCTX, YG + ((size_t)b * TPB) * 512 + h * 64); }
                }
            }
        }
        SEAM(P0 + 7);
        for (int rep_ = 0; rep_ < (DUP == 9 ? 1 + DUPN : 1); ++rep_)
        if (ON(9) && RUN(P0 + 9)) { PHK();
            SchedMerge S{(const char*)KP->ws, wb + W_BR, T / 256, G, bid, l == NLAYER - 1};
            EpiMerge E{Mb, (const unsigned char*)KP->out, (const unsigned char*)(KP->ws + WS_G2)};
            g8::gemm_phase(lds, S, E);
        }
        SEAM(P0 + 9);
        for (int rep_ = 0; rep_ < (DUP == 10 ? 1 + DUPN : 1); ++rep_)
        if (ON(10) && RUN(P0 + 10)) { PHK();
            SchedDense S{(const char*)Mb, wb + W_OUT, 1024, T / 256, 4, G, bid, l == NLAYER - 1}; EpiOut E{rep_ ? (bf16_t*)RA : XB, l == 0 ? KP->x : (const float*)nullptr, l == 0 ? KP->ctx : (const float*)nullptr, modl};
            g8::gemm_phase(lds, S, E);
        }
        SEAM(P0 + 10);
        for (int rep_ = 0; rep_ < (DUP == 11 ? 1 + DUPN : 1); ++rep_)
        if (ON(11) && RUN(P0 + 11)) { LTID();
            LAS float* wl = (LAS float*)lds;
            LAS float* gml = wl + 36 * 1024;
            LAS float* shl = gml + 1024;
            LAS unsigned* lcn = (LAS unsigned*)(shl + 1024);
            LAS int* lsel = (LAS int*)(lcn + 64);
            if (tid < 64) lcn[tid] = 0u;
#define R_PERM(ch) ((((ch) >> 5) * 2 + ((ch) & 1)) * 64 + (((ch) >> 1) & 15) * 4)
            { const float* src = wrt + (size_t)l * 36 * 1024; for (int e = tid; e < 36 * 1024 / 4; e += 512) *(LAS f32x4*)(wl + (e >> 8) * 1024 + R_PERM(e & 255)) = *(const f32x4*)(src + e * 4); }
            const float* bg = KP->moe_bg + l * 4; const float* be = KP->moe_be + l * 32;
            const float* gfp = KP->g_ffn + (size_t)l * 1024;
            const int row = lane >> 4, li = lane & 15;
            for (int bb = bid; bb < T / 136; bb += G) {
            const int mr_main = ((bb * 136) % TPB) < NCTX ? 8 : (bb * 136) / TPB;
            u32x4 L_x[8];
#define R_ISSUE(PP) do { const int g_ = wid + 8 * (PP); const bf16_t* xr_ = XB + (size_t)(bb * 136 + 4 * (g_ < 34 ? g_ : 33) + row) * 1024 + li * 8; _Pragma("unroll") for (int q = 0; q < 8; ++q) L_x[q] = *(const u32x4*)(xr_ + q * 128); } while (0)
            R_ISSUE(0);
            if (tid < 256) { const float* shm = modl + (size_t)mr_main * 6144 + 3072 + tid * 4;
                *(LAS f32x4*)(gml + R_PERM(tid)) = *(const f32x4*)(gfp + tid * 4) * (*(const f32x4*)(shm + 1024) + 1.0f); *(LAS f32x4*)(shl + R_PERM(tid)) = *(const f32x4*)shm; }
            __syncthreads();
            const int npass = wid < 2 ? 5 : 4;
            for (int p = 0; p < npass; ++p) {
                const int kc = 4 * (wid + 8 * p) + row; const int t = bb * 136 + kc;
                const int b = t / TPB, n = t - b * TPB; const int mr = n < NCTX ? 8 : b;
                const bool act = !(l == NLAYER - 1 && n < NCTX);
                f32x4 h[16];
#pragma unroll
                for (int q = 0; q < 8; ++q) { h[2 * q] = unpack4((u32x2){L_x[q].x, L_x[q].y}); h[2 * q + 1] = unpack4((u32x2){L_x[q].z, L_x[q].w}); }
                if (p + 1 < npass) R_ISSUE(p + 1);
                __builtin_amdgcn_sched_barrier(0);
                f32x4 s4 = h[0] * h[0];
#pragma unroll
                for (int q = 1; q < 16; ++q) s4 = __builtin_elementwise_fma(h[q], h[q], s4);
                const float ss = red16((s4[0] + s4[1]) + (s4[2] + s4[3])); const float rstd = rsqrtf(ss * (1.0f / 1024.0f) + 1e-6f);
                f32x4 am4 = {0.f, 0.f, 0.f, 0.f};
                if (!__any(mr != mr_main)) {
#pragma unroll
                    for (int q = 0; q < 16; ++q) { h[q] = __builtin_elementwise_fma(h[q] * rstd, *(const LAS f32x4*)(gml + q * 64 + li * 4), *(const LAS f32x4*)(shl + q * 64 + li * 4));
                        am4 = __builtin_elementwise_max(am4, __builtin_elementwise_abs(h[q])); }
                } else {
                    const float* shp = modl + (size_t)mr * 6144 + 3072;
#pragma unroll
                    for (int q = 0; q < 16; ++q) { const int cb = (q >> 1) * 128 + li * 8 + (q & 1) * 4; const f32x4 g4 = *(const f32x4*)(gfp + cb), sh4 = *(const f32x4*)(shp + cb), sc4 = *(const f32x4*)(shp + 1024 + cb) + 1.0f;
                        h[q] = __builtin_elementwise_fma(h[q] * rstd, g4 * sc4, sh4);
                        am4 = __builtin_elementwise_max(am4, __builtin_elementwise_abs(h[q])); }
                }
                {
                    float am = fmaxf(fmaxf(am4[0], am4[1]), fmaxf(am4[2], am4[3]));
                    am = fmaxf(am, dpp_f<0xB1>(am)); am = fmaxf(am, dpp_f<0x4E>(am)); am = fmaxf(am, dpp_f<0x141>(am)); am = fmaxf(am, dpp_f<0x140>(am));
                    am = fmaxf(am, 1e-30f); const float sc = 127.0f / am;
                    if (act) {
#pragma unroll
                        for (int q = 0; q < 8; ++q) *(u32x2*)(H8 + (size_t)t * 1024 + q * 128 + li * 8) = (u32x2){pack_i8x4(h[2 * q][0], h[2 * q][1], h[2 * q][2], h[2 * q][3], sc), pack_i8x4(h[2 * q + 1][0], h[2 * q + 1][1], h[2 * q + 1][2], h[2 * q + 1][3], sc)};
                        if (li == 0) { RS8[t] = am * (1.0f / 127.0f); lsel[kc * 7 + 6] = (int)__float_as_uint(am * (1.0f / 127.0f)); } }
                }
                float gl[4];
#pragma unroll
                for (int g = 0; g < 4; ++g) { const LAS float* wrow = wl + g * 1024 + li * 4; f32x4 wv[16];
#pragma unroll
                    for (int q = 0; q < 16; ++q) wv[q] = *(const LAS f32x4*)(wrow + q * 64);
                    __builtin_amdgcn_sched_barrier(0);
                    f32x4 a4 = h[0] * wv[0];
#pragma unroll
                    for (int q = 1; q < 16; ++q) a4 = __builtin_elementwise_fma(h[q], wv[q], a4);
                    gl[g] = (a4[0] + a4[1]) + (a4[2] + a4[3]); }
#pragma unroll
                for (int st = 0; st < 4; ++st)
#pragma unroll
                    for (int g = 0; g < 4; ++g) gl[g] += st == 0 ? dpp_f<0xB1>(gl[g]) : st == 1 ? dpp_f<0x4E>(gl[g]) : st == 2 ? dpp_f<0x141>(gl[g]) : dpp_f<0x140>(gl[g]);
#pragma unroll
                for (int g = 0; g < 4; ++g) gl[g] += bg[g];
                int gs = 0; float gm = gl[0];
#pragma unroll
                for (int g = 1; g < 4; ++g) if (gl[g] > gm) { gm = gl[g]; gs = g; }
                float den = 0.f;
#pragma unroll
                for (int g = 0; g < 4; ++g) den += __expf(gl[g] - gm);
                const float pg = __builtin_amdgcn_rcpf(den);
                float el[8];
                const LAS float* wgrp = wl + (4 + gs * 8) * 1024 + li * 4;
#pragma unroll
                for (int e = 0; e < 8; ++e) { const LAS float* wrow = wgrp + e * 1024; f32x4 wv[16];
#pragma unroll
                    for (int q = 0; q < 16; ++q) wv[q] = *(const LAS f32x4*)(wrow + q * 64);
                    __builtin_amdgcn_sched_barrier(0);
                    f32x4 a4 = h[0] * wv[0];
#pragma unroll
                    for (int q = 1; q < 16; ++q) a4 = __builtin_elementwise_fma(h[q], wv[q], a4);
                    el[e] = (a4[0] + a4[1]) + (a4[2] + a4[3]); }
#pragma unroll
                for (int st = 0; st < 4; ++st)
#pragma unroll
                    for (int e = 0; e < 8; ++e) el[e] += st == 0 ? dpp_f<0xB1>(el[e]) : st == 1 ? dpp_f<0x4E>(el[e]) : st == 2 ? dpp_f<0x141>(el[e]) : dpp_f<0x140>(el[e]);
#pragma unroll
                for (int e = 0; e < 8; ++e) el[e] += be[gs * 8 + e];
                int i0 = 0; float v0 = el[0];
#pragma unroll
                for (int e = 1; e < 8; ++e) if (el[e] > v0) { v0 = el[e]; i0 = e; }
                int i1 = -1; float v1 = -INFINITY;
#pragma unroll
                for (int e = 0; e < 8; ++e) if (e != i0 && el[e] > v1) { v1 = el[e]; i1 = e; }
                const float p0 = __builtin_amdgcn_rcpf(1.0f + __expf(v1 - v0)), p1 = 1.0f - p0;
                { LAS int* ls = lsel + kc * 7;
                    if (!act) { if (li == 0) ls[0] = -1; }
                    else if (li < 2) { const int ee = gs * 8 + (li ? i1 : i0);
                        ls[li] = ee; ls[2 + li] = (int)__hip_atomic_fetch_add(lcn + ee, 1u, __ATOMIC_RELAXED, __HIP_MEMORY_SCOPE_WORKGROUP); ls[4 + li] = (int)__float_as_uint((li ? p1 : p0) * pg); } }
            }
#undef R_ISSUE
#undef R_PERM
            __syncthreads();
            if (tid < 32) { const unsigned c_ = lcn[tid]; lcn[32 + tid] = (c_ && rep_ == 0) ? __hip_atomic_fetch_add(cnt + tid * 64, c_, __ATOMIC_RELAXED, __HIP_MEMORY_SCOPE_AGENT) : 0u; }
            __syncthreads();
            if (tid < 136 && rep_ == 0) { const LAS int* ls = lsel + tid * 7; const int e0 = ls[0];
                if (e0 >= 0) { const int e1 = ls[1], t_ = bb * 136 + tid; const float rs_ = __uint_as_float((unsigned)ls[6]);
                    const size_t q0 = (size_t)e0 * LCAP + (unsigned)ls[2] + lcn[32 + e0], q1 = (size_t)e1 * LCAP + (unsigned)ls[3] + lcn[32 + e1];
                    ltok2[q0] = t_ * 2; lp2[q0] = __uint_as_float((unsigned)ls[4]); lrs2[q0] = rs_; ltok2[q1] = t_ * 2 + 1; lp2[q1] = __uint_as_float((unsigned)ls[5]); lrs2[q1] = rs_; } }
            __syncthreads();
            if (tid < 32) lcn[tid] = 0u;
            }
        }
        SEAM(P0 + 11);
        for (int rep_ = 0; rep_ < (DUP == 13 ? 1 + DUPN : 1); ++rep_)
        if (ON(13) && RUN(P0 + 13)) { PHK();
            LAS int* tofl = (LAS int*)(lds + g8::STAGE_BYTES);
            { int t_ = threadIdx.x; asm volatile("" : "+v"(t_));
              if (t_ < 32) tofl[64 + t_] = (int)__hip_atomic_load(cnt + t_ * 64, __ATOMIC_RELAXED, __HIP_MEMORY_SCOPE_AGENT);
              __syncthreads();
              if (t_ == 0) { int o = 0; for (int e = 0; e < NEXP; ++e) { tofl[e] = o; o += (tofl[64 + e] + 255) >> 8; } tofl[NEXP] = o; } }
            __syncthreads();
            const int ntl = tofl[NEXP];
            SchedMoe<true> S{(const char*)H8, wb + W_13, ltok2, tofl, ntl, 2, 512, G, bid, (size_t)512 * 1024}; EpiMoe1I8 E{HE, lrs2, CMAX3(l)};
            g8::gemm_phase(lds, S, E);
        }
        SEAM(P0 + 13);
        for (int rep_ = 0; rep_ < (DUP == 14 ? 1 + DUPN : 1); ++rep_)
        if (ON(14) && RUN(P0 + 14)) { PHK();
            LAS int* tofl = (LAS int*)(lds + g8::STAGE_BYTES);
            { int t_ = threadIdx.x; asm volatile("" : "+v"(t_));
              if (t_ < 32) tofl[64 + t_] = (int)__hip_atomic_load(cnt + t_ * 64, __ATOMIC_RELAXED, __HIP_MEMORY_SCOPE_AGENT);
              __syncthreads();
              if (t_ == 0) { int o = 0; for (int e = 0; e < NEXP; ++e) { tofl[e] = o; o += (tofl[64 + e] + 255) >> 8; } tofl[NEXP] = o; } }
            __syncthreads();
            const int ntl = tofl[NEXP];
            SchedMoe<false> S{(const char*)HE, wb + W_2T, ltok2, tofl, ntl, 4, 256, G, bid, (size_t)1024 * 256 * 2}; EpiMoe2 E{Y2, ltok2, lp2};
            g8::gemm_phase(lds, S, E);
        }
        SEAM(P0 + 14);
    }
    if (ON(16) && RUN(PH_FINAL)) { LTID();
        f32x4 gfin[4];
#pragma unroll
        for (int j = 0; j < 4; ++j) gfin[j] = *(const f32x4*)(KP->g_final + (j * 64 + lane) * 4);
        for (int bb = bid; bb < NB_ * SEQ / 128; bb += G) {
            const int b = (bb * 128) / SEQ; f32x4 gf4[4];
            { const float* gf = modv + ((size_t)(NLAYER - 1) * 9 + b) * 6144 + 5120;
#pragma unroll
              for (int j = 0; j < 4; ++j) gf4[j] = *(const f32x4*)(gf + (j * 64 + lane) * 4); }
            u32x2 L_v[4], L_ya[4], L_yb[4];
#define F_ISSUE(RR) do { const int r_ = (RR); const int n_ = r_ - b * SEQ; const bf16_t* xr_ = XB + (size_t)(b * TPB + NCTX + n_) * 1024; const bf16_t* y_ = Y2 + (size_t)(b * TPB + NCTX + n_) * 2048; \
                _Pragma("unroll") for (int j = 0; j < 4; ++j) { const int col = (j * 64 + lane) * 4; L_v[j] = *(const u32x2*)(xr_ + col); L_ya[j] = *(const u32x2*)(y_ + col); L_yb[j] = *(const u32x2*)(y_ + 1024 + col); } } while (0)
            F_ISSUE(bb * 128 + wid);
            for (int it = 0; it < 16; ++it) {
                const int r = bb * 128 + it * 8 + wid; float* xr = KP->out + (size_t)r * DM;
                f32x4 v[4]; u32x2 ya[4], yb[4];
#pragma unroll
                for (int j = 0; j < 4; ++j) { v[j] = unpack4(L_v[j]); ya[j] = L_ya[j]; yb[j] = L_yb[j]; }
                if (it + 1 < 16) F_ISSUE(r + 8);
                __builtin_amdgcn_sched_barrier(0);
                float ss = 0.f;
#pragma unroll
                for (int j = 0; j < 4; ++j) { f32x4 xv = v[j]; const f32x4 g = gf4[j]; const u32x2 a = ya[j], bq = yb[j];
                    xv[0] += g[0] * (__uint_as_float(a.x << 16) + __uint_as_float(bq.x << 16)); xv[1] += g[1] * (__uint_as_float(a.x & 0xffff0000u) + __uint_as_float(bq.x & 0xffff0000u));
                    xv[2] += g[2] * (__uint_as_float(a.y << 16) + __uint_as_float(bq.y << 16)); xv[3] += g[3] * (__uint_as_float(a.y & 0xffff0000u) + __uint_as_float(bq.y & 0xffff0000u));
                    v[j] = xv; ss += xv[0] * xv[0] + xv[1] * xv[1] + xv[2] * xv[2] + xv[3] * xv[3]; }
                ss = wave_sum(ss); const float rstd = rsqrtf(ss * (1.0f / 1024.0f) + 1e-6f);
#pragma unroll
                for (int j = 0; j < 4; ++j) *(f32x4*)(xr + (j * 64 + lane) * 4) = v[j] * rstd * gfin[j];
            }
#undef F_ISSUE
        }
    }
}

extern "C" void kernel_launch(void* const* d_in, const int* in_sizes, int n_in, void* d_out, int out_size, void* d_ws, size_t ws_size, hipStream_t stream) {
    static int grid = 0;
    if (!grid) {
        if (n_in != 32 || ws_size < WS_END2) { fprintf(stderr, "kernel_launch: unexpected inputs (n_in %d, ws %zu, need %zu)\n", n_in, ws_size, (size_t)WS_END); grid = -1; return; }
        int dev = 0, cus = 0, per_cu = 0;
        hipGetDevice(&dev); hipDeviceGetAttribute(&cus, hipDeviceAttributeMultiprocessorCount, dev);
        hipFuncSetAttribute((const void*)mega, hipFuncAttributeMaxDynamicSharedMemorySize, LDS_BYTES);
        hipOccupancyMaxActiveBlocksPerMultiprocessor(&per_cu, (const void*)mega, 512, LDS_BYTES);
        if (per_cu < 1) fprintf(stderr, "kernel_launch: occupancy query says %d\n", per_cu);
        grid = cus > 0 ? cus : 256;
    }
    if (grid < 0) return;
    hipMemsetAsync((char*)d_ws + WS_CTL, 0, CTL_BYTES, stream);
    Params p{};
    const float** fp = (const float**)&p;
    for (int i = 0; i < 32; ++i) fp[i] = (const float*)d_in[i];
    p.out = (float*)d_out; p.ws = (char*)d_ws;
#if N_LAUNCH_MODE == 1
    p.lo = 0; p.hi = NPHASE;
    hipLaunchKernelGGL(mega, dim3(grid), dim3(512), LDS_BYTES, stream, p);
#else
    for (int ph = 0; ph < NPHASE; ++ph) {
        p.lo = ph; p.hi = ph + 1;
        hipLaunchKernelGGL(mega, dim3(grid), dim3(512), LDS_BYTES, stream, p);
    }
#endif
}
```
